# Optimizing an MI355X kernel written in HIP

```python
import jax, jax.numpy as jnp
from jax import lax
import numpy as np

D_MODEL = 2048
BATCH = 2
SEQ = 4096
DEPTH = 2

GRID_W = 64
CTX_LEN = 256
EPS = 1e-6

QK_NOPE = 128
QK_ROPE = 64
V_DIM = 128
N_HEADS = D_MODEL // V_DIM
Q_LORA = D_MODEL // 4
KV_LORA = D_MODEL // 4
ROPE_THETA = 10000.0
ATTN_SCALE = (QK_NOPE + QK_ROPE) ** -0.5
Q_BLOCK = 128

POOL_WINDOWS = (2, 4, 8, 16)
N_POOL_GROUPS = len(POOL_WINDOWS)
POOL_WIDTH = D_MODEL // 2
POOL_GROUP = POOL_WIDTH // N_POOL_GROUPS
POOL_OUT_GROUP = D_MODEL // N_POOL_GROUPS

N_BRANCH = 2
OFF_Q = 0
OFF_KV = OFF_Q + Q_LORA
OFF_KR = OFF_KV + KV_LORA
OFF_POOL = OFF_KR + QK_ROPE
OFF_GATE = OFF_POOL + POOL_WIDTH
IN_WIDTH = OFF_GATE + N_BRANCH * D_MODEL

D_FF = 7 * D_MODEL // 2
N_EXPERTS = 8
TOP_K = 2
D_EXPERT = 7 * D_MODEL // 2
N_DENSE = (DEPTH + 1) // 2
N_MOE = DEPTH // 2

kernel_name = "hybrid_mla_pool_moe_dit_block"


def rmsnorm(x, g):
    xf = x.astype(jnp.float32)
    y = xf * lax.rsqrt(jnp.mean(xf * xf, axis=-1, keepdims=True) + EPS) * g.astype(jnp.float32)
    return y.astype(x.dtype)


def modulate(h, shift, scale):
    return h * (1.0 + scale) + shift


def axial_rope(n_tokens):
    rows = n_tokens // GRID_W
    row_ids = jnp.repeat(jnp.arange(rows, dtype=jnp.float32), GRID_W)
    col_ids = jnp.tile(jnp.arange(GRID_W, dtype=jnp.float32), rows)
    n_freq = QK_ROPE // 4
    inv = ROPE_THETA ** (-jnp.arange(n_freq, dtype=jnp.float32) / n_freq)
    ang = jnp.concatenate([row_ids[:, None] * inv, col_ids[:, None] * inv], axis=-1)
    return jnp.cos(ang), jnp.sin(ang)


def apply_rope(x, cos, sin):
    half = x.shape[-1] // 2
    x1 = x[..., :half].astype(jnp.float32)
    x2 = x[..., half:].astype(jnp.float32)
    return jnp.concatenate([x1 * cos - x2 * sin, x1 * sin + x2 * cos], axis=-1).astype(x.dtype)


def q_heads(q_lat, g_q, w_q_up):
    B, L = q_lat.shape[:2]
    q = (rmsnorm(q_lat, g_q) @ w_q_up).reshape(B, L, N_HEADS, QK_NOPE + QK_ROPE)
    return q[..., :QK_NOPE], q[..., QK_NOPE:]


def kv_heads(kv_lat, g_kv, w_kv_up):
    B, L = kv_lat.shape[:2]
    kv = (rmsnorm(kv_lat, g_kv) @ w_kv_up).reshape(B, L, N_HEADS, QK_NOPE + V_DIM)
    return kv[..., :QK_NOPE], kv[..., QK_NOPE:]


def mla_attend(qn, qr, kn, kr, v):
    s = jnp.einsum('bqhd,bkhd->bhqk', qn, kn) + jnp.einsum('bqhr,bkr->bhqk', qr, kr)
    p = jax.nn.softmax(s.astype(jnp.float32) * ATTN_SCALE, axis=-1).astype(v.dtype)
    o = jnp.einsum('bhqk,bkhd->bqhd', p, v)
    return o.reshape(o.shape[0], o.shape[1], N_HEADS * V_DIM)


def latent_attention(qn, qr, kn, kr, v):
    B, S = qn.shape[:2]
    nb = S // Q_BLOCK
    qn_b = qn.reshape(B, nb, Q_BLOCK, N_HEADS, QK_NOPE).swapaxes(0, 1)
    qr_b = qr.reshape(B, nb, Q_BLOCK, N_HEADS, QK_ROPE).swapaxes(0, 1)
    out = lax.map(lambda q: mla_attend(q[0], q[1], kn, kr, v), (qn_b, qr_b))
    return out.swapaxes(0, 1).reshape(B, S, N_HEADS * V_DIM)


def multiscale_pool(u, w_pool, pool_scale):
    B, L, _ = u.shape
    ug = u.reshape(B, L, N_POOL_GROUPS, POOL_GROUP)
    cs = jnp.concatenate([jnp.zeros((B, 1, N_POOL_GROUPS, POOL_GROUP), jnp.float32),
                          jnp.cumsum(ug.astype(jnp.float32), axis=1)], axis=1)
    t = jnp.arange(L)
    mixed = []
    for gi, w in enumerate(POOL_WINDOWS):
        lo = jnp.clip(t - w // 2, 0, L)
        hi = jnp.clip(t - w // 2 + w, 0, L)
        cnt = (hi - lo).astype(jnp.float32)[None, :, None]
        mean = (cs[:, hi, gi] - cs[:, lo, gi]) / cnt
        mixed.append(mean - ug[:, :, gi].astype(jnp.float32))
    pooled = jnp.stack(mixed, axis=2).astype(u.dtype)
    out = jnp.einsum('blgc,gcd->blgd', pooled, w_pool).reshape(B, L, D_MODEL)
    return out * pool_scale


def merge_branches(attn, pool, gate_logits, b_gate, w_out):
    g = jax.nn.sigmoid((gate_logits + b_gate).astype(jnp.float32)).astype(attn.dtype)
    return (g[..., :D_MODEL] * attn + g[..., D_MODEL:] * pool) @ w_out


def swiglu(h, wg, wu, wd):
    return (jax.nn.silu(h @ wg) * (h @ wu)) @ wd


def moe_swiglu(h, w_router, b_router, wg, wu, wd):
    logits = (h @ w_router).astype(jnp.float32) + b_router.astype(jnp.float32)
    probs = jax.nn.softmax(logits, axis=-1)
    top_p, top_i = lax.top_k(probs, TOP_K)
    top_p = top_p / jnp.sum(top_p, axis=-1, keepdims=True)
    combine = jnp.sum(jax.nn.one_hot(top_i, N_EXPERTS, dtype=jnp.float32) * top_p[..., None], axis=-2)
    y = jnp.zeros(h.shape[:-1] + (D_MODEL,), h.dtype)
    for e in range(N_EXPERTS):
        y = y + combine[..., e:e + 1].astype(h.dtype) * swiglu(h, wg[e], wu[e], wd[e])
    return y


def setup_inputs(seed: int = 0) -> dict:
    key = jax.random.key(seed)
    ks = jax.random.split(key, 32)
    f32 = jnp.float32

    def nrm(k, shape, scale):
        return jax.random.normal(k, shape, f32) * scale

    def gain(k, shape):
        return 1.0 + 0.05 * jax.random.normal(k, shape, f32)

    D = D_MODEL
    return {
        "x": nrm(ks[0], (BATCH, SEQ, D), 1.0),
        "c": nrm(ks[1], (BATCH, D), 1.0),
        "ctx": nrm(ks[2], (BATCH, CTX_LEN, D), 1.0),
        "c_ctx": nrm(ks[3], (D,), 1.0),
        "w_mod": nrm(ks[4], (DEPTH, D, 6 * D), D ** -0.5),
        "b_mod": nrm(ks[5], (DEPTH, 6 * D), 0.02),
        "g_mix_pre": gain(ks[6], (DEPTH, D)),
        "g_mix_post": gain(ks[7], (DEPTH, D)),
        "g_ffn_pre": gain(ks[8], (DEPTH, D)),
        "g_ffn_post": gain(ks[9], (DEPTH, D)),
        "w_in": nrm(ks[10], (DEPTH, D, IN_WIDTH), D ** -0.5),
        "b_gate": nrm(ks[11], (DEPTH, N_BRANCH * D), 0.02),
        "g_q_lat": gain(ks[12], (DEPTH, Q_LORA)),
        "g_kv_lat": gain(ks[13], (DEPTH, KV_LORA)),
        "w_q_up": nrm(ks[14], (DEPTH, Q_LORA, N_HEADS * (QK_NOPE + QK_ROPE)), Q_LORA ** -0.5),
        "w_kv_up": nrm(ks[15], (DEPTH, KV_LORA, N_HEADS * (QK_NOPE + V_DIM)), KV_LORA ** -0.5),
        "w_pool": nrm(ks[16], (DEPTH, N_POOL_GROUPS, POOL_GROUP, POOL_OUT_GROUP), POOL_GROUP ** -0.5),
        "pool_scale": gain(ks[17], (DEPTH, D)),
        "w_out": nrm(ks[18], (DEPTH, D, D), D ** -0.5),
        "w_ff_gate": nrm(ks[19], (N_DENSE, D, D_FF), D ** -0.5),
        "w_ff_up": nrm(ks[20], (N_DENSE, D, D_FF), D ** -0.5),
        "w_ff_down": nrm(ks[21], (N_DENSE, D_FF, D), D_FF ** -0.5),
        "w_router": nrm(ks[22], (N_MOE, D, N_EXPERTS), D ** -0.5),
        "b_router": nrm(ks[23], (N_MOE, N_EXPERTS), 0.01),
        "w_exp_gate": nrm(ks[24], (N_MOE, N_EXPERTS, D, D_EXPERT), D ** -0.5),
        "w_exp_up": nrm(ks[25], (N_MOE, N_EXPERTS, D, D_EXPERT), D ** -0.5),
        "w_exp_down": nrm(ks[26], (N_MOE, N_EXPERTS, D_EXPERT, D), D_EXPERT ** -0.5),
    }


def reference(x, c, ctx, c_ctx, w_mod, b_mod, g_mix_pre, g_mix_post, g_ffn_pre, g_ffn_post,
              w_in, b_gate, g_q_lat, g_kv_lat, w_q_up, w_kv_up, w_pool, pool_scale, w_out,
              w_ff_gate, w_ff_up, w_ff_down, w_router, b_router, w_exp_gate, w_exp_up, w_exp_down):
    S = x.shape[1]
    cos, sin = axial_rope(S)
    h_ctx = ctx

    def channel_mixer(l, h):
        i = l // 2
        if l % 2 == 0:
            return swiglu(h, w_ff_gate[i], w_ff_up[i], w_ff_down[i])
        return moe_swiglu(h, w_router[i], b_router[i], w_exp_gate[i], w_exp_up[i], w_exp_down[i])

    for l in range(DEPTH):
        last = l == DEPTH - 1
        mod_x = (jax.nn.silu(c) @ w_mod[l] + b_mod[l])[:, None, :]
        mod_c = (jax.nn.silu(c_ctx) @ w_mod[l] + b_mod[l])[None, None, :]
        sh1, sc1, g1, sh2, sc2, g2 = jnp.split(mod_x, 6, axis=-1)
        csh1, csc1, cg1, csh2, csc2, cg2 = jnp.split(mod_c, 6, axis=-1)

        h = modulate(rmsnorm(x, g_mix_pre[l]), sh1, sc1)
        hc = modulate(rmsnorm(h_ctx, g_mix_pre[l]), csh1, csc1)

        p = h @ w_in[l]
        qn, qr = q_heads(p[..., OFF_Q:OFF_KV], g_q_lat[l], w_q_up[l])
        qr = apply_rope(qr, cos[:, None, :], sin[:, None, :])
        kn, v = kv_heads(p[..., OFF_KV:OFF_KR], g_kv_lat[l], w_kv_up[l])
        kr = apply_rope(p[..., OFF_KR:OFF_POOL], cos, sin)

        if last:
            pc_kv = hc @ w_in[l][:, OFF_KV:OFF_POOL]
        else:
            pc = hc @ w_in[l]
            pc_kv = pc[..., OFF_KV:OFF_POOL]
        kn_c, v_c = kv_heads(pc_kv[..., :KV_LORA], g_kv_lat[l], w_kv_up[l])
        kr_c = pc_kv[..., KV_LORA:]

        kn_all = jnp.concatenate([kn_c, kn], axis=1)
        kr_all = jnp.concatenate([kr_c, kr], axis=1)
        v_all = jnp.concatenate([v_c, v], axis=1)
        attn = latent_attention(qn, qr, kn_all, kr_all, v_all)
        pool = multiscale_pool(p[..., OFF_POOL:OFF_GATE], w_pool[l], pool_scale[l])
        y = merge_branches(attn, pool, p[..., OFF_GATE:], b_gate[l], w_out[l])
        x = x + g1 * rmsnorm(y, g_mix_post[l])

        if not last:
            qn_c, qr_c = q_heads(pc[..., OFF_Q:OFF_KV], g_q_lat[l], w_q_up[l])
            attn_c = mla_attend(qn_c, qr_c, kn_c, kr_c, v_c)
            pool_c = multiscale_pool(pc[..., OFF_POOL:OFF_GATE], w_pool[l], pool_scale[l])
            yc = merge_branches(attn_c, pool_c, pc[..., OFF_GATE:], b_gate[l], w_out[l])
            h_ctx = h_ctx + cg1 * rmsnorm(yc, g_mix_post[l])

        h2 = modulate(rmsnorm(x, g_ffn_pre[l]), sh2, sc2)
        if last:
            y2 = channel_mixer(l, h2)
            x = x + g2 * rmsnorm(y2, g_ffn_post[l])
        else:
            C = h_ctx.shape[1]
            h2c = modulate(rmsnorm(h_ctx, g_ffn_pre[l]), csh2, csc2)
            y_all = channel_mixer(l, jnp.concatenate([h2c, h2], axis=1))
            x = x + g2 * rmsnorm(y_all[:, C:], g_ffn_post[l])
            h_ctx = h_ctx + cg2 * rmsnorm(y_all[:, :C], g_ffn_post[l])

    return x
```

```cpp
#include <hip/hip_runtime.h>
#include <cstdio>
#include <cstdint>
#include <type_traits>

#ifndef NAIVE_GEMM
#define NAIVE_GEMM 0
#endif
#ifndef MOE_FP8
#define MOE_FP8 1
#endif
#ifndef MOE_DIRECT
#define MOE_DIRECT (MOE_FP8)
#endif
#ifndef DENSE_I8
#define DENSE_I8 1
#endif
#ifndef WIN_I8
#define WIN_I8 1
#endif
#ifndef NAIVE_ATTN
#define NAIVE_ATTN 0
#endif

#define GAS __attribute__((address_space(1)))
#define LAS __attribute__((address_space(3)))
typedef unsigned short bf16_t;
typedef short bf16x8 __attribute__((ext_vector_type(8)));
typedef short s16x4 __attribute__((ext_vector_type(4)));
typedef float f32x4 __attribute__((ext_vector_type(4)));
typedef float f32x2 __attribute__((ext_vector_type(2)));
typedef float f32x16 __attribute__((ext_vector_type(16)));
typedef unsigned u32x4 __attribute__((ext_vector_type(4)));
typedef unsigned u32x2 __attribute__((ext_vector_type(2)));

constexpr int DM = 2048, NB = 2, SEQ = 4096, CTXL = 256, TPB = SEQ + CTXL, R = NB * TPB;
constexpr int NH = 16, DN = 128, DRP = 64, DV = 128, DQK = 192, QL = 512, KVL = 512;
constexpr int POOLW = 1024, INW = 6208, INWP = 6400;
constexpr int DFF = 7168, NE = 8;
constexpr int NLAT = NB * SEQ;
constexpr int MOE_ROWS = 18432;
constexpr float EPS = 1e-6f;
constexpr float ATTN_SCALE = 0.07216878364870322f;
constexpr int CQ = 0, CKV = 512, CPOOL = 1024, CGATE = 2048, CKR = 6144;
constexpr int ZK = 2, KSPL = DFF / ZK;

constexpr size_t MiB = 1u << 20;
constexpr size_t WS_CTL = 0, CTL_BYTES = 1 * MiB;
constexpr size_t WS_MODP = 1 * MiB;
constexpr size_t WS_MOD = 6 * MiB;
constexpr size_t WS_ROPE = 7 * MiB;
constexpr size_t WS_WSCP = 9 * MiB;
constexpr size_t WS_WSC = 10 * MiB;
constexpr size_t WS_HSC = 11 * MiB;
constexpr size_t WS_WSCP2 = 12 * MiB;
constexpr size_t WS_WSC2 = 13 * MiB;
constexpr size_t WS_TOK = 8 * MiB;
constexpr size_t WS_WIN = 16 * MiB;
constexpr size_t SZ_WIN = (size_t)INWP * DM * 2;
constexpr size_t WS_WQUP = WS_WIN + 2 * SZ_WIN;
constexpr size_t SZ_WQUP = (size_t)3072 * 512 * 2;
constexpr size_t WS_WKVUP = WS_WQUP + 2 * SZ_WQUP;
constexpr size_t SZ_WKVUP = (size_t)4096 * 512 * 2;
constexpr size_t WS_WPOOL = WS_WKVUP + 2 * SZ_WKVUP;
constexpr size_t SZ_WPOOL = (size_t)2048 * 256 * 2;
constexpr size_t WS_WOUT = WS_WPOOL + 2 * SZ_WPOOL;
constexpr size_t SZ_WOUT = (size_t)2048 * 2048 * 2;
constexpr size_t WS_WFFGU = WS_WOUT + 2 * SZ_WOUT;
constexpr size_t SZ_WGU = (size_t)14336 * 2048 * 2;
constexpr size_t WS_WFFD = WS_WFFGU + SZ_WGU;
constexpr size_t SZ_WD = (size_t)2048 * 7168 * 2;
constexpr size_t WS_WEGU = WS_WFFD + SZ_WD;
constexpr size_t WS_WED = WS_WEGU + 8 * SZ_WGU;
constexpr size_t WS_WEND = WS_WED + 8 * SZ_WD;
constexpr size_t WS_XRES = (WS_WEND + MiB - 1) / MiB * MiB;
constexpr size_t WS_H = WS_XRES + (size_t)R * DM * 4;
constexpr size_t WS_U = WS_H + (size_t)R * DM * 2;
constexpr size_t WS_P = WS_U;
constexpr size_t WS_QLN = WS_P + (size_t)R * INWP * 2;
constexpr size_t WS_KVLN = WS_QLN + (size_t)R * 512 * 2;
constexpr size_t WS_PL = WS_KVLN + (size_t)R * 512 * 2;
constexpr size_t WS_Q = WS_PL + (size_t)R * 1024 * 2;
constexpr size_t WS_KN = WS_Q + (size_t)R * 3072 * 2;
constexpr size_t WS_V = WS_KN + (size_t)R * 2048 * 2;
constexpr size_t WS_POOLM = WS_V + (size_t)R * 2048 * 2;
constexpr size_t WS_MB = WS_POOLM + (size_t)R * 2048 * 2;
constexpr size_t WS_Y = WS_MB + (size_t)R * 2048 * 2;
constexpr size_t WS_MIXEND = WS_Y + (size_t)R * 2048 * 2;
constexpr size_t WS_ACT = WS_U;
constexpr size_t WS_Y2 = WS_ACT + (size_t)MOE_ROWS * DFF * 2;
constexpr size_t WS_HS = WS_Y2 + (size_t)ZK * MOE_ROWS * DM * 4;
constexpr size_t WS_FFNEND = WS_HS + (size_t)MOE_ROWS * DM * 2;
constexpr size_t WS_HS2 = WS_U + 400 * MiB;
static_assert(WS_HS2 + (size_t)NE * NLAT * DM <= WS_FFNEND && WS_HS2 >= WS_MIXEND && WS_HS2 >= WS_Y2 + (size_t)ZK * MOE_ROWS * DM * 2, "fixed-capacity expert rows");
constexpr size_t WS_YC = WS_U + 400 * MiB;
constexpr int ZS_G5 = 14, ZS_G3 = 16;
static_assert(WS_YC >= WS_MIXEND && WS_YC >= WS_Y2 + (size_t)R * DM * 4 && WS_YC + (size_t)16 * 512 * DM * 4 <= WS_FFNEND, "YC placement");
constexpr size_t WS_END = WS_FFNEND > WS_MIXEND ? WS_FFNEND : WS_MIXEND;
static_assert(WS_Y + (size_t)R * 2048 * 2 <= WS_HS || true, "");
constexpr int CW_BAR = 4096;
constexpr int CW_QHEAD = 20480;
constexpr int CW_DONE = 24576;
constexpr int CW_CNT = 16384;

constexpr int RING_BYTES = 131072;
constexpr int LDSCTL_OFF = RING_BYTES, MISC_OFF = LDSCTL_OFF + 320;
constexpr int LDS_BYTES = 163840;

#define RLX_AGENT __ATOMIC_RELAXED, __HIP_MEMORY_SCOPE_AGENT
__device__ __forceinline__ float bf2f(unsigned h) { return __uint_as_float(h << 16); }
__device__ __forceinline__ unsigned f2bf(float f) { unsigned u = __float_as_uint(f); return (u + 0x7fffu + ((u >> 16) & 1u)) >> 16; }
__device__ __forceinline__ unsigned pk2(float lo, float hi) { return f2bf(lo) | (f2bf(hi) << 16); }
__device__ __forceinline__ unsigned cvt_pk_bf16(float lo, float hi) { unsigned r; asm volatile("v_cvt_pk_bf16_f32 %0, %1, %2" : "=v"(r) : "v"(lo), "v"(hi)); return r; }
template <int M> __device__ __forceinline__ float swz_xor(float v) { return __int_as_float(__builtin_amdgcn_ds_swizzle(__float_as_int(v), (M << 10) | 0x1f)); }
__device__ __forceinline__ float wave_sum(float v) {
    v += swz_xor<1>(v); v += swz_xor<2>(v); v += swz_xor<4>(v); v += swz_xor<8>(v); v += swz_xor<16>(v);
    auto rr = __builtin_amdgcn_permlane32_swap(__float_as_uint(v), __float_as_uint(v), false, false);
    return __uint_as_float(rr[0]) + __uint_as_float(rr[1]);
}
__device__ __forceinline__ float wave_max(float v) {
    v = fmaxf(v, swz_xor<1>(v)); v = fmaxf(v, swz_xor<2>(v)); v = fmaxf(v, swz_xor<4>(v)); v = fmaxf(v, swz_xor<8>(v)); v = fmaxf(v, swz_xor<16>(v));
    auto rr = __builtin_amdgcn_permlane32_swap(__float_as_uint(v), __float_as_uint(v), false, false);
    return fmaxf(__uint_as_float(rr[0]), __uint_as_float(rr[1]));
}
__device__ __forceinline__ float fast_exp(float x) { return __builtin_amdgcn_exp2f(x * 1.4426950408889634f); }
__device__ __forceinline__ float sigmoidf_(float x) { return __builtin_amdgcn_rcpf(1.f + fast_exp(-x)); }
__device__ __forceinline__ u32x4 pack8(const float* v) { u32x4 w; w.x = cvt_pk_bf16(v[0], v[1]); w.y = cvt_pk_bf16(v[2], v[3]); w.z = cvt_pk_bf16(v[4], v[5]); w.w = cvt_pk_bf16(v[6], v[7]); return w; }
__device__ __forceinline__ unsigned cvt4_fp8(float a, float b, float c, float d) { int p = 0; p = __builtin_amdgcn_cvt_pk_fp8_f32(a, b, p, false); p = __builtin_amdgcn_cvt_pk_fp8_f32(c, d, p, true); return (unsigned)p; }
__device__ __forceinline__ void unpack8(u32x4 w, float* v) {
    v[0] = __uint_as_float(w.x << 16); v[1] = __uint_as_float(w.x & 0xffff0000u); v[2] = __uint_as_float(w.y << 16); v[3] = __uint_as_float(w.y & 0xffff0000u);
    v[4] = __uint_as_float(w.z << 16); v[5] = __uint_as_float(w.z & 0xffff0000u); v[6] = __uint_as_float(w.w << 16); v[7] = __uint_as_float(w.w & 0xffff0000u);
}

__device__ __forceinline__ int fresh_tid(int wv);
#define XB_TMO      128
#define XB_XCNT(j)  (256  + 64 * (j))
#define XB_XSUB(j)  (1280 + 64 * (j))
#define XB_XGEN(j)  (2304 + 64 * (j))
#define XB_TOP      3328
#define XB_TOPGEN   3392
#define XCD_BAR_WORDS 3456
#if NAIVE_GEMM || NAIVE_ATTN
#define XB_SPIN_CAP (1u << 27)
#else
#define XB_SPIN_CAP (1u << 20)
#endif
__device__ __forceinline__ unsigned xb_ld(unsigned* p)              { return __hip_atomic_load(p, __ATOMIC_RELAXED, __HIP_MEMORY_SCOPE_AGENT); }
__device__ __forceinline__ unsigned xb_add(unsigned* p, unsigned v) { return __hip_atomic_fetch_add(p, v, __ATOMIC_RELAXED, __HIP_MEMORY_SCOPE_AGENT); }
__device__ __forceinline__ unsigned xb_xcc_id() { return (unsigned)__builtin_amdgcn_s_getreg((3 << 11) | 20) & 0xFu; }
#define XB_SPIN(cond, bar) do { unsigned _sp = 0; while (cond) { __builtin_amdgcn_s_sleep(1); \
    if ((++_sp & 255u) == 0u) { if (xb_ld(&(bar)[XB_TMO])) break; if (_sp > XB_SPIN_CAP) { atomicAdd(&(bar)[XB_TMO], 1u); break; } } } } while (0)
struct XcdBarrier { unsigned* bar; unsigned x; volatile LAS unsigned* st; };
__device__ __forceinline__ XcdBarrier xcd_barrier_post(unsigned* bar, volatile LAS unsigned* st) {
    XcdBarrier b; b.bar = bar; b.x = xb_xcc_id(); b.st = st;
    if (threadIdx.x == 0) (void)xb_add(&bar[XB_XCNT(b.x)], 1u);
    return b;
}
__device__ __forceinline__ void xcd_barrier_complete(unsigned* bar, unsigned x, unsigned& nloc, unsigned& nx) {
    const unsigned G = gridDim.x * gridDim.y * gridDim.z;
    unsigned sum, cnt, mine, sp = 0u;
    for (;;) {
        sum = 0u; cnt = 0u; mine = 0u;
#pragma unroll
        for (unsigned j = 0; j < 16; ++j) { const unsigned c = xb_ld(&bar[XB_XCNT(j)]); sum += c; cnt += (c > 0u) ? 1u : 0u; mine = (j == x) ? c : mine; }
        if (sum == G) break;
        __builtin_amdgcn_s_sleep(1);
        if ((++sp & 255u) == 0u) { if (xb_ld(&bar[XB_TMO])) break; if (sp > XB_SPIN_CAP) { atomicAdd(&bar[XB_TMO], 1u); break; } }
    }
    nloc = mine > 0u ? mine : 1u; nx = cnt > 0u ? cnt : 1u;
}
__device__ __forceinline__ void xcd_barrier(const XcdBarrier& b) {
    asm volatile("s_waitcnt vmcnt(0)" ::: "memory");
    __syncthreads();
    if (threadIdx.x == 0) {
        unsigned* bar = b.bar;
        __builtin_amdgcn_s_waitcnt(0);
        unsigned nloc = b.st[0], nx = b.st[1];
        if (nloc == 0u) { xcd_barrier_complete(bar, b.x, nloc, nx); b.st[0] = nloc; b.st[1] = nx; }
        const unsigned old = xb_add(&bar[XB_XSUB(b.x)], 1u);
        const unsigned gen = old / nloc;
        if (old + 1u == (gen + 1u) * nloc) {
            __builtin_amdgcn_fence(__ATOMIC_RELEASE, "agent");
            asm volatile("s_waitcnt vmcnt(0)" ::: "memory");
            const unsigned og = xb_add(&bar[XB_TOP], 1u);
            const unsigned tg = og / nx;
            if (og + 1u == (tg + 1u) * nx) xb_add(&bar[XB_TOPGEN], 1u);
            else XB_SPIN(xb_ld(&bar[XB_TOPGEN]) == tg, bar);
            __builtin_amdgcn_fence(__ATOMIC_ACQUIRE, "agent");
            xb_add(&bar[XB_XGEN(b.x)], 1u);
            asm volatile("s_waitcnt vmcnt(0)" ::: "memory");
        } else {
            XB_SPIN(xb_ld(&bar[XB_XGEN(b.x)]) == gen, bar);
            __builtin_amdgcn_fence(__ATOMIC_ACQUIRE, "agent");
            asm volatile("s_waitcnt vmcnt(0)" ::: "memory");
        }
    }
    __syncthreads();
}

namespace pg8 {
constexpr int BM = 256, BK = 64, HALF = 128, HTB = HALF * BK * 2, STAGE_BYTES = 8 * HTB, NXCD = 8, WGM = 8;
__host__ __device__ __forceinline__ int lds_byte(int r, int c) { const int st = (r >> 4) * 2 + (c >> 5), rr = r & 15, cc = c & 31, ob = rr * 64 + cc * 2; return st * 1024 + (ob ^ (((ob >> 9) & 1) << 5)); }
__host__ __device__ __forceinline__ void stage_rc(int b, int& R_, int& C_) { const int st = b / 1024, sb = b % 1024, swz = sb ^ (((sb >> 9) & 1) << 5); R_ = (st >> 1) * 16 + swz / 64; C_ = (st & 1) * 32 + (swz % 64) / 2; }
__host__ __device__ __forceinline__ int perm32(int rho) { const int n = rho >> 4, i = rho & 15; return 8 * (i >> 2) + 4 * n + (i & 3); }

struct Unit { int pm, pn, z; };
template <class T, class = void> struct HasPrep : std::false_type {};
template <class T> struct HasPrep<T, std::void_t<typename T::Prep>> : std::true_type {};

struct GridOrder {
    int nM, nN, nwg, G, c;
    __device__ __forceinline__ void init(int nM_, int nN_, int G_, int c_) { nM = nM_; nN = nN_; nwg = nM * nN; G = G_; c = c_; }
    __device__ __forceinline__ bool next2(int i, int& pm, int& pn) const {
        const int L = i * G + c; if (L >= nwg) return false;
        int wgid = L; { const int q = nwg / NXCD, r = nwg % NXCD, xcd = wgid % NXCD, off = wgid / NXCD; wgid = (xcd < r ? xcd * (q + 1) : r * (q + 1) + (xcd - r) * q) + off; }
        const int nig = WGM * nN, gid = wgid / nig, fm = gid * WGM, gsz = (nM - fm) < WGM ? (nM - fm) : WGM;
        pm = fm + ((wgid % nig) % gsz); pn = (wgid % nig) / gsz; return true;
    }
};

__device__ __forceinline__ const char* uniform_ptr(const char* p) { const unsigned long long v = (unsigned long long)p; const unsigned lo = (unsigned)__builtin_amdgcn_readfirstlane((int)(unsigned)v), hi = (unsigned)__builtin_amdgcn_readfirstlane((int)(unsigned)(v >> 32)); return (const char*)(((unsigned long long)hi << 32) | lo); }
typedef int i32x4 __attribute__((ext_vector_type(4)));
typedef int i32x8 __attribute__((ext_vector_type(8)));
constexpr int FP8_WSHIFT = 8;
constexpr int FP8_SCALE_W = 0x7f7f7f7f, FP8_SCALE_A = 0x7f7f7f7f;
constexpr float FP8_WINV = 1.0f / (float)(1 << FP8_WSHIFT);
#if !NAIVE_GEMM
template <bool FP8, class F, class Sched, bool I8 = false>
__device__ __forceinline__ void gemm_phase(LAS unsigned char* lds, const unsigned char* wsb, const int wv, const int lda, const int ldb, const int nt, const Sched& S, const F& f) {
    constexpr int ES = (FP8 || I8) ? 1 : 2;
    const int tid = fresh_tid(wv), wid = __builtin_amdgcn_readfirstlane(tid >> 6), lane = tid & 63, wr = wid >> 2, wc = wid & 3, fr = lane & 15, fq = lane >> 4;
    unsigned voffA[2], voffB[2];
#pragma unroll
    for (int i = 0; i < 2; ++i) { int R_, C_; stage_rc(tid * 16 + i * 8192, R_, C_); const int Rb = (R_ & ~31) + perm32(R_ & 31);
        voffA[i] = (unsigned)(R_ * lda * ES + C_ * 2); voffB[i] = (unsigned)(Rb * ldb * ES + C_ * 2); }
    const unsigned kstep = (unsigned)(BK * 2);
    const unsigned hsA = (unsigned)(HALF * lda * ES), hsB = (unsigned)(HALF * ldb * ES);
    const __amdgpu_buffer_rsrc_t rsA = __builtin_amdgcn_make_buffer_rsrc((void*)wsb, 0, 0xffffffff, 0x00020000);
    const unsigned ldsw = (unsigned)wid * 1024u;
    const int aoff = lds_byte(wr * 64 + fr, fq * 8), boff = lds_byte(wc * 32 + fr, fq * 8);
#define PG8_SA(b, h) (((b) * 2 + (h)) * HTB)
#define PG8_SB(b, h) ((4 + (b) * 2 + (h)) * HTB)
#define PG8_STAGE(bufoff, goff, voff) do { _Pragma("unroll") for (int _i = 0; _i < 2; ++_i) \
        __builtin_amdgcn_raw_ptr_buffer_load_lds(PG8_RS_##voff, (LAS void*)(lds + (bufoff) + ldsw + _i * 8192), 16, (int)(voff)[_i], (int)(goff), 0, 0); } while (0)
#define PG8_RS_voffA rsA
#define PG8_RS_voffB rsA
#define PG8_LDA(dst, b, h) do { _Pragma("unroll") for (int m = 0; m < 4; ++m) _Pragma("unroll") for (int k = 0; k < 2; ++k) dst[m][k] = *(const LAS bf16x8*)(lds + PG8_SA(b, h) + aoff + m * 2048 + k * 1024); } while (0)
#define PG8_LDB(dst, b, h) do { _Pragma("unroll") for (int n = 0; n < 2; ++n) _Pragma("unroll") for (int k = 0; k < 2; ++k) dst[n][k] = *(const LAS bf16x8*)(lds + PG8_SB(b, h) + boff + n * 2048 + k * 1024); } while (0)
#define PG8_CAT8(x) __builtin_shufflevector(__builtin_bit_cast(i32x4, (x)[0]), __builtin_bit_cast(i32x4, (x)[1]), 0, 1, 2, 3, 4, 5, 6, 7)
#define PG8_MMA(ai, bj, At, Bt) do { __builtin_amdgcn_s_setprio(1); \
        if constexpr (FP8) { _Pragma("unroll") for (int m = 0; m < 4; ++m) _Pragma("unroll") for (int n = 0; n < 2; ++n) \
            acc[ai][bj][m][n] = __builtin_amdgcn_mfma_scale_f32_16x16x128_f8f6f4(PG8_CAT8(Bt[n]), PG8_CAT8(At[m]), acc[ai][bj][m][n], 0, 0, 0, FP8_SCALE_W, 0, FP8_SCALE_A); } \
        else if constexpr (I8) { _Pragma("unroll") for (int m = 0; m < 4; ++m) _Pragma("unroll") for (int n = 0; n < 2; ++n) _Pragma("unroll") for (int k = 0; k < 2; ++k) \
            acc[ai][bj][m][n] = __builtin_bit_cast(f32x4, __builtin_amdgcn_mfma_i32_16x16x64_i8(__builtin_bit_cast(i32x4, Bt[n][k]), __builtin_bit_cast(i32x4, At[m][k]), __builtin_bit_cast(i32x4, acc[ai][bj][m][n]), 0, 0, 0)); } \
        else { _Pragma("unroll") for (int m = 0; m < 4; ++m) _Pragma("unroll") for (int n = 0; n < 2; ++n) _Pragma("unroll") for (int k = 0; k < 2; ++k) \
            acc[ai][bj][m][n] = __builtin_amdgcn_mfma_f32_16x16x32_bf16(Bt[n][k], At[m][k], acc[ai][bj][m][n], 0, 0, 0); } \
        __builtin_amdgcn_s_setprio(0); } while (0)
#define PG8_WAIT_V(n) asm volatile("s_waitcnt vmcnt(" #n ")" ::: "memory")
#define PG8_WAIT_L(n) asm volatile("s_waitcnt lgkmcnt(" #n ")" ::: "memory")
#define PG8_BAR __builtin_amdgcn_s_barrier()
#define PG8_SCHED __builtin_amdgcn_sched_barrier(0)
    Unit cur, nxt; int ui = 0;
    if (!S.next(0, cur)) return;
    f32x4 acc[2][2][4][2];
#pragma unroll
    for (int a = 0; a < 2; ++a)
#pragma unroll
        for (int b = 0; b < 2; ++b)
#pragma unroll
            for (int m = 0; m < 4; ++m)
#pragma unroll
                for (int n = 0; n < 2; ++n) acc[a][b][m][n] = (f32x4){0.f, 0.f, 0.f, 0.f};
    bf16x8 At[4][2], B0[2][2], B1[2][2];
    unsigned cA, cB; { const char* pa; const char* pb; S.ptrs(cur, pa, pb); cA = (unsigned)__builtin_amdgcn_readfirstlane((int)(unsigned)(pa - (const char*)wsb)); cB = (unsigned)__builtin_amdgcn_readfirstlane((int)(unsigned)(pb - (const char*)wsb)); }
    PG8_STAGE(PG8_SB(0, 0), cB, voffB); PG8_STAGE(PG8_SB(0, 1), cB + hsB, voffB); PG8_STAGE(PG8_SA(0, 0), cA, voffA); PG8_STAGE(PG8_SA(0, 1), cA + hsA, voffA);
    if (wr == 1) PG8_BAR;
    PG8_WAIT_V(2); PG8_BAR;
    PG8_STAGE(PG8_SB(1, 0), cB + kstep, voffB); PG8_STAGE(PG8_SA(1, 0), cA + kstep, voffA); PG8_STAGE(PG8_SB(1, 1), cB + hsB + kstep, voffB);
    PG8_WAIT_V(6); PG8_BAR;
    for (;;) {
        const bool has_next = S.next(ui + 1, nxt);
        unsigned nA = cA, nB = cB; if (has_next) { const char* pa; const char* pb; S.ptrs(nxt, pa, pb); nA = (unsigned)__builtin_amdgcn_readfirstlane((int)(unsigned)(pa - (const char*)wsb)); nB = (unsigned)__builtin_amdgcn_readfirstlane((int)(unsigned)(pb - (const char*)wsb)); }
        for (int t = 0; t < nt; t += 2) {
            const bool last = (t == nt - 2);
            const unsigned a1 = cA + (unsigned)(t + 1) * kstep;
            const unsigned a2 = last ? nA : cA + (unsigned)(t + 2) * kstep, b2 = last ? nB : cB + (unsigned)(t + 2) * kstep;
            const unsigned a3 = a2 + kstep, b3 = b2 + kstep;
            PG8_LDB(B0, 0, 0); PG8_LDB(B1, 0, 1); PG8_SCHED; PG8_LDA(At, 0, 0); PG8_STAGE(PG8_SA(1, 1), a1 + hsA, voffA);
            PG8_WAIT_V(8); PG8_WAIT_L(0); PG8_BAR; PG8_MMA(0, 0, At, B0); PG8_MMA(0, 1, At, B1); PG8_BAR; PG8_SCHED;
            PG8_LDA(At, 0, 1); PG8_STAGE(PG8_SB(0, 0), b2, voffB); PG8_STAGE(PG8_SB(0, 1), b2 + hsB, voffB); PG8_STAGE(PG8_SA(0, 0), a2, voffA);
            PG8_WAIT_V(8); PG8_WAIT_L(0); PG8_BAR; PG8_MMA(1, 0, At, B0); PG8_MMA(1, 1, At, B1); PG8_BAR; PG8_SCHED;
            PG8_LDB(B0, 1, 0); PG8_LDB(B1, 1, 1); PG8_SCHED; PG8_LDA(At, 1, 0); PG8_STAGE(PG8_SA(0, 1), a2 + hsA, voffA);
            PG8_WAIT_V(8); PG8_WAIT_L(0); PG8_BAR; PG8_MMA(0, 0, At, B0); PG8_MMA(0, 1, At, B1); PG8_BAR; PG8_SCHED;
            PG8_LDA(At, 1, 1); PG8_STAGE(PG8_SB(1, 0), b3, voffB); PG8_STAGE(PG8_SB(1, 1), b3 + hsB, voffB); PG8_STAGE(PG8_SA(1, 0), a3, voffA);
            PG8_WAIT_V(8); PG8_WAIT_L(0); PG8_BAR; PG8_MMA(1, 0, At, B0); PG8_MMA(1, 1, At, B1); PG8_BAR; PG8_SCHED;
        }
        if (wr == 0) PG8_BAR;
        if constexpr (HasPrep<F>::value) { const auto pr_ = f.prep(cur, wc * 32 + 8 * fq, wr * 64 + fr);
#pragma unroll
        for (int ai = 0; ai < 2; ++ai)
#pragma unroll
            for (int m = 0; m < 4; ++m) {
                f32x4 a[2][2];
#pragma unroll
                for (int bj = 0; bj < 2; ++bj)
#pragma unroll
                    for (int n = 0; n < 2; ++n) { if constexpr (I8) a[bj][n] = __builtin_convertvector(__builtin_bit_cast(i32x4, acc[ai][bj][m][n]), f32x4); else a[bj][n] = acc[ai][bj][m][n]; }
                f.row(cur, ai * HALF + wr * 64 + m * 16 + fr, wc * 32 + 8 * fq, a, pr_, ai * 4 + m);
            }
        } else {
#pragma unroll
        for (int ai = 0; ai < 2; ++ai)
#pragma unroll
            for (int m = 0; m < 4; ++m) {
                f32x4 a[2][2];
#pragma unroll
                for (int bj = 0; bj < 2; ++bj)
#pragma unroll
                    for (int n = 0; n < 2; ++n) { if constexpr (I8) a[bj][n] = __builtin_convertvector(__builtin_bit_cast(i32x4, acc[ai][bj][m][n]), f32x4); else a[bj][n] = acc[ai][bj][m][n]; }
                f.row(cur, ai * HALF + wr * 64 + m * 16 + fr, wc * 32 + 8 * fq, a);
            }
        }
        if (!has_next) break;
#pragma unroll
        for (int a = 0; a < 2; ++a)
#pragma unroll
            for (int b = 0; b < 2; ++b)
#pragma unroll
                for (int m = 0; m < 4; ++m)
#pragma unroll
                    for (int n = 0; n < 2; ++n) acc[a][b][m][n] = (f32x4){0.f, 0.f, 0.f, 0.f};
        cur = nxt; cA = nA; cB = nB; ++ui;
        if (wr == 1) PG8_BAR;
    }
    PG8_WAIT_V(0);
    PG8_BAR;
#undef PG8_SA
#undef PG8_SB
#undef PG8_STAGE
#undef PG8_RS_voffA
#undef PG8_RS_voffB
#undef PG8_LDA
#undef PG8_LDB
#undef PG8_MMA
#undef PG8_CAT8
#undef PG8_WAIT_V
#undef PG8_WAIT_L
#undef PG8_BAR
#undef PG8_SCHED
}
#else
__device__ __forceinline__ float fp8_to_f(unsigned b) { const unsigned e = (b >> 3) & 15u, m = b & 7u; const float v = e ? __uint_as_float(((e + 120u) << 23) | (m << 20)) : (float)m * 0.001953125f; return (b & 128u) ? -v : v; }
template <bool FP8, class F, class Sched, bool I8 = false>
__device__ __forceinline__ void gemm_phase(LAS unsigned char* lds, const unsigned char* wsb, const int wv, const int lda, const int ldb, const int nt_, const Sched& S, const F& f) {
    const int nt = (FP8 || I8) ? nt_ * 2 : nt_;
    const int tid = fresh_tid(wv);
    LAS float* As = (LAS float*)lds;
    LAS float* Bs = As + 64 * 65;
    Unit u;
    for (int i = 0; S.next(i, u); ++i) {
        const char* cA; const char* cB; S.ptrs(u, cA, cB);
        const bf16_t* A = (const bf16_t*)cA; const bf16_t* B = (const bf16_t*)cB; const unsigned char* A8 = (const unsigned char*)cA; const unsigned char* B8 = (const unsigned char*)cB;
        for (int sub = 0; sub < 8; ++sub) {
            const int r0 = (sub >> 1) * 64, c0 = (sub & 1) * 64;
            float acc[2][8];
#pragma unroll
            for (int b = 0; b < 2; ++b)
#pragma unroll
                for (int j = 0; j < 8; ++j) acc[b][j] = 0.f;
            const int tr = tid >> 3, tc = (tid & 7) * 8;
            for (int kt = 0; kt < nt; ++kt) {
                __syncthreads();
                for (int e = tid; e < 4096; e += 512) { const int rr = e >> 6, kk = e & 63;
                    if constexpr (I8) {
                    As[rr * 65 + kk] = (float)(signed char)A8[(size_t)(r0 + rr) * lda + kt * 64 + kk];
                    Bs[rr * 65 + kk] = (float)(signed char)B8[(size_t)(c0 + rr) * ldb + kt * 64 + kk];
                    Bs[(64 + rr) * 65 + kk] = (float)(signed char)B8[(size_t)(128 + c0 + rr) * ldb + kt * 64 + kk]; } else
                    if constexpr (FP8) {
                    As[rr * 65 + kk] = fp8_to_f(A8[(size_t)(r0 + rr) * lda + kt * 64 + kk]);
                    Bs[rr * 65 + kk] = fp8_to_f(B8[(size_t)(c0 + rr) * ldb + kt * 64 + kk]);
                    Bs[(64 + rr) * 65 + kk] = fp8_to_f(B8[(size_t)(128 + c0 + rr) * ldb + kt * 64 + kk]); } else {
                    As[rr * 65 + kk] = bf2f(A[(size_t)(r0 + rr) * lda + kt * 64 + kk]);
                    Bs[rr * 65 + kk] = bf2f(B[(size_t)(c0 + rr) * ldb + kt * 64 + kk]);
                    Bs[(64 + rr) * 65 + kk] = bf2f(B[(size_t)(128 + c0 + rr) * ldb + kt * 64 + kk]); } }
                __syncthreads();
                for (int kk = 0; kk < 64; ++kk) { const float a = As[tr * 65 + kk];
#pragma unroll
                    for (int j = 0; j < 8; ++j) { acc[0][j] += a * Bs[(tc + j) * 65 + kk]; acc[1][j] += a * Bs[(64 + tc + j) * 65 + kk]; } }
            }
            f32x4 a[2][2];
#pragma unroll
            for (int b = 0; b < 2; ++b) { a[b][0] = (f32x4){acc[b][0], acc[b][1], acc[b][2], acc[b][3]}; a[b][1] = (f32x4){acc[b][4], acc[b][5], acc[b][6], acc[b][7]}; }
            f.row(u, r0 + tr, c0 + tc, a);
        }
    }
    __syncthreads();
}
#endif
}

struct Args { const float* in[27]; float* out; unsigned char* ws; };
typedef __attribute__((address_space(4))) const char* kaddr_t;
__device__ __forceinline__ const float* in_ptr(int i) { kaddr_t k = (kaddr_t)__builtin_amdgcn_kernarg_segment_ptr(); asm volatile("" : "+s"(k)); return (const float*)*(__attribute__((address_space(4))) const unsigned long long*)(k + 8 * i); }
struct Frame {
    LAS unsigned char* lds;
    unsigned* ctl;
    unsigned char* ws;
    int vcu, G, wv;
    float* out;
};

__device__ __forceinline__ int fresh_tid(int wv) { int l; asm volatile("v_mbcnt_lo_u32_b32 %0, -1, 0\n\tv_mbcnt_hi_u32_b32 %0, -1, %0" : "=v"(l)); return wv * 64 + l; }
#define PHASE_IDS() const int tid = fresh_tid(F.wv); const int lane = tid & 63; const int wave = __builtin_amdgcn_readfirstlane(tid >> 6); (void)tid; (void)lane; (void)wave
__device__ __forceinline__ int row_t(int row) { return row % TPB; }
__device__ __forceinline__ int row_b(int row) { return row / TPB; }
__device__ __forceinline__ int row_modidx(int row) { return (row % TPB) < CTXL ? 2 : row / TPB; }

__device__ __forceinline__ const float* modp(const Frame& F, int l, int mi, int which) { return (const float*)(F.ws + WS_MOD) + ((size_t)(l * 3 + mi) * 6 + which) * DM; }

struct EpiG1 {
    bf16_t* P; const float* bgate; const float* ropec; const float* ropes; const float* hsc = nullptr; const float* wsc = nullptr;
    struct Prep { f32x4 s[2][2]; float hs[8]; };
    __device__ __forceinline__ Prep prep(const pg8::Unit& u, int cit, int rbase) const { Prep p;
#pragma unroll
        for (int bj = 0; bj < 2; ++bj) { const int col = u.pn * 256 + bj * 128 + cit;
            if (wsc) { p.s[bj][0] = *(const f32x4*)(wsc + col); p.s[bj][1] = *(const f32x4*)(wsc + col + 4); } else { p.s[bj][0] = (f32x4){1.f, 1.f, 1.f, 1.f}; p.s[bj][1] = p.s[bj][0]; } }
#pragma unroll
        for (int k = 0; k < 8; ++k) p.hs[k] = wsc ? hsc[u.pm * 256 + rbase + (k >> 2) * 128 + (k & 3) * 16] : 1.0f;
        return p; }
    __device__ __forceinline__ void row(const pg8::Unit& u, int rit, int cit, const f32x4 (&a)[2][2], const Prep& pp, int k) const {
        const int grow = u.pm * 256 + rit;
        const float hs = pp.hs[k];
#pragma unroll
        for (int bj = 0; bj < 2; ++bj) {
            const int col = u.pn * 256 + bj * 128 + cit;
            if (u.pn == 24 && col >= CKR + 64) continue;
            float v[8] = {a[bj][0][0], a[bj][0][1], a[bj][0][2], a[bj][0][3], a[bj][1][0], a[bj][1][1], a[bj][1][2], a[bj][1][3]};
            if (wsc) { const f32x4 s0 = pp.s[bj][0], s1 = pp.s[bj][1];
                v[0] *= hs * s0[0]; v[1] *= hs * s0[1]; v[2] *= hs * s0[2]; v[3] *= hs * s0[3]; v[4] *= hs * s1[0]; v[5] *= hs * s1[1]; v[6] *= hs * s1[2]; v[7] *= hs * s1[3]; }
            if (u.pn >= 8 && u.pn < 24) {
                const f32x4 b0 = *(const f32x4*)(bgate + col - CGATE), b1 = *(const f32x4*)(bgate + col - CGATE + 4);
                v[0] = sigmoidf_(v[0] + b0[0]); v[1] = sigmoidf_(v[1] + b0[1]); v[2] = sigmoidf_(v[2] + b0[2]); v[3] = sigmoidf_(v[3] + b0[3]);
                v[4] = sigmoidf_(v[4] + b1[0]); v[5] = sigmoidf_(v[5] + b1[1]); v[6] = sigmoidf_(v[6] + b1[2]); v[7] = sigmoidf_(v[7] + b1[3]);
            } else if (u.pn == 24) {
                if (col >= CKR + 64) continue;
                const int t = grow % TPB;
                if (t >= CTXL) { const int s = t - CTXL, i0 = (col - CKR) >> 1;
                    const f32x4 cs = *(const f32x4*)(ropec + s * 32 + i0), sn = *(const f32x4*)(ropes + s * 32 + i0);
#pragma unroll
                    for (int p = 0; p < 4; ++p) { const float x1 = v[2 * p], x2 = v[2 * p + 1]; v[2 * p] = x1 * cs[p] - x2 * sn[p]; v[2 * p + 1] = x1 * sn[p] + x2 * cs[p]; } }
            }
            *(u32x4*)(P + (size_t)grow * INWP + col) = pack8(v);
        }
    }
};
struct EpiQ {
    bf16_t* Q; const float* ropec; const float* ropes;
    __device__ __forceinline__ void row(const pg8::Unit& u, int rit, int cit, const f32x4 (&a)[2][2]) const {
        const int grow = u.pm * 256 + rit; const int t = grow % TPB;
#pragma unroll
        for (int bj = 0; bj < 2; ++bj) {
            const int col = u.pn * 256 + bj * 128 + cit, d = col % DQK;
            float v[8] = {a[bj][0][0], a[bj][0][1], a[bj][0][2], a[bj][0][3], a[bj][1][0], a[bj][1][1], a[bj][1][2], a[bj][1][3]};
            if (d >= DN && t >= CTXL) { const int s = t - CTXL, i0 = (d - DN) >> 1;
                const f32x4 cs = *(const f32x4*)(ropec + s * 32 + i0), sn = *(const f32x4*)(ropes + s * 32 + i0);
#pragma unroll
                for (int p = 0; p < 4; ++p) { const float x1 = v[2 * p], x2 = v[2 * p + 1]; v[2 * p] = x1 * cs[p] - x2 * sn[p]; v[2 * p + 1] = x1 * sn[p] + x2 * cs[p]; } }
            *(u32x4*)(Q + (size_t)grow * 3072 + col) = pack8(v);
        }
    }
};
struct EpiKV {
    bf16_t* KN; bf16_t* V;
    __device__ __forceinline__ void row(const pg8::Unit& u, int rit, int cit, const f32x4 (&a)[2][2]) const {
        const int grow = u.pm * 256 + rit;
#pragma unroll
        for (int bj = 0; bj < 2; ++bj) {
            float v[8] = {a[bj][0][0], a[bj][0][1], a[bj][0][2], a[bj][0][3], a[bj][1][0], a[bj][1][1], a[bj][1][2], a[bj][1][3]};
            bf16_t* dst = (bj == 0 ? KN : V) + (size_t)grow * 2048 + u.pn * 128 + cit;
            *(u32x4*)dst = pack8(v);
        }
    }
};
struct EpiPool {
    bf16_t* POOLM; const bf16_t* P; const float* pscale;
    __device__ __forceinline__ void row(const pg8::Unit& u, int rit, int cit, const f32x4 (&a)[2][2]) const {
        const int grow = u.pm * 256 + rit;
#pragma unroll
        for (int bj = 0; bj < 2; ++bj) {
            const int col = u.pn * 256 + bj * 128 + cit;
            float v[8] = {a[bj][0][0], a[bj][0][1], a[bj][0][2], a[bj][0][3], a[bj][1][0], a[bj][1][1], a[bj][1][2], a[bj][1][3]};
            float g[8]; unpack8(*(const u32x4*)(P + (size_t)grow * INWP + CGATE + 2048 + col), g);
            const f32x4 s0 = *(const f32x4*)(pscale + col), s1 = *(const f32x4*)(pscale + col + 4);
            v[0] *= s0[0] * g[0]; v[1] *= s0[1] * g[1]; v[2] *= s0[2] * g[2]; v[3] *= s0[3] * g[3];
            v[4] *= s1[0] * g[4]; v[5] *= s1[1] * g[5]; v[6] *= s1[2] * g[6]; v[7] *= s1[3] * g[7];
            *(u32x4*)(POOLM + (size_t)grow * 2048 + col) = pack8(v);
        }
    }
};
struct EpiPlain {
    bf16_t* O; int ldc;
    __device__ __forceinline__ void row(const pg8::Unit& u, int rit, int cit, const f32x4 (&a)[2][2]) const {
        const int grow = u.pm * 256 + rit;
#pragma unroll
        for (int bj = 0; bj < 2; ++bj) {
            const int col = u.pn * 256 + bj * 128 + cit;
            float v[8] = {a[bj][0][0], a[bj][0][1], a[bj][0][2], a[bj][0][3], a[bj][1][0], a[bj][1][1], a[bj][1][2], a[bj][1][3]};
            *(u32x4*)(O + (size_t)grow * ldc + col) = pack8(v);
        }
    }
};
struct EpiSwiglu {
    bf16_t* ACT;
    __device__ __forceinline__ void row(const pg8::Unit& u, int rit, int cit, const f32x4 (&a)[2][2]) const {
        const int grow = u.pm * 256 + rit;
        float v[8];
#pragma unroll
        for (int n = 0; n < 2; ++n)
#pragma unroll
            for (int j = 0; j < 4; ++j) { const float g = a[0][n][j], up = a[1][n][j]; v[n * 4 + j] = g * sigmoidf_(g) * up; }
        *(u32x4*)((char*)ACT + (unsigned)(grow * DFF + u.pn * 128 + cit) * 2u) = pack8(v);
    }
};
struct EpiSwigluI8 {
    unsigned char* ws;
    struct Prep { f32x4 g0, g1, u0, u1; float hs[8]; };
    __device__ __forceinline__ Prep prep(const pg8::Unit& u, int cit, int rbase) const { const float* wg = (const float*)(ws + WS_WSC) + u.pn * 128 + cit; const float* wu = wg + DFF;
        Prep p; p.g0 = *(const f32x4*)wg; p.g1 = *(const f32x4*)(wg + 4); p.u0 = *(const f32x4*)wu; p.u1 = *(const f32x4*)(wu + 4);
        const float* hp = (const float*)(ws + WS_HSC) + u.pm * 256 + rbase;
#pragma unroll
        for (int k = 0; k < 8; ++k) p.hs[k] = hp[(k >> 2) * 128 + (k & 3) * 16];
        return p; }
    __device__ __forceinline__ void row(const pg8::Unit& u, int rit, int cit, const f32x4 (&a)[2][2], const Prep& pp, int k) const {
        const int grow = u.pm * 256 + rit, col = u.pn * 128 + cit;
        const float hs = pp.hs[k];
        const f32x4 g0 = pp.g0, g1 = pp.g1, u0 = pp.u0, u1 = pp.u1;
        float v[8];
#pragma unroll
        for (int j = 0; j < 4; ++j) { const float g = a[0][0][j] * (hs * g0[j]), up = a[1][0][j] * (hs * u0[j]); v[j] = g * sigmoidf_(g) * up; }
#pragma unroll
        for (int j = 0; j < 4; ++j) { const float g = a[0][1][j] * (hs * g1[j]), up = a[1][1][j] * (hs * u1[j]); v[4 + j] = g * sigmoidf_(g) * up; }
        *(u32x4*)(ws + WS_ACT + (unsigned)(grow * DFF + col) * 2u) = pack8(v);
    }
};
struct EpiSwiglu8 {
    unsigned char* ws;
    __device__ __forceinline__ void row(const pg8::Unit& u, int rit, int cit, const f32x4 (&a)[2][2]) const {
        const int grow = u.pm * 256 + rit;
        float v[8];
#pragma unroll
        for (int n = 0; n < 2; ++n)
#pragma unroll
            for (int j = 0; j < 4; ++j) { const float g = a[0][n][j] * pg8::FP8_WINV, up = a[1][n][j] * pg8::FP8_WINV; v[n * 4 + j] = g * sigmoidf_(g) * up; }
        u32x2 w; w.x = cvt4_fp8(v[0], v[1], v[2], v[3]); w.y = cvt4_fp8(v[4], v[5], v[6], v[7]);
        *(u32x2*)(ws + WS_ACT + (unsigned)(grow * DFF + u.pn * 128 + cit)) = w;
    }
};
struct EpiDown {
    unsigned char* ws; unsigned zstride; float sc;
    __device__ __forceinline__ void row(const pg8::Unit& u, int rit, int cit, const f32x4 (&a)[2][2]) const {
        const int grow = u.pm * 256 + rit;
#pragma unroll
        for (int bj = 0; bj < 2; ++bj) {
            float v[8] = {a[bj][0][0] * sc, a[bj][0][1] * sc, a[bj][0][2] * sc, a[bj][0][3] * sc, a[bj][1][0] * sc, a[bj][1][1] * sc, a[bj][1][2] * sc, a[bj][1][3] * sc};
            *(u32x4*)((char*)(ws + WS_Y2) + ((unsigned)u.z * zstride + (unsigned)(grow * DM + u.pn * 256 + bj * 128 + cit)) * 2u) = pack8(v);
        }
    }
};

struct SchedDense {
    pg8::GridOrder o; const char* A; const char* B; size_t lda2, ldb2;
    bool lat_only = false;
    __device__ __forceinline__ bool next(int i, pg8::Unit& u) const { u.z = 0; if (!o.next2(i, u.pm, u.pn)) return false; if (lat_only) u.pm += 1 + (u.pm >= 16 ? 1 : 0); return true; }
    __device__ __forceinline__ void ptrs(const pg8::Unit& u, const char*& a, const char*& b) const { a = A + (size_t)u.pm * 256 * lda2; b = B + (size_t)u.pn * 256 * ldb2; }
};
struct SchedG1Last {
    pg8::GridOrder o; const char* A; const char* B; int es = 2;
    __device__ __forceinline__ bool next(int i, pg8::Unit& u) const { u.z = 0;
        if (o.next2(i, u.pm, u.pn)) { u.pm += 1 + (u.pm >= 16 ? 1 : 0); return true; }
        const int k = i * o.G + o.c - o.nwg; if (k < 0 || k >= 6) return false;
        u.pm = (k / 3) * 17; u.pn = (k % 3) == 2 ? 24 : 2 + (k % 3); return true; }
    __device__ __forceinline__ void ptrs(const pg8::Unit& u, const char*& a, const char*& b) const { a = A + (size_t)u.pm * 256 * DM * es; b = B + (size_t)u.pn * 256 * DM * es; }
};
struct SchedPool {
    pg8::GridOrder o; const char* A; const char* B;
    __device__ __forceinline__ bool next(int i, pg8::Unit& u) const { u.z = 0; return o.next2(i, u.pm, u.pn); }
    __device__ __forceinline__ void ptrs(const pg8::Unit& u, const char*& a, const char*& b) const { a = A + ((size_t)u.pm * 256 * POOLW + (size_t)(u.pn >> 1) * 256) * 2; b = B + (size_t)u.pn * 256 * 256 * 2; }
};
struct SchedSplitK {
    pg8::GridOrder o; const char* A; const char* B; int nN;
    __device__ __forceinline__ bool next(int i, pg8::Unit& u) const { int pn2; if (!o.next2(i, u.pm, pn2)) return false; u.pn = pn2 % nN; u.z = pn2 / nN; return true; }
    __device__ __forceinline__ void ptrs(const pg8::Unit& u, const char*& a, const char*& b) const { a = A + ((size_t)u.pm * 256 * DFF + (size_t)u.z * KSPL) * 2; b = B + ((size_t)u.pn * 256 * DFF + (size_t)u.z * KSPL) * 2; }
};
struct SchedCtxSplit {
    pg8::GridOrder o; const char* A; const char* B; size_t lda2, ldb2; int nN; unsigned ksb;
    __device__ __forceinline__ bool next(int i, pg8::Unit& u) const { int c, pn2; if (!o.next2(i, c, pn2)) return false; u.pm = c * 17; u.pn = pn2 % nN; u.z = pn2 / nN; return true; }
    __device__ __forceinline__ void ptrs(const pg8::Unit& u, const char*& a, const char*& b) const { a = A + (size_t)u.pm * 256 * lda2 + (size_t)u.z * ksb; b = B + (size_t)u.pn * 256 * ldb2 + (size_t)u.z * ksb; }
};
struct EpiCtxPart {
    unsigned char* ws;
    __device__ __forceinline__ void row(const pg8::Unit& u, int rit, int cit, const f32x4 (&a)[2][2]) const {
        const int crow = (u.pm ? CTXL : 0) + rit;
#pragma unroll
        for (int bj = 0; bj < 2; ++bj) {
            float* dst = (float*)(ws + WS_YC + ((unsigned)(u.z * (NB * CTXL) + crow) * DM + (unsigned)(u.pn * 256 + bj * 128 + cit)) * 4u);
            *(f32x4*)dst = a[bj][0]; *(f32x4*)(dst + 4) = a[bj][1];
        }
    }
};
struct MoeTiles { const volatile LAS int* tb; int total;
    __device__ __forceinline__ int get(int k) const { return __builtin_amdgcn_readfirstlane(tb[k]); } };
__device__ __forceinline__ int moe_expert_of(const MoeTiles& mt, int pm) { int e = 0;
#pragma unroll
    for (int k = 1; k < NE; ++k) e += (pm >= mt.get(k)) ? 1 : 0;
    return e; }
constexpr int MOE_ES = MOE_FP8 ? 1 : 2;
struct SchedMoeUp {
    pg8::GridOrder o; MoeTiles mt; const char* A; const char* B;
    __device__ __forceinline__ bool next(int i, pg8::Unit& u) const { u.z = 0; return o.next2(i, u.pm, u.pn); }
    __device__ __forceinline__ void ptrs(const pg8::Unit& u, const char*& a, const char*& b) const { const int e = moe_expert_of(mt, u.pm);
#if MOE_DIRECT
        a = A + ((size_t)e * NLAT + (size_t)(u.pm - mt.get(e)) * 256) * DM;
#else
        a = A + (size_t)u.pm * 256 * DM * MOE_ES;
#endif
        b = B + (size_t)e * SZ_WGU + (size_t)u.pn * 256 * DM * MOE_ES; }
};
struct SchedMoeDown {
    pg8::GridOrder o; MoeTiles mt; const char* A; const char* B; int nN;
    __device__ __forceinline__ bool next(int i, pg8::Unit& u) const { int pn2; if (!o.next2(i, u.pm, pn2)) return false; u.pn = pn2 % nN; u.z = pn2 / nN; return true; }
    __device__ __forceinline__ void ptrs(const pg8::Unit& u, const char*& a, const char*& b) const { const int e = moe_expert_of(mt, u.pm);
        a = A + ((size_t)u.pm * 256 * DFF + (size_t)u.z * KSPL) * MOE_ES; b = B + (size_t)e * SZ_WD + ((size_t)u.pn * 256 * DFF + (size_t)u.z * KSPL) * MOE_ES; }
};

namespace att {
constexpr int NW = 8, QBLK = 32, KVBLK = 64;
constexpr int LDQ = 3072, LDKN = 2048, LDKR = INWP, LDV = 2048;
constexpr int SHM_V = 16384, SHM_KN = 16384, SHM_KR = 8192;
constexpr int OFF_V = 0, OFF_KN = 2 * SHM_V, OFF_KR = OFF_KN + 2 * SHM_KN, OFF_WS = OFF_KR + 2 * SHM_KR, OFF_QR = OFF_WS + NW * 64 * 4, ATT_LDS = OFF_QR + NW * 4096;
constexpr float THR = 8.f;
struct Out { unsigned char* ws;
    __device__ __forceinline__ void put(int grow, int hcol, float val) const {
        const bf16_t* P = (const bf16_t*)(ws + WS_P); const bf16_t* POOLM = (const bf16_t*)(ws + WS_POOLM); bf16_t* MB = (bf16_t*)(ws + WS_MB);
        const unsigned op = ((unsigned)grow * INWP + CGATE + hcol) * 2u, om = ((unsigned)grow * 2048u + hcol) * 2u;
        const float ga = bf2f(*(const bf16_t*)((const char*)P + op)), pm = bf2f(*(const bf16_t*)((const char*)POOLM + om));
        *(bf16_t*)((char*)MB + om) = (bf16_t)f2bf(ga * val + pm);
    }
};
#if !NAIVE_ATTN
#define KSWZ(row, colB) ((row) * 256 + ((colB) ^ (((row) & 15) << 4)))
#define KRSWZ(row, ch) ((row) * 128 + ((((ch) ^ (((row) >> 1) & 7))) << 4))
#define SBAR() __builtin_amdgcn_sched_barrier(0)
__device__ __forceinline__ int crow(int r, int hi) { return (r & 3) + 8 * (r >> 2) + 4 * hi; }
__device__ __forceinline__ void partialSM(f32x16& p0, f32x16& p1, float& m_reg, float& mn, float& alpha) {
    constexpr float C = ATTN_SCALE * 1.4426950408889634f;
    float pmax = p0[0];
#pragma unroll
    for (int r = 1; r < 16; ++r) pmax = fmaxf(pmax, p0[r]);
#pragma unroll
    for (int r = 0; r < 16; ++r) pmax = fmaxf(pmax, p1[r]);
    { auto rr = __builtin_amdgcn_permlane32_swap(__float_as_uint(pmax), __float_as_uint(pmax), false, false);
      pmax = fmaxf(__uint_as_float(rr[0]), __uint_as_float(rr[1])); }
    if (__builtin_expect(__all(pmax - m_reg <= THR / ATTN_SCALE), 1)) { mn = m_reg; alpha = 1.f; }
    else { mn = fmaxf(m_reg, pmax); alpha = __builtin_amdgcn_exp2f((m_reg - mn) * C); m_reg = mn; }
    const float mnC = -mn * C;
#pragma unroll
    for (int r = 0; r < 16; ++r) p0[r] = fmaf(p0[r], C, mnC);
#pragma unroll
    for (int r = 0; r < 16; ++r) p1[r] = fmaf(p1[r], C, mnC);
#pragma unroll
    for (int r = 0; r < 16; ++r) p0[r] = __builtin_amdgcn_exp2f(p0[r]);
}
__device__ __forceinline__ void finishSM(f32x16& p0, f32x16& p1, float alpha, float& l_reg, bf16x8& pa0, bf16x8& pa1, bf16x8& pa2, bf16x8& pa3) {
#pragma unroll
    for (int r = 0; r < 16; ++r) p1[r] = __builtin_amdgcn_exp2f(p1[r]);
    float ps = 0;
#pragma unroll
    for (int r = 0; r < 16; ++r) ps += p0[r];
#pragma unroll
    for (int r = 0; r < 16; ++r) ps += p1[r];
    { auto rr = __builtin_amdgcn_permlane32_swap(__float_as_uint(ps), __float_as_uint(ps), false, false);
      ps = __uint_as_float(rr[0]) + __uint_as_float(rr[1]); }
    l_reg = l_reg * alpha + ps;
#define PK4(P_, BASE, OUT) do { unsigned a0 = cvt_pk_bf16(P_[BASE + 0], P_[BASE + 1]), a1 = cvt_pk_bf16(P_[BASE + 2], P_[BASE + 3]);   \
    unsigned b0 = cvt_pk_bf16(P_[BASE + 4], P_[BASE + 5]), b1 = cvt_pk_bf16(P_[BASE + 6], P_[BASE + 7]);                              \
    auto r0 = __builtin_amdgcn_permlane32_swap(a0, b0, false, false); auto r1 = __builtin_amdgcn_permlane32_swap(a1, b1, false, false); \
    u32x4 w = {r0[0], r1[0], r0[1], r1[1]}; OUT = *reinterpret_cast<bf16x8*>(&w); } while (0)
    PK4(p0, 0, pa0); PK4(p0, 8, pa1); PK4(p1, 0, pa2); PK4(p1, 8, pa3);
#undef PK4
}
__device__ __forceinline__ void kfrag(const char* Kn, const char* Kr, int d0, int r32, int hi, bf16x8& b0, bf16x8& b1) {
    if (d0 < 8) { const int cb = (d0 * 16 + hi * 8) * 2; b0 = *reinterpret_cast<const bf16x8*>(Kn + KSWZ(r32, cb)); b1 = *reinterpret_cast<const bf16x8*>(Kn + KSWZ(32 + r32, cb)); }
    else { const int ch = (d0 - 8) * 2 + hi; b0 = *reinterpret_cast<const bf16x8*>(Kr + KRSWZ(r32, ch)); b1 = *reinterpret_cast<const bf16x8*>(Kr + KRSWZ(32 + r32, ch)); }
}
struct NoPiece { __device__ __forceinline__ void operator()(int) const {} };
template <class PF>
__device__ __forceinline__ void qkt(f32x16& p0, f32x16& p1, const char* Kn, const char* Kr, const bf16x8* qr, int r32, int hi, const PF& piece) {
    p0 = f32x16{}; p1 = f32x16{};
    bf16x8 a0, a1, c0, c1, n0, n1;
    kfrag(Kn, Kr, 0, r32, hi, a0, a1); kfrag(Kn, Kr, 1, r32, hi, c0, c1);
#pragma unroll
    for (int d0 = 0; d0 < 12; ++d0) {
        if (d0 + 2 < 12) kfrag(Kn, Kr, d0 + 2, r32, hi, n0, n1);
        __builtin_amdgcn_sched_barrier(0);
        p0 = __builtin_amdgcn_mfma_f32_32x32x16_bf16(a0, qr[d0], p0, 0, 0, 0);
        p1 = __builtin_amdgcn_mfma_f32_32x32x16_bf16(a1, qr[d0], p1, 0, 0, 0);
        __builtin_amdgcn_sched_barrier(0);
        piece(d0);
        __builtin_amdgcn_sched_barrier(0);
        a0 = c0; a1 = c1; c0 = n0; c1 = n1;
    }
}
__device__ __forceinline__ int v_st(int k, int c) { const int kk = (k & ~0xC) | ((k & 4) << 1) | ((k & 8) >> 1); return ((kk >> 3) * 4 + (c >> 5)) * 512 + ((kk & 7) * 32 + (c & 31)) * 2; }
__device__ __forceinline__ int v_rd_base(int lane) { return ((lane & 3) << 3) | (((lane >> 2) & 3) << 6) | (((lane >> 4) & 1) << 5) | (((lane >> 5) & 1) << 8); }
constexpr int v_rd_off(int d0, int ks, int half) { return d0 * 512 + ks * 4096 + half * 2048; }
template <int OFF> __device__ __forceinline__ s16x4 tr_read(int vb) {
    s16x4 r; asm volatile("ds_read_b64_tr_b16 %0, %1 offset:%2" : "=&v"(r) : "v"(vb), "i"(OFF) : "memory"); return r;
}
template <int D0> __device__ __forceinline__ void pv_one(f32x16& od, int vb, bf16x8 pa0, bf16x8 pa1, bf16x8 pa2, bf16x8 pa3) {
    const s16x4 l0 = tr_read<v_rd_off(D0, 0, 0)>(vb), h0 = tr_read<v_rd_off(D0, 0, 1)>(vb), l1 = tr_read<v_rd_off(D0, 1, 0)>(vb), h1 = tr_read<v_rd_off(D0, 1, 1)>(vb);
    const s16x4 l2 = tr_read<v_rd_off(D0, 2, 0)>(vb), h2 = tr_read<v_rd_off(D0, 2, 1)>(vb), l3 = tr_read<v_rd_off(D0, 3, 0)>(vb), h3 = tr_read<v_rd_off(D0, 3, 1)>(vb);
    asm volatile("s_waitcnt lgkmcnt(0)" ::: "memory"); SBAR();
#define PK(L, H) (bf16x8){L[0], L[1], L[2], L[3], H[0], H[1], H[2], H[3]}
    od = __builtin_amdgcn_mfma_f32_32x32x16_bf16(pa0, PK(l0, h0), od, 0, 0, 0);
    od = __builtin_amdgcn_mfma_f32_32x32x16_bf16(pa1, PK(l1, h1), od, 0, 0, 0);
    od = __builtin_amdgcn_mfma_f32_32x32x16_bf16(pa2, PK(l2, h2), od, 0, 0, 0);
    od = __builtin_amdgcn_mfma_f32_32x32x16_bf16(pa3, PK(l3, h3), od, 0, 0, 0);
#undef PK
}
template <class PF>
__device__ __forceinline__ void pv_d0(f32x16* o, int vb, bf16x8 pa0, bf16x8 pa1, bf16x8 pa2, bf16x8 pa3, const PF& piece) {
    pv_one<0>(o[0], vb, pa0, pa1, pa2, pa3); SBAR(); piece(0); SBAR(); pv_one<1>(o[1], vb, pa0, pa1, pa2, pa3); SBAR(); piece(1); SBAR();
    pv_one<2>(o[2], vb, pa0, pa1, pa2, pa3); SBAR(); piece(2); SBAR(); pv_one<3>(o[3], vb, pa0, pa1, pa2, pa3); SBAR(); piece(3); SBAR();
}
constexpr int SLOTB = 40960, SL_V = 0, SL_KN = 16384, SL_KR = 32768, OFF_WS3 = 3 * SLOTB, ATT_LDS3 = OFF_WS3 + NW * 64 * 4;
constexpr int AC_JOBS = 18, AC_STRIPS_PER_JOB = (DM / 32) * (DFF / 32) / (8 * 32), AC_STRIPS = AC_JOBS * AC_STRIPS_PER_JOB, AC_STEPS = 32;
static_assert(AC_STRIPS_PER_JOB == 56 && AC_STRIPS <= 4 * 256 && 2 * AC_STEPS + 2 <= TPB / KVBLK - 2, "conversion strips fit the attention units' tile steps (one item per two steps)");
constexpr int AC_STG_HI = MISC_OFF + 1024;
static_assert(ATT_LDS3 + 4096 <= LDSCTL_OFF && AC_STG_HI + 7 * 4096 <= LDS_BYTES && AC_STG_HI % 16 == 0, "conversion staging blocks");
__device__ __forceinline__ void attn_unit(int qrow0, int krow0, int nkeys, int h, char* lds, LAS unsigned char* lds3, const Out& O, int wv, int ac_slot) {
    const bf16_t* __restrict__ Qg = (const bf16_t*)(O.ws + WS_Q);
    const int tid = fresh_tid(wv), wid = __builtin_amdgcn_readfirstlane(tid >> 6), lane = tid & 63, r32 = lane & 31, hi = lane >> 5;
    float* ws = (float*)(lds + OFF_WS3) + wid * 64; float* li_l = ws; float* al_l = ws + 32;
    float m_reg = -1e30f, l_reg = 0; f32x16 o[4] = {}; bf16x8 qr[12];
    { const char* Qb = (const char*)(Qg + (size_t)(qrow0 + wid * QBLK) * LDQ + h * DQK); const unsigned qo = (unsigned)(r32 * LDQ + hi * 8) * 2u;
#pragma unroll
      for (int d0 = 0; d0 < 12; ++d0) qr[d0] = *reinterpret_cast<const bf16x8*>(Qb + qo + d0 * 32); }
    unsigned vofV[1], vofK[1], vofR;
#pragma unroll
    for (int i = 0; i < 1; ++i) { const int p = (i * 8 + wid) * 1024 + lane * 16;
        { const int sub = p >> 9, kkh = sub >> 2, ch = sub & 3, within = p & 511, kkl = within >> 6, cl = (within & 63) >> 1, kk = kkh * 8 + kkl;
          const int k = (kk & ~0xC) | ((kk & 4) << 1) | ((kk & 8) >> 1), c = ch * 32 + cl; vofV[i] = (unsigned)(k * LDV + c) * 2u; }
        { const int row = p >> 8, cs = (p & 255) >> 4, c16 = cs ^ (row & 15); vofK[i] = (unsigned)(row * LDKN + c16 * 8) * 2u; } }
    { const int p = wid * 1024 + lane * 16, row = p >> 7, cs = (p & 127) >> 4, chh = cs ^ ((row >> 1) & 7); vofR = (unsigned)(row * LDKR + chh * 8) * 2u; }
    const __amdgpu_buffer_rsrc_t rs = __builtin_amdgcn_make_buffer_rsrc((void*)O.ws, 0, 0xffffffff, 0x00020000);
    const unsigned sV0 = (unsigned)(WS_V + ((size_t)krow0 * LDV + h * DV) * 2), sK0 = (unsigned)(WS_KN + ((size_t)krow0 * LDKN + h * DN) * 2), sR0 = (unsigned)(WS_P + ((size_t)krow0 * LDKR + CKR) * 2);
#define DMA(t, slot) do { const unsigned tv_ = sV0 + (unsigned)(t) * (KVBLK * LDV * 2), tk_ = sK0 + (unsigned)(t) * (KVBLK * LDKN * 2), tr_ = sR0 + (unsigned)(t) * (KVBLK * LDKR * 2); \
    _Pragma("unroll") for (int i_ = 0; i_ < 2; ++i_) __builtin_amdgcn_raw_ptr_buffer_load_lds(rs, (LAS void*)(lds3 + (slot) + SL_V + (i_ * 8 + wid) * 1024), 16, (int)vofV[0], (int)(tv_ + (unsigned)i_ * (32u * LDV * 2u)), 0, 0); \
    _Pragma("unroll") for (int i_ = 0; i_ < 2; ++i_) __builtin_amdgcn_raw_ptr_buffer_load_lds(rs, (LAS void*)(lds3 + (slot) + SL_KN + (i_ * 8 + wid) * 1024), 16, (int)vofK[0], (int)(tk_ + (unsigned)i_ * (32u * LDKN * 2u)), 0, 0); \
    __builtin_amdgcn_raw_ptr_buffer_load_lds(rs, (LAS void*)(lds3 + (slot) + SL_KR + wid * 1024), 16, (int)vofR, (int)tr_, 0, 0); } while (0)
#define LANDED() do { asm volatile("s_waitcnt vmcnt(0)" ::: "memory"); __syncthreads(); } while (0)
#define RESC(a) do { if (__any((a) < 1.f)) { if (hi == 0) al_l[r32] = (a); asm volatile("s_waitcnt lgkmcnt(0)" ::: "memory"); \
    _Pragma("unroll") for (int d = 0; d < 4; ++d) _Pragma("unroll") for (int r = 0; r < 16; ++r) o[d][r] *= al_l[crow(r, hi)]; } } while (0)
#define ROT3() do { const int t_ = s_prev; s_prev = s_cur; s_cur = s_next; s_next = t_; } while (0)
    const int vbl = (int)(uintptr_t)lds + SL_V + v_rd_base(lane);
    f32x16 pA0, pA1, pB0, pB1; float mnA, mnB, alA, alB; bf16x8 pa0, pa1, pa2, pa3; const int NT = nkeys / KVBLK;
    int s_prev = 0, s_cur = SLOTB, s_next = 2 * SLOTB;
    int ac_left = 0, ac_pend = 0, ac_N = DFF, ac_K = DM, ac_t = 0; unsigned ac_src = 0, ac_dst = 0;
    { const int sl = __builtin_amdgcn_readfirstlane(ac_slot);
      if (sl >= 0 && sl < AC_STRIPS) { const int jb = sl / AC_STRIPS_PER_JOB, r = sl - jb * AC_STRIPS_PER_JOB, e = jb / 3; ac_t = jb - e * 3;
          if (ac_t < 2) { const int kh = r / (DFF / 256), ns = r - kh * (DFF / 256), n0 = (ns * 8 + wid) * 32, k0 = kh * (AC_STEPS * 32);
              ac_src = (unsigned)e * (unsigned)(DM * DFF * 4) + ((unsigned)k0 * (unsigned)DFF + (unsigned)n0) * 4u;
              ac_dst = (unsigned)(WS_WEGU + (size_t)e * SZ_WGU) + (unsigned)((n0 >> 7) * 256 + ac_t * 128 + (n0 & 127)) * (unsigned)DM + (unsigned)k0; }
          else { const int part = r >> 3, ns = r & 7, n0 = (ns * 8 + wid) * 32, k0 = part * (AC_STEPS * 32); ac_N = DM; ac_K = DFF;
              ac_src = (unsigned)e * (unsigned)(DM * DFF * 4) + ((unsigned)k0 * (unsigned)DM + (unsigned)n0) * 4u;
              ac_dst = (unsigned)(WS_WED + (size_t)e * SZ_WD) + (unsigned)n0 * (unsigned)DFF + (unsigned)k0; }
          ac_left = AC_STEPS; } }
    const __amdgpu_buffer_rsrc_t ac_rs = __builtin_amdgcn_make_buffer_rsrc((void*)in_ptr(24 + ac_t), 0, 0xffffffff, 0x00020000);
    const int ac_stg = wid == 0 ? ATT_LDS3 : AC_STG_HI + (wid - 1) * 4096;
#define AC_PROC() do { \
        if (ac_pend) { const unsigned a0_ = (unsigned)(uintptr_t)(lds3 + ac_stg) + (unsigned)((16 * hi) * 32 + r32) * 4u, a1_ = a0_ + 1024u; f32x2 q0_, q1_, q2_, q3_, q4_, q5_, q6_, q7_; \
            asm volatile("ds_read2_b32 %0, %8 offset1:32\n\tds_read2_b32 %1, %8 offset0:64 offset1:96\n\tds_read2_b32 %2, %8 offset0:128 offset1:160\n\tds_read2_b32 %3, %8 offset0:192 offset1:224\n\t" \
                         "ds_read2_b32 %4, %9 offset1:32\n\tds_read2_b32 %5, %9 offset0:64 offset1:96\n\tds_read2_b32 %6, %9 offset0:128 offset1:160\n\tds_read2_b32 %7, %9 offset0:192 offset1:224\n\ts_waitcnt lgkmcnt(0)" \
                         : "=&v"(q0_), "=&v"(q1_), "=&v"(q2_), "=&v"(q3_), "=&v"(q4_), "=&v"(q5_), "=&v"(q6_), "=&v"(q7_) : "v"(a0_), "v"(a1_) : "memory"); \
            const float sc_ = (float)(1 << pg8::FP8_WSHIFT); q0_ *= sc_; q1_ *= sc_; q2_ *= sc_; q3_ *= sc_; q4_ *= sc_; q5_ *= sc_; q6_ *= sc_; q7_ *= sc_; \
            u32x4 w_; w_.x = cvt4_fp8(q0_.x, q0_.y, q1_.x, q1_.y); w_.y = cvt4_fp8(q2_.x, q2_.y, q3_.x, q3_.y); w_.z = cvt4_fp8(q4_.x, q4_.y, q5_.x, q5_.y); w_.w = cvt4_fp8(q6_.x, q6_.y, q7_.x, q7_.y); \
            *(u32x4*)(O.ws + (ac_dst - 32u + (unsigned)(r32 * ac_K + 16 * hi))) = w_; } \
        if (ac_pend) asm volatile("s_waitcnt lgkmcnt(0)" ::: "memory"); \
        ac_pend = 0; } while (0)
#define AC_PIECE(i_) do { const unsigned vo_ = (unsigned)((lane >> 3) * ac_N + (lane & 7) * 4) * 4u; \
        __builtin_amdgcn_raw_ptr_buffer_load_lds(ac_rs, (LAS void*)(lds3 + ac_stg + (i_) * 1024), 16, (int)vo_, (int)(ac_src + (unsigned)((i_) * 8 * 4) * (unsigned)ac_N), 0, 2); } while (0)
#define AC_ADV() do { ac_src += (unsigned)(32 * 4) * (unsigned)ac_N; ac_dst += 32u; ac_pend = 1; --ac_left; } while (0)
#define AC_STEP() do { AC_PROC(); if (ac_left) { AC_PIECE(0); AC_PIECE(1); AC_PIECE(2); AC_PIECE(3); AC_ADV(); } } while (0)
#define KVPIECE(pi_, tv_, tk_, tr_, slot_) do { \
        if ((pi_) < 2) __builtin_amdgcn_raw_ptr_buffer_load_lds(rs, (LAS void*)(lds3 + (slot_) + SL_V + ((pi_) * 8 + wid) * 1024), 16, (int)vofV[0], (int)((tv_) + (unsigned)((pi_) & 1) * (32u * LDV * 2u)), 0, 0); \
        else if ((pi_) < 4) __builtin_amdgcn_raw_ptr_buffer_load_lds(rs, (LAS void*)(lds3 + (slot_) + SL_KN + (((pi_) - 2) * 8 + wid) * 1024), 16, (int)vofK[0], (int)((tk_) + (unsigned)((pi_) & 1) * (32u * LDKN * 2u)), 0, 0); \
        else __builtin_amdgcn_raw_ptr_buffer_load_lds(rs, (LAS void*)(lds3 + (slot_) + SL_KR + wid * 1024), 16, (int)vofR, (int)(tr_), 0, 0); } while (0)
#define KVSPREAD(d0_, tq_, tv_, tk_, tr_, sn_) do { if ((tq_) >= 0) { if ((d0_) == 0) KVPIECE(0, tv_, tk_, tr_, sn_); else if ((d0_) == 3) KVPIECE(1, tv_, tk_, tr_, sn_); else if ((d0_) == 6) KVPIECE(2, tv_, tk_, tr_, sn_); \
        else if ((d0_) == 9) KVPIECE(3, tv_, tk_, tr_, sn_); else if ((d0_) == 11) KVPIECE(4, tv_, tk_, tr_, sn_); } } while (0)
    DMA(0, 0); DMA(1, SLOTB);
    LANDED();
    if (2 < NT) DMA(2, 2 * SLOTB);
    qkt(pA0, pA1, lds + SL_KN, lds + SL_KR, qr, r32, hi, NoPiece{}); partialSM(pA0, pA1, m_reg, mnA, alA);
    int pend_t = -1;
    for (int j = 1; j + 1 < NT; j += 2) {
        { const int tq = pend_t, tc = tq < 0 ? 0 : tq, sn = s_next; const unsigned tv_ = sV0 + (unsigned)tc * (KVBLK * LDV * 2), tk_ = sK0 + (unsigned)tc * (KVBLK * LDKN * 2), tr_ = sR0 + (unsigned)tc * (KVBLK * LDKR * 2);
          SBAR(); qkt(pB0, pB1, lds + s_cur + SL_KN, lds + s_cur + SL_KR, qr, r32, hi, [&](int d0) { KVSPREAD(d0, tq, tv_, tk_, tr_, sn); }); }
        finishSM(pA0, pA1, alA, l_reg, pa0, pa1, pa2, pa3); SBAR();
        pv_d0(o, vbl + s_prev, pa0, pa1, pa2, pa3, NoPiece{}); partialSM(pB0, pB1, m_reg, mnB, alB);
        RESC(alB);
        LANDED();
        AC_PROC();
        ROT3();
        { const int tq = j + 2 < NT ? j + 2 : -1, tc = tq < 0 ? 0 : tq, sn = s_next; const unsigned tv_ = sV0 + (unsigned)tc * (KVBLK * LDV * 2), tk_ = sK0 + (unsigned)tc * (KVBLK * LDKN * 2), tr_ = sR0 + (unsigned)tc * (KVBLK * LDKR * 2);
          SBAR(); qkt(pA0, pA1, lds + s_cur + SL_KN, lds + s_cur + SL_KR, qr, r32, hi, [&](int d0) { KVSPREAD(d0, tq, tv_, tk_, tr_, sn); }); }
        finishSM(pB0, pB1, alB, l_reg, pa0, pa1, pa2, pa3); SBAR();
        pv_d0(o, vbl + s_prev, pa0, pa1, pa2, pa3, NoPiece{});
        partialSM(pA0, pA1, m_reg, mnA, alA);
        RESC(alA);
        if (ac_left) { AC_PIECE(0); AC_PIECE(1); AC_PIECE(2); AC_PIECE(3); AC_ADV(); }
        if (ac_pend) asm volatile("s_waitcnt vmcnt(4)\n\ts_waitcnt lgkmcnt(0)" ::: "memory"); else asm volatile("s_waitcnt vmcnt(0)\n\ts_waitcnt lgkmcnt(0)" ::: "memory");
        __builtin_amdgcn_s_barrier(); asm volatile("" ::: "memory");
        ROT3();
        pend_t = j + 3 < NT ? j + 3 : -1;
    }
    SBAR(); qkt(pB0, pB1, lds + s_cur + SL_KN, lds + s_cur + SL_KR, qr, r32, hi, NoPiece{});
    finishSM(pA0, pA1, alA, l_reg, pa0, pa1, pa2, pa3); SBAR();
    pv_d0(o, vbl + s_prev, pa0, pa1, pa2, pa3, NoPiece{}); partialSM(pB0, pB1, m_reg, mnB, alB);
    RESC(alB);
    finishSM(pB0, pB1, alB, l_reg, pa0, pa1, pa2, pa3); SBAR();
    pv_d0(o, vbl + s_cur, pa0, pa1, pa2, pa3, NoPiece{});
    while (ac_pend) { asm volatile("s_waitcnt vmcnt(0)" ::: "memory"); AC_STEP(); }
    if (hi == 0) li_l[r32] = l_reg; asm volatile("s_waitcnt lgkmcnt(0)" ::: "memory");
    float rli[16];
#pragma unroll
    for (int r = 0; r < 16; ++r) rli[r] = __builtin_amdgcn_rcpf(li_l[crow(r, hi)]);
    __syncthreads();
    { LAS float* so = (LAS float*)lds3 + wid * 4096;
#pragma unroll
      for (int r = 0; r < 16; ++r)
#pragma unroll
          for (int d0 = 0; d0 < 4; ++d0) so[crow(r, hi) * 128 + d0 * 32 + r32] = o[d0][r] * rli[r];
      asm volatile("s_waitcnt lgkmcnt(0)" ::: "memory");
      int ln_; asm volatile("v_mbcnt_lo_u32_b32 %0, -1, 0\n\tv_mbcnt_hi_u32_b32 %0, -1, %0" : "=v"(ln_));
      const int rr = ln_ >> 4, c8 = (ln_ & 15) * 8;
      const unsigned og = ((unsigned)(qrow0 + wid * QBLK + rr) * INWP + CGATE + h * DV + c8) * 2u, om = ((unsigned)(qrow0 + wid * QBLK + rr) * 2048u + h * DV + c8) * 2u;
      const char* Pb = (const char*)(O.ws + WS_P); const char* PMb = (const char*)(O.ws + WS_POOLM); char* MBb = (char*)(O.ws + WS_MB);
#pragma unroll
      for (int hb = 0; hb < 8; hb += 4) {
      u32x4 g[4], pm[4];
#pragma unroll
      for (int q = 0; q < 4; ++q) { const int it = hb + q; g[q] = *(const u32x4*)(Pb + og + (unsigned)it * (4u * INWP * 2u)); pm[q] = *(const u32x4*)(PMb + om + (unsigned)it * (4u * 2048u * 2u)); }
      asm volatile("" ::: "memory");
#pragma unroll
      for (int q = 0; q < 4; ++q) { const int it = hb + q; const LAS float* sp = so + (it * 4 + rr) * 128 + c8; const f32x4 v0 = *(const LAS f32x4*)sp, v1 = *(const LAS f32x4*)(sp + 4);
          float gf[8], pf[8], ov[8]; unpack8(g[q], gf); unpack8(pm[q], pf);
          ov[0] = gf[0] * v0[0] + pf[0]; ov[1] = gf[1] * v0[1] + pf[1]; ov[2] = gf[2] * v0[2] + pf[2]; ov[3] = gf[3] * v0[3] + pf[3];
          ov[4] = gf[4] * v1[0] + pf[4]; ov[5] = gf[5] * v1[1] + pf[5]; ov[6] = gf[6] * v1[2] + pf[6]; ov[7] = gf[7] * v1[3] + pf[7];
          *(u32x4*)(MBb + om + (unsigned)it * (4u * 2048u * 2u)) = pack8(ov); }
      asm volatile("" ::: "memory"); } }
    __syncthreads();
#undef DMA
#undef LANDED
#undef RESC
#undef ROT3
#undef AC_STEP
#undef AC_PROC
#undef AC_PIECE
#undef AC_ADV
#undef KVPIECE
#undef KVSPREAD
}
#undef SBAR
#else
__device__ __forceinline__ void attn_naive_item(const bf16_t* Qg, const bf16_t* KNg, const bf16_t* Pg, const bf16_t* Vg, int grow, int krow0, int nkeys, int h,
                                                LAS float* sc, LAS float* qs, int lane, const Out& O) {
#pragma unroll
    for (int i = 0; i < 3; ++i) qs[lane + 64 * i] = bf2f(Qg[(size_t)grow * LDQ + h * DQK + lane + 64 * i]);
    asm volatile("s_waitcnt lgkmcnt(0)" ::: "memory");
    float mx = -1e30f;
    for (int k = lane; k < nkeys; k += 64) {
        const bf16_t* kn = KNg + (size_t)(krow0 + k) * LDKN + h * DN; const bf16_t* kr = Pg + (size_t)(krow0 + k) * LDKR + CKR;
        float s = 0.f;
        for (int c = 0; c < 16; ++c) { float kv[8]; unpack8(*(const u32x4*)(kn + c * 8), kv);
#pragma unroll
            for (int j = 0; j < 8; ++j) s += kv[j] * qs[c * 8 + j]; }
        for (int c = 0; c < 8; ++c) { float kv[8]; unpack8(*(const u32x4*)(kr + c * 8), kv);
#pragma unroll
            for (int j = 0; j < 8; ++j) s += kv[j] * qs[128 + c * 8 + j]; }
        s *= ATTN_SCALE; sc[k] = s; mx = fmaxf(mx, s);
    }
    mx = wave_max(mx);
    float sum = 0.f;
    for (int k = lane; k < nkeys; k += 64) { const float p = fast_exp(sc[k] - mx); sc[k] = p; sum += p; }
    sum = wave_sum(sum);
    asm volatile("s_waitcnt lgkmcnt(0)" ::: "memory");
    float o0 = 0.f, o1 = 0.f;
    for (int k = 0; k < nkeys; ++k) { const float p = sc[k]; const bf16_t* v = Vg + (size_t)(krow0 + k) * LDV + h * DV;
        o0 += p * bf2f(v[lane]); o1 += p * bf2f(v[lane + 64]); }
    const float inv = 1.f / sum;
    O.put(grow, h * DV + lane, o0 * inv); O.put(grow, h * DV + lane + 64, o1 * inv);
    asm volatile("s_waitcnt lgkmcnt(0)" ::: "memory");
}
#endif
}

__device__ __forceinline__ void ld_row_f32(const float* p, f32x4 (&v)[8], int lane) {
#pragma unroll
    for (int j = 0; j < 8; ++j) v[j] = *(const f32x4*)(p + 4 * lane + 256 * j);
}
__device__ __forceinline__ void st_row_f32(float* p, const f32x4 (&v)[8], int lane) {
#pragma unroll
    for (int j = 0; j < 8; ++j) *(f32x4*)(p + 4 * lane + 256 * j) = v[j];
}
__device__ __forceinline__ void ld_row_bf16(const bf16_t* p, f32x4 (&v)[8], int lane) {
#pragma unroll
    for (int j = 0; j < 8; ++j) { const u32x2 w = *(const u32x2*)(p + 4 * lane + 256 * j);
        v[j] = (f32x4){__uint_as_float(w.x << 16), __uint_as_float(w.x & 0xffff0000u), __uint_as_float(w.y << 16), __uint_as_float(w.y & 0xffff0000u)}; }
}
__device__ __forceinline__ void st_row_bf16(bf16_t* p, const f32x4 (&v)[8], int lane) {
#pragma unroll
    for (int j = 0; j < 8; ++j) { u32x2 w; w.x = cvt_pk_bf16(v[j][0], v[j][1]); w.y = cvt_pk_bf16(v[j][2], v[j][3]); *(u32x2*)(p + 4 * lane + 256 * j) = w; }
}
__device__ __forceinline__ float row_rstd(const f32x4 (&v)[8]) {
    float s = 0.f;
#pragma unroll
    for (int j = 0; j < 8; ++j) s += (v[j][0] * v[j][0] + v[j][1] * v[j][1]) + (v[j][2] * v[j][2] + v[j][3] * v[j][3]);
    s = wave_sum(s);
    return 1.0f / sqrtf(s * (1.0f / DM) + EPS);
}
__device__ __forceinline__ void norm_mod(const f32x4 (&x)[8], f32x4 (&o)[8], const float* gain, const float* shift, const float* scale, int lane) {
    const float rs = row_rstd(x);
#pragma unroll
    for (int j = 0; j < 8; ++j) { const int c = 4 * lane + 256 * j; const f32x4 g = *(const f32x4*)(gain + c), sh = *(const f32x4*)(shift + c), sc = *(const f32x4*)(scale + c);
        o[j] = x[j] * rs * g * (sc + 1.0f) + sh; }
}

#define LV_A(F) ((LAS float*)(F).lds)
#define LV_B(F) ((LAS float*)(F).lds + 3 * DM)
#define LV_C(F) ((LAS float*)(F).lds + 6 * DM)
#define LV_G1(F) ((LAS float*)(F).lds + 9 * DM)
#define LV_G2(F) ((LAS float*)(F).lds + 10 * DM)
__device__ __forceinline__ void stage3(LAS float* dst, const float* src, int tid) {
#pragma unroll
    for (int mi = 0; mi < 3; ++mi) *(LAS f32x4*)(dst + mi * DM + 4 * tid) = *(const f32x4*)(src + (size_t)mi * 6 * DM + 4 * tid);
}
__device__ __forceinline__ void stage1(LAS float* dst, const float* src, int tid) { *(LAS f32x4*)(dst + 4 * tid) = *(const f32x4*)(src + 4 * tid); }
__device__ __forceinline__ void norm_mod_l(const f32x4 (&x)[8], f32x4 (&o)[8], const LAS float* gain, const LAS float* shift, const LAS float* scale, int lane) {
    const float rs = row_rstd(x);
#pragma unroll
    for (int j = 0; j < 8; ++j) { const int c = 4 * lane + 256 * j; const f32x4 g = *(const LAS f32x4*)(gain + c), sh = *(const LAS f32x4*)(shift + c), sc = *(const LAS f32x4*)(scale + c);
        o[j] = x[j] * rs * g * (sc + 1.0f) + sh; }
}
__device__ __forceinline__ void st_row_i8(const Frame& F, int row, const f32x4 (&o)[8], int lane) {
    float mx = 0.f;
#pragma unroll
    for (int j = 0; j < 8; ++j) mx = fmaxf(fmaxf(mx, fmaxf(fabsf(o[j][0]), fabsf(o[j][1]))), fmaxf(fabsf(o[j][2]), fabsf(o[j][3])));
    mx = fmaxf(wave_max(mx), 1e-20f); const float inv = 127.0f / mx;
    unsigned char* h8 = F.ws + WS_H + (size_t)row * DM;
#pragma unroll
    for (int j = 0; j < 8; ++j) { const int q0 = (int)rintf(o[j][0] * inv), q1 = (int)rintf(o[j][1] * inv), q2 = (int)rintf(o[j][2] * inv), q3 = (int)rintf(o[j][3] * inv);
        *(unsigned*)(h8 + 4 * lane + 256 * j) = (unsigned)(q0 & 255) | ((unsigned)(q1 & 255) << 8) | ((unsigned)(q2 & 255) << 16) | ((unsigned)(q3 & 255) << 24); }
    if (lane == 0) ((float*)(F.ws + WS_HSC))[row] = mx * (1.0f / 127.0f);
}
__device__ __forceinline__ void phase_norm1_l0(const Frame& F) {
    PHASE_IDS(); const int gw = F.vcu * 8 + wave, NGW = F.G * 8;
    float* XRES = (float*)(F.ws + WS_XRES); bf16_t* H = (bf16_t*)(F.ws + WS_H);
    __syncthreads();
    stage3(LV_B(F), modp(F, 0, 0, 0), tid); stage3(LV_C(F), modp(F, 0, 0, 1), tid); stage1(LV_G1(F), in_ptr(6), tid);
    __syncthreads();
    for (int row = gw; row < R; row += NGW) {
        const int b = row / TPB, t = row % TPB;
        const float* src = t < CTXL ? in_ptr(2) + ((size_t)b * CTXL + t) * DM : in_ptr(0) + ((size_t)b * SEQ + (t - CTXL)) * DM;
        f32x4 x[8], o[8]; ld_row_f32(src, x, lane);
        st_row_f32(XRES + (size_t)row * DM, x, lane);
        const int mi = t < CTXL ? 2 : b;
        norm_mod_l(x, o, LV_G1(F), LV_B(F) + mi * DM, LV_C(F) + mi * DM, lane);
#if WIN_I8
        st_row_i8(F, row, o, lane);
#else
        st_row_bf16(H + (size_t)row * DM, o, lane);
#endif
    }
}
struct T2Row { u32x4 qv, kvv, wv[15], sv[4]; };
__device__ __forceinline__ void t2_load(const bf16_t* P, int row, int lane, T2Row& d) {
    const bf16_t* pr = P + (size_t)row * INWP; const int hv = lane >> 5, l32 = lane & 31;
    const int b = row / TPB, t = row % TPB, segrow0 = t < CTXL ? b * TPB : b * TPB + CTXL, L = t < CTXL ? CTXL : SEQ, tt = t < CTXL ? t : t - CTXL;
    d.qv = *(const u32x4*)(pr + CQ + 8 * lane); d.kvv = *(const u32x4*)(pr + CKV + 8 * lane);
#pragma unroll
    for (int gi = 0; gi < 4; ++gi) { const int w = 2 << gi, col = CPOOL + gi * 256 + 8 * l32;
#pragma unroll
        for (int q = 0; q < w / 2; ++q) { const int rr = tt - w / 2 + 2 * q + hv; const int rc = rr < 0 ? 0 : (rr >= L ? L - 1 : rr);
            d.wv[(w / 2 - 1) + q] = *(const u32x4*)(P + (size_t)(segrow0 + rc) * INWP + col); }
        d.sv[gi] = *(const u32x4*)(pr + col); }
}
__device__ __forceinline__ void t2_compute(const Frame& F, int row, int lane, const T2Row& d, const LAS float* GQ, const LAS float* GKV) {
    bf16_t* QLN = (bf16_t*)(F.ws + WS_QLN); bf16_t* KVLN = (bf16_t*)(F.ws + WS_KVLN); bf16_t* PL = (bf16_t*)(F.ws + WS_PL);
    const int hv = lane >> 5, l32 = lane & 31;
    const int t = row % TPB, L = t < CTXL ? CTXL : SEQ, tt = t < CTXL ? t : t - CTXL;
#pragma unroll
    for (int w = 0; w < 2; ++w) {
        float v[8]; unpack8(w == 0 ? d.qv : d.kvv, v);
        float s = 0.f;
#pragma unroll
        for (int j = 0; j < 8; ++j) s += v[j] * v[j];
        s = wave_sum(s); const float rs = 1.0f / sqrtf(s * (1.0f / 512.f) + EPS);
        const LAS float* g = (w == 0 ? GQ : GKV) + 8 * lane; const f32x4 g0 = *(const LAS f32x4*)g, g1 = *(const LAS f32x4*)(g + 4);
        v[0] *= rs * g0[0]; v[1] *= rs * g0[1]; v[2] *= rs * g0[2]; v[3] *= rs * g0[3]; v[4] *= rs * g1[0]; v[5] *= rs * g1[1]; v[6] *= rs * g1[2]; v[7] *= rs * g1[3];
        *(u32x4*)((w == 0 ? QLN : KVLN) + (size_t)row * 512 + 8 * lane) = pack8(v);
    }
#pragma unroll
    for (int gi = 0; gi < 4; ++gi) {
        const int w = 2 << gi; int lo = tt - w / 2, hi = tt - w / 2 + w; lo = lo < 0 ? 0 : lo; hi = hi > L ? L : hi;
        float a[8];
#pragma unroll
        for (int i = 0; i < 8; ++i) a[i] = 0.f;
#pragma unroll
        for (int q = 0; q < w / 2; ++q) { const int rr = tt - w / 2 + 2 * q + hv; const bool ok = rr >= 0 && rr < L;
            float v[8]; unpack8(d.wv[(w / 2 - 1) + q], v); const float m = ok ? 1.f : 0.f;
#pragma unroll
            for (int i = 0; i < 8; ++i) a[i] += m * v[i]; }
#pragma unroll
        for (int i = 0; i < 8; ++i) { auto sw = __builtin_amdgcn_permlane32_swap(__float_as_uint(a[i]), __float_as_uint(a[i]), false, false); a[i] = __uint_as_float(sw[0]) + __uint_as_float(sw[1]); }
        const float ic = 1.0f / (float)(hi - lo);
        float s8[8]; unpack8(d.sv[gi], s8);
#pragma unroll
        for (int i = 0; i < 8; ++i) a[i] = a[i] * ic - s8[i];
        if (hv == 0) *(u32x4*)(PL + (size_t)row * POOLW + gi * 256 + 8 * l32) = pack8(a);
    }
}
__device__ __forceinline__ void phase_thin2(const Frame& F, int l) {
    PHASE_IDS(); const int gw = F.vcu * 8 + wave, NGW = F.G * 8;
    const bf16_t* P = (const bf16_t*)(F.ws + WS_P);
    LAS float* const GQ = (LAS float*)F.lds; LAS float* const GKV = GQ + QL;
    if (tid < 128) *(LAS f32x4*)(GQ + 4 * tid) = *(const f32x4*)(in_ptr(12) + l * QL + 4 * tid); else if (tid < 256) *(LAS f32x4*)(GKV + 4 * (tid - 128)) = *(const f32x4*)(in_ptr(13) + l * KVL + 4 * (tid - 128));
    __syncthreads();
    for (int row = gw; row < R; row += 2 * NGW) { const int r2 = row + NGW; const bool h2 = r2 < R;
        T2Row A, B; t2_load(P, row, lane, A); t2_load(P, h2 ? r2 : row, lane, B);
        asm volatile("" ::: "memory");
        t2_compute(F, row, lane, A, GQ, GKV);
        if (h2) t2_compute(F, r2, lane, B, GQ, GKV);
    }
}
#ifndef MOD_DEFER
#define MOD_DEFER 1
#endif
__device__ __forceinline__ void mod_partial_item(const Frame& F, int it, int lane) {
    float* MODP = (float*)(F.ws + WS_MODP); const float* cvec = in_ptr(1); const float* cctx = in_ptr(3);
    const int l = it / (16 * 48), kc = (it / 48) % 16, cb = it % 48, n0 = cb * 256 + 4 * lane;
    const float* W = in_ptr(4) + (size_t)l * DM * 12288 + (size_t)(kc * 128) * 12288 + n0;
    f32x4 a0 = {0.f, 0.f, 0.f, 0.f}, a1 = a0, a2 = a0;
    for (int k = 0; k < 128; ++k) { const int kk = kc * 128 + k; const f32x4 w = *(const f32x4*)(W + (size_t)k * 12288);
        const float c0 = cvec[kk], c1 = cvec[DM + kk], c2 = cctx[kk];
        a0 += w * (c0 * sigmoidf_(c0)); a1 += w * (c1 * sigmoidf_(c1)); a2 += w * (c2 * sigmoidf_(c2)); }
    float* o = MODP + (((size_t)kc * 2 + l) * 3) * 12288 + n0;
    *(f32x4*)(o) = a0; *(f32x4*)(o + 12288) = a1; *(f32x4*)(o + 2 * 12288) = a2;
}
__device__ __forceinline__ void mod_reduce_layer(const Frame& F, int l, int tid) {
    const float* MODP = (const float*)(F.ws + WS_MODP); float* MOD = (float*)(F.ws + WS_MOD); const float* bmod = in_ptr(5);
    for (int j = F.vcu * 512 + tid; j < 3 * 12288; j += F.G * 512) { const int i = l * 3 * 12288 + j, n = j % 12288;
        float s = bmod[l * 12288 + n];
        for (int kc = 0; kc < 16; ++kc) s += MODP[(size_t)kc * (2 * 3 * 12288) + i];
        MOD[i] = s; }
}
__device__ __forceinline__ void phase_thin3_dense(const Frame& F, int l) {
    PHASE_IDS();
    const int gw = F.vcu * 8 + wave, NGW = F.G * 8;
    if (MOD_DEFER && F.G == 256) mod_reduce_layer(F, 1, tid);
    float* XRES = (float*)(F.ws + WS_XRES); bf16_t* H = (bf16_t*)(F.ws + WS_H); const bf16_t* Y = (const bf16_t*)(F.ws + WS_Y);
    stage3(LV_A(F), modp(F, l, 0, 2), tid); stage3(LV_B(F), modp(F, l, 0, 3), tid); stage3(LV_C(F), modp(F, l, 0, 4), tid); stage1(LV_G1(F), in_ptr(7) + l * DM, tid); stage1(LV_G2(F), in_ptr(8) + l * DM, tid);
    __syncthreads();
    const int nlr = (NLAT + NGW - 1) / NGW;
    for (int it = 0; ; ++it) { int row;
        if (it < nlr) { const int lat = it * NGW + gw; if (lat >= NLAT) continue; row = (lat / SEQ) * TPB + CTXL + lat % SEQ; }
        else { const int c = (it - nlr) * NGW + wave * F.G + F.vcu; if (c >= NB * CTXL) break; row = (c / CTXL) * TPB + c % CTXL; }
        const int mi = row_modidx(row);
        f32x4 y[8], x[8], o[8];
        if (row % TPB < CTXL) { const float* yc = (const float*)(F.ws + WS_YC) + (size_t)((row / TPB) * CTXL + row % TPB) * DM;
            ld_row_f32(yc, y, lane);
            for (int z = 1; z < ZS_G3; ++z) { f32x4 t[8]; ld_row_f32(yc + (size_t)z * (NB * CTXL) * DM, t, lane);
#pragma unroll
                for (int j = 0; j < 8; ++j) y[j] = y[j] + t[j]; } }
        else ld_row_bf16(Y + (size_t)row * DM, y, lane);
        ld_row_f32(XRES + (size_t)row * DM, x, lane);
        const float rs = row_rstd(y); const LAS float* gp = LV_G1(F); const LAS float* g1 = LV_A(F) + mi * DM;
#pragma unroll
        for (int j = 0; j < 8; ++j) { const int c = 4 * lane + 256 * j; x[j] = x[j] + *(const LAS f32x4*)(g1 + c) * (y[j] * rs * *(const LAS f32x4*)(gp + c)); }
        st_row_f32(XRES + (size_t)row * DM, x, lane);
        norm_mod_l(x, o, LV_G2(F), LV_B(F) + mi * DM, LV_C(F) + mi * DM, lane);
#if DENSE_I8
        st_row_i8(F, row, o, lane);
#else
        st_row_bf16(H + (size_t)row * DM, o, lane);
#endif
    }
}
__device__ __forceinline__ void phase_thin3_moe(const Frame& F, int l) {
    PHASE_IDS(); const int gw = F.vcu * 8 + wave, NGW = F.G * 8;
    float* XRES = (float*)(F.ws + WS_XRES); const bf16_t* Y = (const bf16_t*)(F.ws + WS_Y);
    unsigned* TOK = (unsigned*)(F.ws + WS_TOK);
    const float* wr = in_ptr(22); const float* br = in_ptr(23);
    __syncthreads();
    LAS float* const VA = (LAS float*)F.lds; LAS float* const VB = VA + 2 * DM; LAS float* const VC = VA + 4 * DM; LAS float* const VG1 = VA + 6 * DM; LAS float* const VG2 = VA + 7 * DM; LAS float* const WE = VA + 8 * DM;
#pragma unroll
    for (int m2 = 0; m2 < 2; ++m2) { stage1(VA + m2 * DM, modp(F, l, m2, 2), tid); stage1(VB + m2 * DM, modp(F, l, m2, 3), tid); stage1(VC + m2 * DM, modp(F, l, m2, 4), tid); }
    stage1(VG1, in_ptr(7) + l * DM, tid); stage1(VG2, in_ptr(8) + l * DM, tid);
#pragma unroll
    for (int i = 0; i < 8; ++i) { const int c = i * 512 + tid, k = c >> 1, e0 = (c & 1) * 4; const f32x4 v = *(const f32x4*)(wr + (size_t)c * 4);
        WE[(e0 + 0) * DM + k] = v[0]; WE[(e0 + 1) * DM + k] = v[1]; WE[(e0 + 2) * DM + k] = v[2]; WE[(e0 + 3) * DM + k] = v[3]; }
    __syncthreads();
    for (int tok = gw; tok < NLAT; tok += NGW) {
        const int b = tok / SEQ, s = tok % SEQ, row = b * TPB + CTXL + s, mi = b;
        f32x4 y[8], x[8], o[8]; ld_row_bf16(Y + (size_t)row * DM, y, lane); ld_row_f32(XRES + (size_t)row * DM, x, lane);
        const float rs = row_rstd(y); const LAS float* gp = VG1; const LAS float* g1 = VA + mi * DM;
#pragma unroll
        for (int j = 0; j < 8; ++j) { const int c = 4 * lane + 256 * j; x[j] = x[j] + *(const LAS f32x4*)(g1 + c) * (y[j] * rs * *(const LAS f32x4*)(gp + c)); }
        st_row_f32(XRES + (size_t)row * DM, x, lane);
        norm_mod_l(x, o, VG2, VB + mi * DM, VC + mi * DM, lane);
        float lg[8];
#pragma unroll
        for (int e = 0; e < 8; ++e) lg[e] = 0.f;
#pragma unroll
        for (int j = 0; j < 8; ++j) {
#pragma unroll
            for (int e = 0; e < 8; ++e) { const f32x4 w = *(const LAS f32x4*)(WE + e * DM + 4 * lane + 256 * j);
                lg[e] += (o[j][0] * w[0] + o[j][1] * w[1]) + (o[j][2] * w[2] + o[j][3] * w[3]); }
            asm volatile("" ::: "memory"); }
#pragma unroll
        for (int e = 0; e < 8; ++e) lg[e] = wave_sum(lg[e]) + br[e];
        int e1 = 0; float m1 = lg[0];
#pragma unroll
        for (int e = 1; e < 8; ++e) if (lg[e] > m1) { m1 = lg[e]; e1 = e; }
        int e2 = -1; float m2 = -3.0e38f;
#pragma unroll
        for (int e = 0; e < 8; ++e) if (e != e1 && lg[e] > m2) { m2 = lg[e]; e2 = e; }
        const float p2 = fast_exp(m2 - m1), w1n = 1.0f / (1.0f + p2), w2n = p2 / (1.0f + p2);
        unsigned r1 = 0u, r2 = 0u;
        if (lane == 0) {
            r1 = __hip_atomic_fetch_add(F.ctl + CW_CNT + 64 * e1, 1u, RLX_AGENT);
            r2 = __hip_atomic_fetch_add(F.ctl + CW_CNT + 64 * e2, 1u, RLX_AGENT);
            u32x4 a; a.x = (unsigned)e1; a.y = r1; a.z = __float_as_uint(w1n); a.w = (unsigned)e2; u32x4 c2; c2.x = r2; c2.y = __float_as_uint(w2n); c2.z = 0u; c2.w = 0u;
            *(u32x4*)(TOK + (size_t)tok * 8) = a; *(u32x4*)(TOK + (size_t)tok * 8 + 4) = c2;
        }
#if MOE_DIRECT
        { r1 = (unsigned)__builtin_amdgcn_readfirstlane((int)r1); r2 = (unsigned)__builtin_amdgcn_readfirstlane((int)r2);
          const int e1u = __builtin_amdgcn_readfirstlane(e1), e2u = __builtin_amdgcn_readfirstlane(e2);
          unsigned char* h1 = F.ws + WS_HS2 + ((size_t)e1u * NLAT + r1) * DM; unsigned char* h2 = F.ws + WS_HS2 + ((size_t)e2u * NLAT + r2) * DM;
#pragma unroll
          for (int j = 0; j < 8; ++j) { const unsigned w = cvt4_fp8(o[j][0], o[j][1], o[j][2], o[j][3]); *(unsigned*)(h1 + 4 * lane + 256 * j) = w; *(unsigned*)(h2 + 4 * lane + 256 * j) = w; } }
#endif
    }
}
__device__ __forceinline__ MoeTiles moe_tiles(const Frame& F) {
    volatile LAS int* tbl = (volatile LAS int*)(F.lds + MISC_OFF + 64);
    __syncthreads();
    if (threadIdx.x == 0) { int acc = 0;
        for (int e = 0; e < NE; ++e) { tbl[e] = acc; const unsigned c = __hip_atomic_load(F.ctl + CW_CNT + 64 * e, RLX_AGENT); acc += (int)((c + 255u) >> 8); }
        tbl[NE] = acc; }
    __syncthreads();
    MoeTiles mt; mt.tb = tbl; mt.total = __builtin_amdgcn_readfirstlane(tbl[NE]); return mt;
}
__device__ __forceinline__ void phase_moe_scatter(const Frame& F, int l, const MoeTiles& mt) {
    PHASE_IDS(); const int gw = F.vcu * 8 + wave, NGW = F.G * 8;
    const float* XRES = (const float*)(F.ws + WS_XRES); bf16_t* HS = (bf16_t*)(F.ws + WS_HS);
    const unsigned* TOK = (const unsigned*)(F.ws + WS_TOK);
    for (int tok = gw; tok < NLAT; tok += NGW) {
        const int b = tok / SEQ, s = tok % SEQ, row = b * TPB + CTXL + s, mi = b;
        f32x4 x[8], o[8]; ld_row_f32(XRES + (size_t)row * DM, x, lane);
        norm_mod(x, o, in_ptr(8) + l * DM, modp(F, l, mi, 3), modp(F, l, mi, 4), lane);
        const u32x4 a = *(const u32x4*)(TOK + (size_t)tok * 8); const u32x4 c2 = *(const u32x4*)(TOK + (size_t)tok * 8 + 4);
        int base1 = 0, base2 = 0;
        base1 = mt.tb[(int)a.x]; base2 = mt.tb[(int)a.w];
        const int s1 = base1 * 256 + (int)a.y, s2 = base2 * 256 + (int)c2.x;
#if MOE_FP8
        { unsigned char* h1 = (unsigned char*)HS + (size_t)s1 * DM; unsigned char* h2 = (unsigned char*)HS + (size_t)s2 * DM;
#pragma unroll
          for (int j = 0; j < 8; ++j) { const unsigned w = cvt4_fp8(o[j][0], o[j][1], o[j][2], o[j][3]); *(unsigned*)(h1 + 4 * lane + 256 * j) = w; *(unsigned*)(h2 + 4 * lane + 256 * j) = w; } }
#else
        st_row_bf16(HS + (size_t)s1 * DM, o, lane); st_row_bf16(HS + (size_t)s2 * DM, o, lane);
#endif
    }
}
__device__ __forceinline__ void phase_thin4_dense(const Frame& F, int l) {
    PHASE_IDS(); const int gw = F.vcu * 8 + wave, NGW = F.G * 8;
    float* XRES = (float*)(F.ws + WS_XRES); bf16_t* H = (bf16_t*)(F.ws + WS_H); const float* Y2 = (const float*)(F.ws + WS_Y2);
    stage3(LV_A(F), modp(F, l, 0, 5), tid); stage3(LV_B(F), modp(F, l + 1, 0, 0), tid); stage3(LV_C(F), modp(F, l + 1, 0, 1), tid); stage1(LV_G1(F), in_ptr(9) + l * DM, tid); stage1(LV_G2(F), in_ptr(6) + (l + 1) * DM, tid);
    __syncthreads();
    const int nlr = (NLAT + NGW - 1) / NGW;
    for (int it = 0; ; ++it) { int row;
        if (it < nlr) { const int lat = it * NGW + gw; if (lat >= NLAT) continue; row = (lat / SEQ) * TPB + CTXL + lat % SEQ; }
        else { const int c = (it - nlr) * NGW + wave * F.G + F.vcu; if (c >= NB * CTXL) break; row = (c / CTXL) * TPB + c % CTXL; }
        const int mi = row_modidx(row);
        f32x4 y[8], x[8], o[8];
        if (row % TPB < CTXL) { const float* yc = (const float*)(F.ws + WS_YC) + (size_t)((row / TPB) * CTXL + row % TPB) * DM;
            ld_row_f32(yc, y, lane);
            for (int z = 1; z < ZS_G5; ++z) { f32x4 t[8]; ld_row_f32(yc + (size_t)z * (NB * CTXL) * DM, t, lane);
#pragma unroll
                for (int j = 0; j < 8; ++j) y[j] = y[j] + t[j]; } }
        else ld_row_bf16((const bf16_t*)Y2 + (size_t)row * DM, y, lane);
        ld_row_f32(XRES + (size_t)row * DM, x, lane);
        const float rs = row_rstd(y); const LAS float* gp = LV_G1(F); const LAS float* g2 = LV_A(F) + mi * DM;
#pragma unroll
        for (int j = 0; j < 8; ++j) { const int c = 4 * lane + 256 * j; x[j] = x[j] + *(const LAS f32x4*)(g2 + c) * (y[j] * rs * *(const LAS f32x4*)(gp + c)); }
        st_row_f32(XRES + (size_t)row * DM, x, lane);
        norm_mod_l(x, o, LV_G2(F), LV_B(F) + mi * DM, LV_C(F) + mi * DM, lane);
#if WIN_I8
        st_row_i8(F, row, o, lane);
#else
        st_row_bf16(H + (size_t)row * DM, o, lane);
#endif
    }
}
__device__ __forceinline__ void phase_final_moe(const Frame& F, int l, const MoeTiles& mt) {
    PHASE_IDS(); const int gw = F.vcu * 8 + wave, NGW = F.G * 8;
    const float* XRES = (const float*)(F.ws + WS_XRES); const float* Y2 = (const float*)(F.ws + WS_Y2);
    const unsigned* TOK = (const unsigned*)(F.ws + WS_TOK);
    for (int tok = gw; tok < NLAT; tok += NGW) {
        const int b = tok / SEQ, s = tok % SEQ, row = b * TPB + CTXL + s, mi = b;
        const u32x4 a = *(const u32x4*)(TOK + (size_t)tok * 8); const u32x4 c2 = *(const u32x4*)(TOK + (size_t)tok * 8 + 4);
        int base1 = 0, base2 = 0;
        base1 = mt.tb[(int)a.x]; base2 = mt.tb[(int)a.w];
        const int s1 = base1 * 256 + (int)a.y, s2 = base2 * 256 + (int)c2.x;
        const float w1 = __uint_as_float(a.z), w2 = __uint_as_float(c2.y);
        f32x4 y[8], t0[8], x[8];
        ld_row_bf16((const bf16_t*)Y2 + (size_t)s1 * DM, y, lane); ld_row_bf16((const bf16_t*)Y2 + (size_t)MOE_ROWS * DM + (size_t)s1 * DM, t0, lane);
#pragma unroll
        for (int j = 0; j < 8; ++j) y[j] = (y[j] + t0[j]) * w1;
        ld_row_bf16((const bf16_t*)Y2 + (size_t)s2 * DM, t0, lane);
#pragma unroll
        for (int j = 0; j < 8; ++j) y[j] = y[j] + t0[j] * w2;
        ld_row_bf16((const bf16_t*)Y2 + (size_t)MOE_ROWS * DM + (size_t)s2 * DM, t0, lane);
#pragma unroll
        for (int j = 0; j < 8; ++j) y[j] = y[j] + t0[j] * w2;
        ld_row_f32(XRES + (size_t)row * DM, x, lane);
        const float rs = row_rstd(y); const float* gp = in_ptr(9) + l * DM; const float* g2 = modp(F, l, mi, 5);
#pragma unroll
        for (int j = 0; j < 8; ++j) { const int c = 4 * lane + 256 * j; x[j] = x[j] + *(const f32x4*)(g2 + c) * (y[j] * rs * *(const f32x4*)(gp + c)); }
        st_row_f32(F.out + (size_t)tok * DM, x, lane);
    }
}

enum { MAP_ID = 0, MAP_WIN = 1, MAP_QUP = 2, MAP_GATE = 3, MAP_UP = 4 };
__device__ __forceinline__ int dst_row(int kind, int n) {
    if (kind == MAP_WIN) {
        if (n < 1024) return n;
        if (n < 1088) { const int i = n - 1024; return i < 32 ? CKR + 2 * i : CKR + 2 * (i - 32) + 1; }
        if (n < 2112) return CPOOL + (n - 1088);
        return CGATE + (n - 2112);
    }
    if (kind == MAP_QUP) { const int h = n / DQK, d = n % DQK; if (d < DN) return n; const int i = d - DN; return h * DQK + DN + (i < 32 ? 2 * i : 2 * (i - 32) + 1); }
    if (kind == MAP_GATE) return (n >> 7) * 256 + (n & 127);
    if (kind == MAP_UP) return (n >> 7) * 256 + 128 + (n & 127);
    return n;
}
__device__ __forceinline__ void titem_load(const float* W, int N, int item, int lane, float (&v)[32]) {
    const int nblk = N / 32, kb = item / nblk, nb = item % nblk;
    const float* p = W + (size_t)(64 * kb + (lane >> 5)) * N + 32 * nb + (lane & 31);
#pragma unroll
    for (int i = 0; i < 32; ++i) v[i] = __builtin_nontemporal_load(p + (size_t)(2 * i) * N);
}
__device__ __forceinline__ void titem_store(const float (&v)[32], int K, int N, bf16_t* WT, int kind, LAS float* scr, int item, int lane) {
    const int nblk = N / 32, kb = item / nblk, nb = item % nblk, k0 = 64 * kb, n0 = 32 * nb;
#pragma unroll
    for (int i = 0; i < 32; ++i) scr[(2 * i + (lane >> 5)) * 33 + (lane & 31)] = v[i];
    asm volatile("s_waitcnt lgkmcnt(0)" ::: "memory");
    const int c = lane & 7;
#pragma unroll
    for (int j = 0; j < 4; ++j) { const int n = (lane >> 3) + 8 * j; const LAS float* s = scr + (8 * c) * 33 + n;
        u32x4 o; o.x = cvt_pk_bf16(s[0 * 33], s[1 * 33]); o.y = cvt_pk_bf16(s[2 * 33], s[3 * 33]); o.z = cvt_pk_bf16(s[4 * 33], s[5 * 33]); o.w = cvt_pk_bf16(s[6 * 33], s[7 * 33]);
        *(u32x4*)(WT + (size_t)dst_row(kind, n0 + n) * K + k0 + 8 * c) = o; }
    asm volatile("s_waitcnt lgkmcnt(0)" ::: "memory");
}
__device__ __forceinline__ void titem_store8(const float (&v)[32], int K, int N, unsigned char* WT, int kind, LAS float* scr, int item, int lane) {
    const int nblk = N / 32, kb = item / nblk, nb = item % nblk, k0 = 64 * kb, n0 = 32 * nb;
#pragma unroll
    for (int i = 0; i < 32; ++i) scr[(2 * i + (lane >> 5)) * 33 + (lane & 31)] = v[i] * (float)(1 << pg8::FP8_WSHIFT);
    asm volatile("s_waitcnt lgkmcnt(0)" ::: "memory");
    const int c = lane & 3;
#pragma unroll
    for (int j = 0; j < 2; ++j) { const int n = (lane >> 2) + 16 * j; const LAS float* s = scr + (16 * c) * 33 + n;
        u32x4 o; o.x = cvt4_fp8(s[0 * 33], s[1 * 33], s[2 * 33], s[3 * 33]); o.y = cvt4_fp8(s[4 * 33], s[5 * 33], s[6 * 33], s[7 * 33]);
        o.z = cvt4_fp8(s[8 * 33], s[9 * 33], s[10 * 33], s[11 * 33]); o.w = cvt4_fp8(s[12 * 33], s[13 * 33], s[14 * 33], s[15 * 33]);
        *(u32x4*)(WT + (size_t)dst_row(kind, n0 + n) * K + k0 + 16 * c) = o; }
    asm volatile("s_waitcnt lgkmcnt(0)" ::: "memory");
}
__device__ __forceinline__ void titem_store_i8(const float (&v)[32], int K, int N, unsigned char* WT, int kind, const float* inv_scale, LAS float* scr, int item, int lane) {
    const int nblk = N / 32, kb = item / nblk, nb = item % nblk, k0 = 64 * kb, n0 = 32 * nb;
    const float isc = inv_scale[n0 + (lane & 31)];
#pragma unroll
    for (int i = 0; i < 32; ++i) scr[(2 * i + (lane >> 5)) * 33 + (lane & 31)] = rintf(v[i] * isc);
    asm volatile("s_waitcnt lgkmcnt(0)" ::: "memory");
    const int c = lane & 3;
#pragma unroll
    for (int j = 0; j < 2; ++j) { const int n = (lane >> 2) + 16 * j; const LAS float* s = scr + (16 * c) * 33 + n;
        unsigned w[4];
#pragma unroll
        for (int q = 0; q < 4; ++q) w[q] = (unsigned)((int)s[(4 * q) * 33] & 255) | ((unsigned)((int)s[(4 * q + 1) * 33] & 255) << 8) | ((unsigned)((int)s[(4 * q + 2) * 33] & 255) << 16) | ((unsigned)((int)s[(4 * q + 3) * 33] & 255) << 24);
        *(u32x4*)(WT + (size_t)dst_row(kind, n0 + n) * K + k0 + 16 * c) = (u32x4){w[0], w[1], w[2], w[3]}; }
    asm volatile("s_waitcnt lgkmcnt(0)" ::: "memory");
}
struct Job { const float* src; bf16_t* dst; int K, N, kind, items; const float* isc; };
__device__ __forceinline__ Job make_job(const float* src, bf16_t* dst, int K, int N, int kind) { Job j; j.src = src; j.dst = dst; j.K = K; j.N = N; j.kind = kind; j.items = (K / 64) * (N / 32); j.isc = nullptr; return j; }
constexpr int NJOBS = 43;
#ifndef AC_CONVERT
#define AC_CONVERT 1
#endif
#ifndef BG_CONVERT
#define BG_CONVERT 1
#endif
constexpr int NJOBS_FG = BG_CONVERT ? 19 : NJOBS;
constexpr int EXP_ITEMS_PER_JOB = (DM / 64) * (DFF / 32), EXP_ITEMS = 24 * EXP_ITEMS_PER_JOB;
static_assert((DFF / 64) * (DM / 32) == EXP_ITEMS_PER_JOB && EXP_ITEMS_PER_JOB % 32 == 0, "expert jobs have equal item counts, whole 32-item rounds");
__device__ __forceinline__ Job get_job(const Frame& F, int jid) {
    unsigned char* ws = F.ws;
    if (jid < 16) { const int l = jid >> 3, k = jid & 7;
        if (k == 0) { Job j = make_job(in_ptr(10) + (size_t)l * DM * INW, (bf16_t*)(ws + WS_WIN + l * SZ_WIN), DM, INW, MAP_WIN + (WIN_I8 ? 64 : 0)); j.isc = (const float*)(ws + WS_WSC2) + 2 * INWP + l * INW; return j; }
        if (k == 1) return make_job(in_ptr(14) + (size_t)l * QL * 3072, (bf16_t*)(ws + WS_WQUP + l * SZ_WQUP), QL, 3072, MAP_QUP);
        if (k == 2) return make_job(in_ptr(15) + (size_t)l * KVL * 4096, (bf16_t*)(ws + WS_WKVUP + l * SZ_WKVUP), KVL, 4096, MAP_ID);
        if (k == 3) return make_job(in_ptr(18) + (size_t)l * DM * DM, (bf16_t*)(ws + WS_WOUT + l * SZ_WOUT), DM, DM, MAP_ID);
        const int g = k - 4; return make_job(in_ptr(16) + ((size_t)l * 4 + g) * 256 * 512, (bf16_t*)(ws + WS_WPOOL + l * SZ_WPOOL) + (size_t)g * 512 * 256, 256, 512, MAP_ID);
    }
    if (jid == 16) { Job j = make_job(in_ptr(19), (bf16_t*)(ws + WS_WFFGU), DM, DFF, MAP_GATE + (DENSE_I8 ? 64 : 0)); j.isc = (const float*)(ws + WS_WSC) + 2 * DFF; return j; }
    if (jid == 17) { Job j = make_job(in_ptr(20), (bf16_t*)(ws + WS_WFFGU), DM, DFF, MAP_UP + (DENSE_I8 ? 64 : 0)); j.isc = (const float*)(ws + WS_WSC) + 3 * DFF; return j; }
    if (jid == 18) return make_job(in_ptr(21), (bf16_t*)(ws + WS_WFFD), DFF, DM, MAP_ID);
    const int e = (jid - 19) / 3, k = (jid - 19) % 3;
    constexpr int FK = MOE_FP8 ? 16 : 0;
    if (k == 0) return make_job(in_ptr(24) + (size_t)e * DM * DFF, (bf16_t*)(ws + WS_WEGU + e * SZ_WGU), DM, DFF, MAP_GATE + FK);
    if (k == 1) return make_job(in_ptr(25) + (size_t)e * DM * DFF, (bf16_t*)(ws + WS_WEGU + e * SZ_WGU), DM, DFF, MAP_UP + FK);
    return make_job(in_ptr(26) + (size_t)e * DFF * DM, (bf16_t*)(ws + WS_WED + e * SZ_WD), DFF, DM, MAP_ID + FK);
}
template <int PART>
__device__ __forceinline__ void phase_prologue(const Frame& F) {
    PHASE_IDS(); const int gw = F.vcu * 8 + wave, NGW = F.G * 8;
    LAS float* scr = (LAS float*)(F.lds + wave * 16384); (void)scr;
    if constexpr (PART == 1) {
    { int total = 0;
      for (int jid = 0; jid < NJOBS_FG; ++jid) total += get_job(F, jid).items;
      int jid = 0, jbase = 0; Job J = get_job(F, 0);
      float cur[32], nxt[32];
      int g = gw;
      Job Jc = J; int itc = 0;
      if (g < total) { while (g >= jbase + J.items) { jbase += J.items; ++jid; J = get_job(F, jid); } Jc = J; itc = g - jbase; titem_load(Jc.src, Jc.N, itc, lane, cur); }
      while (g < total) {
          const int gn = g + NGW; Job Jn = J; int itn = 0; const bool hn = gn < total;
          if (hn) { while (gn >= jbase + J.items) { jbase += J.items; ++jid; J = get_job(F, jid); } Jn = J; itn = gn - jbase; titem_load(Jn.src, Jn.N, itn, lane, nxt); }
          if (Jc.kind >= 64) titem_store_i8(cur, Jc.K, Jc.N, (unsigned char*)Jc.dst, Jc.kind - 64, Jc.isc, scr, itc, lane);
          else if (MOE_FP8 && Jc.kind >= 16) titem_store8(cur, Jc.K, Jc.N, (unsigned char*)Jc.dst, Jc.kind - 16, scr, itc, lane);
          else titem_store(cur, Jc.K, Jc.N, Jc.dst, Jc.kind, scr, itc, lane);
#pragma unroll
          for (int i = 0; i < 32; ++i) cur[i] = nxt[i];
          Jc = Jn; itc = itn; g = gn;
      } }
    for (int l = 0; l < 2; ++l) { constexpr int WES = WIN_I8 ? 1 : 2; u32x4* z = (u32x4*)(F.ws + WS_WIN + l * SZ_WIN + (size_t)INW * DM * WES); const int n16 = (INWP - INW) * DM * WES / 16;
        for (int i = gw * 64 + lane; i < n16; i += NGW * 64) z[i] = (u32x4){0u, 0u, 0u, 0u}; }
    } else {
    { const int nit = (MOD_DEFER && F.G == 256) ? 16 * 48 : 2 * 16 * 48;
      for (int it = gw; it < nit; it += NGW) mod_partial_item(F, it, lane); }
#if DENSE_I8
    { float* WSCP = (float*)(F.ws + WS_WSCP);
      for (int it = gw; it < 2 * 16 * 28; it += NGW) { const int m = it / (16 * 28), kc = (it / 28) % 16, cb = it % 28, n0 = cb * 256 + 4 * lane;
          const float* W = in_ptr(19 + m) + (size_t)(kc * 128) * DFF + n0;
          f32x4 mx = {0.f, 0.f, 0.f, 0.f};
          for (int k = 0; k < 128; ++k) { const f32x4 w = *(const f32x4*)(W + (size_t)k * DFF); mx = __builtin_elementwise_max(mx, __builtin_elementwise_abs(w)); }
          *(f32x4*)(WSCP + ((size_t)kc * 2 + m) * DFF + n0) = mx; } }
#endif
#if WIN_I8
    { float* WSCP2 = (float*)(F.ws + WS_WSCP2);
      for (int it = gw; it < 2 * 16 * 25; it += NGW) { const int l = it / (16 * 25), kc = (it / 25) % 16, cb = it % 25, n0 = cb * 256 + 4 * lane;
          if (n0 < INW) { const float* W = in_ptr(10) + (size_t)l * DM * INW + (size_t)(kc * 128) * INW + n0;
              f32x4 mx = {0.f, 0.f, 0.f, 0.f};
              for (int k = 0; k < 128; ++k) { const f32x4 w = *(const f32x4*)(W + (size_t)k * INW); mx = __builtin_elementwise_max(mx, __builtin_elementwise_abs(w)); }
              *(f32x4*)(WSCP2 + ((size_t)kc * 2 + l) * INWP + n0) = mx; } } }
#endif
    { float* rc = (float*)(F.ws + WS_ROPE); float* rsn = rc + SEQ * 32;
      for (int i = gw * 64 + lane; i < SEQ * 32; i += NGW * 64) { const int s = i >> 5, f = i & 31, jf = f & 15;
          const float inv = __builtin_amdgcn_exp2f(-(float)jf * (13.287712379549449f / 16.0f));
          const float pos = (float)(f < 16 ? (s >> 6) : (s & 63)); const float ang = pos * inv;
          const float rev = ang * 0.15915494309189535f; const float fr = rev - floorf(rev);
          rc[i] = __builtin_amdgcn_cosf(fr); rsn[i] = __builtin_amdgcn_sinf(fr); } }
    }
}
__device__ __forceinline__ void witem_load(const float* W, int N, int item, int lane, f32x4 (&v)[8]) {
    const int nblk = N / 32, kb = item / nblk, nb = item % nblk;
    const float* p = W + (size_t)(64 * kb + (lane >> 3)) * N + 32 * nb + 4 * (lane & 7);
#pragma unroll
    for (int i = 0; i < 8; ++i) v[i] = __builtin_nontemporal_load((const f32x4*)(p + (size_t)(8 * i) * N));
}
__device__ __forceinline__ void witem_store8(const f32x4 (&v)[8], int K, int N, unsigned char* WT, int kind, LAS float* scr, int item, int lane) {
    const int nblk = N / 32, kb = item / nblk, nb = item % nblk, k0 = 64 * kb, n0 = 32 * nb;
#pragma unroll
    for (int i = 0; i < 8; ++i) *(LAS f32x4*)(scr + ((lane >> 3) + 8 * i) * 36 + 4 * (lane & 7)) = v[i] * (float)(1 << pg8::FP8_WSHIFT);
    asm volatile("s_waitcnt lgkmcnt(0)" ::: "memory");
    const int c = lane & 3;
#pragma unroll
    for (int j = 0; j < 2; ++j) { const int n = (lane >> 2) + 16 * j; const LAS float* s = scr + (16 * c) * 36 + n;
        u32x4 o; o.x = cvt4_fp8(s[0 * 36], s[1 * 36], s[2 * 36], s[3 * 36]); o.y = cvt4_fp8(s[4 * 36], s[5 * 36], s[6 * 36], s[7 * 36]);
        o.z = cvt4_fp8(s[8 * 36], s[9 * 36], s[10 * 36], s[11 * 36]); o.w = cvt4_fp8(s[12 * 36], s[13 * 36], s[14 * 36], s[15 * 36]);
        *(u32x4*)(WT + (size_t)dst_row(kind, n0 + n) * K + k0 + 16 * c) = o; }
    asm volatile("s_waitcnt lgkmcnt(0)" ::: "memory");
}
constexpr int QBATCH = 8;
__device__ __forceinline__ int queue_grab(unsigned* qh, int lane) { int v = 0; if (lane == 0) v = (int)__hip_atomic_fetch_add(qh, (unsigned)QBATCH, RLX_AGENT); return __builtin_amdgcn_readfirstlane(v); }
__device__ __forceinline__ void bg_item_load(const Frame& F, int g, int lane, float (&v)[32]) { const Job J = get_job(F, 19 + g / EXP_ITEMS_PER_JOB); titem_load(J.src, J.N, g % EXP_ITEMS_PER_JOB, lane, v); }
__device__ __forceinline__ void bg_item_store(const Frame& F, int g, int lane, const float (&v)[32], LAS float* scr) { const Job J = get_job(F, 19 + g / EXP_ITEMS_PER_JOB);
    if (MOE_FP8) titem_store8(v, J.K, J.N, (unsigned char*)J.dst, J.kind - 16, scr, g % EXP_ITEMS_PER_JOB, lane);
    else titem_store(v, J.K, J.N, J.dst, J.kind, scr, g % EXP_ITEMS_PER_JOB, lane); }
__device__ __forceinline__ void convert_bg(const Frame& F, int ph, unsigned thr) {
#if BG_CONVERT
    const int qoff = (AC_CONVERT && F.G == 256) ? att::AC_JOBS * EXP_ITEMS_PER_JOB : 0;
    if (ph >= 0 && thr == 0u) return;
    PHASE_IDS();
    LAS float* scr = (LAS float*)(F.lds + wave * 16384);
    unsigned* qh = F.ctl + CW_QHEAD; unsigned* dn = F.ctl + CW_DONE + 64 * (ph < 0 ? 0 : ph);
    float cur[32], nxt[32];
    if (ph < 0) {
        const int h = __builtin_amdgcn_readfirstlane((int)__hip_atomic_load(qh, RLX_AGENT)) + qoff;
        const int gw = F.vcu * 8 + wave, NGW = F.G * 8;
        int g = h + gw;
        if (g < EXP_ITEMS) bg_item_load(F, g, lane, cur);
        while (g < EXP_ITEMS) { const int gn = g + NGW;
            if (gn < EXP_ITEMS) bg_item_load(F, gn, lane, nxt);
            bg_item_store(F, g, lane, cur, scr);
#pragma unroll
            for (int i = 0; i < 32; ++i) cur[i] = nxt[i];
            g = gn; }
        return;
    }
    volatile LAS int* qw = (volatile LAS int*)(F.lds + MISC_OFF + 128);
    for (;;) {
        __syncthreads();
        if (tid == 0) { int g0 = EXP_ITEMS;
            if (__hip_atomic_load(dn, RLX_AGENT) < thr) g0 = (int)__hip_atomic_fetch_add(qh, 32u, RLX_AGENT) + qoff;
            qw[0] = g0; }
        __syncthreads();
        const int g0 = __builtin_amdgcn_readfirstlane(qw[0]);
        if (g0 >= EXP_ITEMS) break;
        const int gb = g0 + wave * 4;
#if MOE_FP8
        f32x4 w0[8], w1[8], w2[8], w3[8];
        { const Job J = get_job(F, 19 + gb / EXP_ITEMS_PER_JOB); const int it = gb % EXP_ITEMS_PER_JOB;
          witem_load(J.src, J.N, it, lane, w0); witem_load(J.src, J.N, it + 1, lane, w1); witem_load(J.src, J.N, it + 2, lane, w2); witem_load(J.src, J.N, it + 3, lane, w3);
          witem_store8(w0, J.K, J.N, (unsigned char*)J.dst, J.kind - 16, scr, it, lane); witem_store8(w1, J.K, J.N, (unsigned char*)J.dst, J.kind - 16, scr, it + 1, lane);
          witem_store8(w2, J.K, J.N, (unsigned char*)J.dst, J.kind - 16, scr, it + 2, lane); witem_store8(w3, J.K, J.N, (unsigned char*)J.dst, J.kind - 16, scr, it + 3, lane); }
#else
#pragma unroll 1
        for (int q = 0; q < 4; ++q) { bg_item_load(F, gb + q, lane, cur); bg_item_store(F, gb + q, lane, cur, scr); }
#endif
    }
#endif
}
__device__ __forceinline__ void report_done(const Frame& F, int ph) {
#if BG_CONVERT
    if (threadIdx.x == 0) __hip_atomic_fetch_add(F.ctl + CW_DONE + 64 * ph, 1u, RLX_AGENT);
#endif
}
__device__ __forceinline__ unsigned bg_thr(int units, int G) { const int rem = units % G; return rem ? (unsigned)(G - rem + 1) : 0u; }
__device__ __forceinline__ void phase_mod_reduce(const Frame& F) {
    const float* MODP = (const float*)(F.ws + WS_MODP); float* MOD = (float*)(F.ws + WS_MOD);
    PHASE_IDS(); const float* bmod = in_ptr(5);
    mod_reduce_layer(F, 0, tid);
    if (!(MOD_DEFER && F.G == 256)) mod_reduce_layer(F, 1, tid);
#if DENSE_I8
    { const float* WSCP = (const float*)(F.ws + WS_WSCP); float* WSC = (float*)(F.ws + WS_WSC);
      for (int i = (F.vcu * 8 + wave) * 64 + lane; i < 2 * DFF; i += F.G * 512) { float mx = 1e-30f;
          for (int kc = 0; kc < 16; ++kc) mx = fmaxf(mx, WSCP[(size_t)kc * 2 * DFF + i]);
          WSC[i] = mx * (1.0f / 127.0f); WSC[2 * DFF + i] = 127.0f / mx; } }
#endif
#if WIN_I8
    { const float* WSCP2 = (const float*)(F.ws + WS_WSCP2); float* WSC2 = (float*)(F.ws + WS_WSC2);
      for (int i = (F.vcu * 8 + wave) * 64 + lane; i < 2 * INW; i += F.G * 512) { const int l = i / INW, n = i % INW; float mx = 1e-30f;
          for (int kc = 0; kc < 16; ++kc) mx = fmaxf(mx, WSCP2[((size_t)kc * 2 + l) * INWP + n]);
          WSC2[l * INWP + dst_row(MAP_WIN, n)] = mx * (1.0f / 127.0f); WSC2[2 * INWP + l * INW + n] = 127.0f / mx; }
      for (int i = (F.vcu * 8 + wave) * 64 + lane; i < 2 * (INWP - INW); i += F.G * 512) WSC2[(i / (INWP - INW)) * INWP + INW + i % (INWP - INW)] = 1.0f; }
#endif
}

template <int L>
__device__ __forceinline__ void layer_body(const Frame& F, const XcdBarrier& bar, char* lds_gen) {
    unsigned char* ws = F.ws;
    const float* ropec = (const float*)(ws + WS_ROPE); const float* ropes = ropec + SEQ * 32;
    constexpr int l = L;
    if constexpr (L == 0) {
      constexpr int WES = WIN_I8 ? 1 : 2;
      SchedDense S; S.o.init(R / 256, INWP / 256, F.G, (int)blockIdx.x); S.A = (const char*)(ws + WS_H); S.B = (const char*)(ws + WS_WIN + l * SZ_WIN); S.lda2 = DM * WES; S.ldb2 = DM * WES;
      EpiG1 E{(bf16_t*)(ws + WS_P), in_ptr(11) + l * 4096, ropec, ropes, WIN_I8 ? (const float*)(ws + WS_HSC) : nullptr, WIN_I8 ? (const float*)(ws + WS_WSC2) + l * INWP : nullptr};
      pg8::gemm_phase<false, EpiG1, SchedDense, WIN_I8 != 0>(F.lds, F.ws, F.wv, DM, DM, DM / (WIN_I8 ? 128 : 64), S, E);
      report_done(F, l * 8 + 0); convert_bg(F, l * 8 + 0, bg_thr((R / 256) * (INWP / 256), F.G));
    } else {
      SchedG1Last S; S.o.init(NLAT / 256, INWP / 256, F.G, (int)blockIdx.x); S.A = (const char*)(ws + WS_H); S.B = (const char*)(ws + WS_WIN + l * SZ_WIN); S.es = WIN_I8 ? 1 : 2;
      EpiG1 E{(bf16_t*)(ws + WS_P), in_ptr(11) + l * 4096, ropec, ropes, WIN_I8 ? (const float*)(ws + WS_HSC) : nullptr, WIN_I8 ? (const float*)(ws + WS_WSC2) + l * INWP : nullptr};
      pg8::gemm_phase<false, EpiG1, SchedG1Last, WIN_I8 != 0>(F.lds, F.ws, F.wv, DM, DM, DM / (WIN_I8 ? 128 : 64), S, E);
      report_done(F, l * 8 + 0); convert_bg(F, l * 8 + 0, bg_thr((NLAT / 256) * (INWP / 256) + 6, F.G));
    }
    xcd_barrier(bar);
    phase_thin2(F, l);
    xcd_barrier(bar);
    { SchedDense S; S.o.init(R / 256, 3072 / 256, F.G, (int)blockIdx.x); S.A = (const char*)(ws + WS_QLN); S.B = (const char*)(ws + WS_WQUP + l * SZ_WQUP); S.lda2 = QL * 2; S.ldb2 = QL * 2;
      EpiQ E{(bf16_t*)(ws + WS_Q), ropec, ropes};
      pg8::gemm_phase<false>(F.lds, F.ws, F.wv, QL, QL, QL / 64, S, E); }
    { SchedDense S; S.o.init(R / 256, 4096 / 256, F.G, F.G == 256 ? ((int)blockIdx.x + 104) & 255 : (int)blockIdx.x); S.A = (const char*)(ws + WS_KVLN); S.B = (const char*)(ws + WS_WKVUP + l * SZ_WKVUP); S.lda2 = KVL * 2; S.ldb2 = KVL * 2;
      EpiKV E{(bf16_t*)(ws + WS_KN), (bf16_t*)(ws + WS_V)};
      pg8::gemm_phase<false>(F.lds, F.ws, F.wv, KVL, KVL, KVL / 64, S, E); }
    { SchedPool S; S.o.init(R / 256, 2048 / 256, F.G, F.G == 256 ? ((int)blockIdx.x + 72) & 255 : (int)blockIdx.x); S.A = (const char*)(ws + WS_PL); S.B = (const char*)(ws + WS_WPOOL + l * SZ_WPOOL);
      EpiPool E{(bf16_t*)(ws + WS_POOLM), (const bf16_t*)(ws + WS_P), in_ptr(17) + l * DM};
      pg8::gemm_phase<false>(F.lds, F.ws, F.wv, POOLW, 256, 4, S, E); }
    report_done(F, l * 8 + 1); convert_bg(F, l * 8 + 1, F.G == 256 ? 73u : 0u);
    xcd_barrier(bar);
    { const att::Out O{ws};
#if !NAIVE_ATTN
      int slot = 0;
      for (int uid = F.vcu; uid < 512; uid += F.G, ++slot) { const int b = uid >> 8, h = (uid >> 4) & 15, qt = uid & 15;
          const bool ac = AC_CONVERT && F.G == 256;
          att::attn_unit(b * TPB + CTXL + qt * 256, b * TPB, TPB, h, lds_gen, F.lds, O, F.wv, ac ? (l * 2 + slot) * 256 + F.vcu : -1); }
      if (l == 0) for (int j = 0; j < 32; ++j) if ((j * 8) % F.G == F.vcu) { const int b = j >> 4, h = j & 15;
          att::attn_unit(b * TPB, b * TPB, CTXL, h, lds_gen, F.lds, O, F.wv, -1); }
      if constexpr (L == 0) if (MOD_DEFER && F.G == 256 && (F.vcu & 7) != 0) {
          PHASE_IDS(); const int idx = F.vcu - (F.vcu / 8 + 1), it = wave * 224 + idx;
          if (wave < 4 && it < 16 * 48) mod_partial_item(F, 16 * 48 + it, lane); }
#else
      const bf16_t* Qg = (const bf16_t*)(ws + WS_Q); const bf16_t* KNg = (const bf16_t*)(ws + WS_KN); const bf16_t* Pg = (const bf16_t*)(ws + WS_P); const bf16_t* Vg = (const bf16_t*)(ws + WS_V);
      PHASE_IDS();
      if (wave < 7) { LAS float* sc = (LAS float*)(F.lds) + wave * (TPB + DQK); LAS float* qs = sc + TPB;
          const int gw7 = F.vcu * 7 + wave, NG7 = F.G * 7;
          for (int it = gw7; it < NLAT * NH; it += NG7) { const int tok = it >> 4, h = it & 15, b = tok / SEQ, s = tok % SEQ;
              att::attn_naive_item(Qg, KNg, Pg, Vg, b * TPB + CTXL + s, b * TPB, TPB, h, sc, qs, lane, O); }
          if (l == 0) for (int it = gw7; it < NB * CTXL * NH; it += NG7) { const int tok = it >> 4, h = it & 15, b = tok / CTXL, t = tok % CTXL;
              att::attn_naive_item(Qg, KNg, Pg, Vg, b * TPB + t, b * TPB, CTXL, h, sc, qs, lane, O); } }
      __syncthreads();
#endif
    }
    xcd_barrier(bar);
    { SchedDense S; S.o.init(NLAT / 256, DM / 256, F.G, (int)blockIdx.x); S.lat_only = true;
      S.A = (const char*)(ws + WS_MB); S.B = (const char*)(ws + WS_WOUT + l * SZ_WOUT); S.lda2 = DM * 2; S.ldb2 = DM * 2;
      EpiPlain E{(bf16_t*)(ws + WS_Y), DM};
      pg8::gemm_phase<false>(F.lds, F.ws, F.wv, DM, DM, DM / 64, S, E); }
    if constexpr (L == 0) {
      SchedCtxSplit S; S.o.init(2, (DM / 256) * ZS_G3, F.G, (int)blockIdx.x); S.A = (const char*)(ws + WS_MB); S.B = (const char*)(ws + WS_WOUT + l * SZ_WOUT); S.lda2 = DM * 2; S.ldb2 = DM * 2; S.nN = DM / 256; S.ksb = (DM / ZS_G3) * 2;
      EpiCtxPart E{ws};
      pg8::gemm_phase<false>(F.lds, F.ws, F.wv, DM, DM, DM / ZS_G3 / 64, S, E); }
    xcd_barrier(bar);
    if constexpr (L == 0) {
        phase_thin3_dense(F, l);
        xcd_barrier(bar);
#if DENSE_I8
        { SchedDense S; S.o.init(R / 256, 14336 / 256, F.G, (int)blockIdx.x); S.A = (const char*)(ws + WS_H); S.B = (const char*)(ws + WS_WFFGU); S.lda2 = DM; S.ldb2 = DM;
          EpiSwigluI8 E{ws};
          pg8::gemm_phase<false, EpiSwigluI8, SchedDense, true>(F.lds, F.ws, F.wv, DM, DM, DM / 128, S, E); }
#else
        { SchedDense S; S.o.init(R / 256, 14336 / 256, F.G, (int)blockIdx.x); S.A = (const char*)(ws + WS_H); S.B = (const char*)(ws + WS_WFFGU); S.lda2 = DM * 2; S.ldb2 = DM * 2;
          EpiSwiglu E{(bf16_t*)(ws + WS_ACT)};
          pg8::gemm_phase<false>(F.lds, F.ws, F.wv, DM, DM, DM / 64, S, E); }
#endif
        report_done(F, 3); convert_bg(F, 3, bg_thr((R / 256) * (14336 / 256), F.G));
        xcd_barrier(bar);
        { SchedDense S; S.o.init(NLAT / 256, DM / 256, F.G, (int)blockIdx.x); S.lat_only = true;
          S.A = (const char*)(ws + WS_ACT); S.B = (const char*)(ws + WS_WFFD); S.lda2 = DFF * 2; S.ldb2 = DFF * 2;
          EpiDown E{ws, (unsigned)(MOE_ROWS * DM), 1.0f};
          pg8::gemm_phase<false>(F.lds, F.ws, F.wv, DFF, DFF, DFF / 64, S, E); }
        { SchedCtxSplit S; S.o.init(2, (DM / 256) * ZS_G5, F.G, (int)blockIdx.x); S.A = (const char*)(ws + WS_ACT); S.B = (const char*)(ws + WS_WFFD); S.lda2 = DFF * 2; S.ldb2 = DFF * 2; S.nN = DM / 256; S.ksb = (DFF / ZS_G5) * 2;
          EpiCtxPart E{ws};
          pg8::gemm_phase<false>(F.lds, F.ws, F.wv, DFF, DFF, DFF / ZS_G5 / 64, S, E); }
        report_done(F, 4); convert_bg(F, 4, bg_thr(2 * (DM / 256) * ZS_G5, F.G));
        xcd_barrier(bar);
        phase_thin4_dense(F, l);
        xcd_barrier(bar);
    } else {
        convert_bg(F, -1, 0u);
        phase_thin3_moe(F, l);
        xcd_barrier(bar);
        const MoeTiles mt = moe_tiles(F);
#if !MOE_DIRECT
        phase_moe_scatter(F, l, mt);
        xcd_barrier(bar);
#endif
        { SchedMoeUp S; S.o.init(mt.total, 14336 / 256, F.G, (int)blockIdx.x); S.mt = mt; S.A = (const char*)(ws + (MOE_DIRECT ? WS_HS2 : WS_HS)); S.B = (const char*)(ws + WS_WEGU);
#if MOE_FP8
          EpiSwiglu8 E{ws};
          pg8::gemm_phase<true>(F.lds, F.ws, F.wv, DM, DM, DM / 128, S, E); }
#else
          EpiSwiglu E{(bf16_t*)(ws + WS_ACT)};
          pg8::gemm_phase<false>(F.lds, F.ws, F.wv, DM, DM, DM / 64, S, E); }
#endif
        xcd_barrier(bar);
        { SchedMoeDown S; S.o.init(mt.total, (DM / 256) * ZK, F.G, (int)blockIdx.x); S.mt = mt; S.A = (const char*)(ws + WS_ACT); S.B = (const char*)(ws + WS_WED); S.nN = DM / 256;
          EpiDown E{ws, (unsigned)(MOE_ROWS * DM), MOE_FP8 ? pg8::FP8_WINV : 1.0f};
          pg8::gemm_phase<MOE_FP8 != 0>(F.lds, F.ws, F.wv, DFF, DFF, KSPL / (MOE_FP8 ? 128 : 64), S, E); }
        xcd_barrier(bar);
        phase_final_moe(F, l, mt);
    }
}

__global__ void __launch_bounds__(512, 2) fwd_kernel(Args args) {
    extern __shared__ __attribute__((aligned(16))) unsigned char lds_raw[];
    const int G = gridDim.x, bx = blockIdx.x;
    const Frame F{(LAS unsigned char*)lds_raw, (unsigned*)(args.ws + WS_CTL), args.ws, (G % 8 == 0) ? (bx % 8) * (G / 8) + bx / 8 : bx, G, __builtin_amdgcn_readfirstlane((int)threadIdx.x >> 6), args.out};
    volatile LAS unsigned* MISC = (volatile LAS unsigned*)(F.lds + MISC_OFF);
    for (int u = threadIdx.x; u < (LDS_BYTES - LDSCTL_OFF) / 4; u += 512) ((LAS unsigned*)(F.lds + LDSCTL_OFF))[u] = 0u;
    __syncthreads();
    const XcdBarrier bar = xcd_barrier_post(F.ctl + CW_BAR, MISC + 8);

    phase_prologue<0>(F);
    xcd_barrier(bar);
    phase_mod_reduce(F);
    xcd_barrier(bar);
    phase_prologue<1>(F);
    phase_norm1_l0(F);
    xcd_barrier(bar);
    layer_body<0>(F, bar, (char*)lds_raw);
    layer_body<1>(F, bar, (char*)lds_raw);
}

extern "C" void kernel_launch(void* const* d_in, const int* in_sizes, int n_in, void* d_out, int out_size, void* d_ws, size_t ws_size, hipStream_t stream) {
    static int grid = 0;
    if (grid == 0) {
        if (n_in != 27 || out_size != NLAT * DM || ws_size < WS_END) { fprintf(stderr, "kernel_launch: shape mismatch n_in %d out %d ws %zu (need %zu)\n", n_in, out_size, ws_size, (size_t)WS_END); grid = -1; return; }
        int dev = 0, cus = 0;
        if (hipGetDevice(&dev) != hipSuccess || hipDeviceGetAttribute(&cus, hipDeviceAttributeMultiprocessorCount, dev) != hipSuccess) { grid = -1; return; }
        if (hipFuncSetAttribute((const void*)fwd_kernel, hipFuncAttributeMaxDynamicSharedMemorySize, LDS_BYTES) != hipSuccess) { fprintf(stderr, "kernel_launch: hipFuncSetAttribute failed\n"); grid = -1; return; }
        int per_cu = 0;
        if (hipOccupancyMaxActiveBlocksPerMultiprocessor(&per_cu, (const void*)fwd_kernel, 512, LDS_BYTES) != hipSuccess || per_cu < 1) fprintf(stderr, "kernel_launch: occupancy query says %d\n", per_cu);
        (void)hipGetLastError();
        grid = cus;
    }
    if (grid < 0) return;
    (void)hipMemsetAsync((char*)d_ws + WS_CTL, 0, CTL_BYTES, stream);
    Args a{};
    for (int i = 0; i < 27; ++i) a.in[i] = (const float*)d_in[i];
    a.out = (float*)d_out; a.ws = (unsigned char*)d_ws;
    hipLaunchKernelGGL(fwd_kernel, dim3(grid), dim3(512), LDS_BYTES, stream, a);
    const hipError_t le = hipPeekAtLastError();
    if (le != hipSuccess) fprintf(stderr, "kernel_launch: launch failed: %s\n", hipGetErrorName(le));
}
```

```cpp
#include <hip/hip_runtime.h>
#include <cstdio>
#include <cstdint>
#include <type_traits>

#ifndef NAIVE_GEMM
#define NAIVE_GEMM 0
#endif
#ifndef MOE_FP8
#define MOE_FP8 1
#endif
#ifndef MOE_DIRECT
#define MOE_DIRECT (MOE_FP8)
#endif
#ifndef DENSE_I8
#define DENSE_I8 1
#endif
#ifndef WIN_I8
#define WIN_I8 1
#endif
#ifndef NAIVE_ATTN
#define NAIVE_ATTN 0
#endif

#define GAS __attribute__((address_space(1)))
#define LAS __attribute__((address_space(3)))
typedef unsigned short bf16_t;
typedef short bf16x8 __attribute__((ext_vector_type(8)));
typedef short s16x4 __attribute__((ext_vector_type(4)));
typedef float f32x4 __attribute__((ext_vector_type(4)));
typedef float f32x2 __attribute__((ext_vector_type(2)));
typedef float f32x16 __attribute__((ext_vector_type(16)));
typedef unsigned u32x4 __attribute__((ext_vector_type(4)));
typedef unsigned u32x2 __attribute__((ext_vector_type(2)));

constexpr int DM = 2048, NB = 2, SEQ = 4096, CTXL = 256, TPB = SEQ + CTXL, R = NB * TPB;
constexpr int NH = 16, DN = 128, DRP = 64, DV = 128, DQK = 192, QL = 512, KVL = 512;
constexpr int POOLW = 1024, INW = 6208, INWP = 6400;
constexpr int DFF = 7168, NE = 8;
constexpr int NLAT = NB * SEQ;
constexpr int MOE_ROWS = 18432;
constexpr float EPS = 1e-6f;
constexpr float ATTN_SCALE = 0.07216878364870322f;
constexpr int CQ = 0, CKV = 512, CPOOL = 1024, CGATE = 2048, CKR = 6144;
constexpr int ZK = 2, KSPL = DFF / ZK;

constexpr size_t MiB = 1u << 20;
constexpr size_t WS_CTL = 0, CTL_BYTES = 1 * MiB;
constexpr size_t WS_MODP = 1 * MiB;
constexpr size_t WS_MOD = 6 * MiB;
constexpr size_t WS_ROPE = 7 * MiB;
constexpr size_t WS_WSCP = 9 * MiB;
constexpr size_t WS_WSC = 10 * MiB;
constexpr size_t WS_HSC = 11 * MiB;
constexpr size_t WS_WSCP2 = 12 * MiB;
constexpr size_t WS_WSC2 = 13 * MiB;
constexpr size_t WS_TOK = 8 * MiB;
constexpr size_t WS_WIN = 16 * MiB;
constexpr size_t SZ_WIN = (size_t)INWP * DM * 2;
constexpr size_t WS_WQUP = WS_WIN + 2 * SZ_WIN;
constexpr size_t SZ_WQUP = (size_t)3072 * 512 * 2;
constexpr size_t WS_WKVUP = WS_WQUP + 2 * SZ_WQUP;
constexpr size_t SZ_WKVUP = (size_t)4096 * 512 * 2;
constexpr size_t WS_WPOOL = WS_WKVUP + 2 * SZ_WKVUP;
constexpr size_t SZ_WPOOL = (size_t)2048 * 256 * 2;
constexpr size_t WS_WOUT = WS_WPOOL + 2 * SZ_WPOOL;
constexpr size_t SZ_WOUT = (size_t)2048 * 2048 * 2;
constexpr size_t WS_WFFGU = WS_WOUT + 2 * SZ_WOUT;
constexpr size_t SZ_WGU = (size_t)14336 * 2048 * 2;
constexpr size_t WS_WFFD = WS_WFFGU + SZ_WGU;
constexpr size_t SZ_WD = (size_t)2048 * 7168 * 2;
constexpr size_t WS_WEGU = WS_WFFD + SZ_WD;
constexpr size_t WS_WED = WS_WEGU + 8 * SZ_WGU;
constexpr size_t WS_WEND = WS_WED + 8 * SZ_WD;
constexpr size_t WS_XRES = (WS_WEND + MiB - 1) / MiB * MiB;
constexpr size_t WS_H = WS_XRES + (size_t)R * DM * 4;
constexpr size_t WS_U = WS_H + (size_t)R * DM * 2;
constexpr size_t WS_P = WS_U;
constexpr size_t WS_QLN = WS_P + (size_t)R * INWP * 2;
constexpr size_t WS_KVLN = WS_QLN + (size_t)R * 512 * 2;
constexpr size_t WS_PL = WS_KVLN + (size_t)R * 512 * 2;
constexpr size_t WS_Q = WS_PL + (size_t)R * 1024 * 2;
constexpr size_t WS_KN = WS_Q + (size_t)R * 3072 * 2;
constexpr size_t WS_V = WS_KN + (size_t)R * 2048 * 2;
constexpr size_t WS_POOLM = WS_V + (size_t)R * 2048 * 2;
constexpr size_t WS_MB = WS_POOLM + (size_t)R * 2048 * 2;
constexpr size_t WS_Y = WS_MB + (size_t)R * 2048 * 2;
constexpr size_t WS_MIXEND = WS_Y + (size_t)R * 2048 * 2;
constexpr size_t WS_ACT = WS_U;
constexpr size_t WS_Y2 = WS_ACT + (size_t)MOE_ROWS * DFF * 2;
constexpr size_t WS_HS = WS_Y2 + (size_t)ZK * MOE_ROWS * DM * 4;
constexpr size_t WS_FFNEND = WS_HS + (size_t)MOE_ROWS * DM * 2;
constexpr size_t WS_HS2 = WS_U + 400 * MiB;
static_assert(WS_HS2 + (size_t)NE * NLAT * DM <= WS_FFNEND && WS_HS2 >= WS_MIXEND && WS_HS2 >= WS_Y2 + (size_t)ZK * MOE_ROWS * DM * 2, "fixed-capacity expert rows");
constexpr size_t WS_YC = WS_U + 400 * MiB;
constexpr int ZS_G5 = 14, ZS_G3 = 16;
static_assert(WS_YC >= WS_MIXEND && WS_YC >= WS_Y2 + (size_t)R * DM * 4 && WS_YC + (size_t)16 * 512 * DM * 4 <= WS_FFNEND, "YC placement");
constexpr size_t WS_END = WS_FFNEND > WS_MIXEND ? WS_FFNEND : WS_MIXEND;
static_assert(WS_Y + (size_t)R * 2048 * 2 <= WS_HS || true, "");
constexpr int CW_BAR = 4096;
constexpr int CW_QHEAD = 20480;
constexpr int CW_DONE = 24576;
constexpr int CW_CNT = 16384;

constexpr int RING_BYTES = 131072;
constexpr int LDSCTL_OFF = RING_BYTES, MISC_OFF = LDSCTL_OFF + 320;
constexpr int LDS_BYTES = 163840;

#define RLX_AGENT __ATOMIC_RELAXED, __HIP_MEMORY_SCOPE_AGENT
__device__ __forceinline__ float bf2f(unsigned h) { return __uint_as_float(h << 16); }
__device__ __forceinline__ unsigned f2bf(float f) { unsigned u = __float_as_uint(f); return (u + 0x7fffu + ((u >> 16) & 1u)) >> 16; }
__device__ __forceinline__ unsigned pk2(float lo, float hi) { return f2bf(lo) | (f2bf(hi) << 16); }
__device__ __forceinline__ unsigned cvt_pk_bf16(float lo, float hi) { unsigned r; asm volatile("v_cvt_pk_bf16_f32 %0, %1, %2" : "=v"(r) : "v"(lo), "v"(hi)); return r; }
template <int M> __device__ __forceinline__ float swz_xor(float v) { return __int_as_float(__builtin_amdgcn_ds_swizzle(__float_as_int(v), (M << 10) | 0x1f)); }
__device__ __forceinline__ float wave_sum(float v) {
    v += swz_xor<1>(v); v += swz_xor<2>(v); v += swz_xor<4>(v); v += swz_xor<8>(v); v += swz_xor<16>(v);
    auto rr = __builtin_amdgcn_permlane32_swap(__float_as_uint(v), __float_as_uint(v), false, false);
    return __uint_as_float(rr[0]) + __uint_as_float(rr[1]);
}
__device__ __forceinline__ float wave_max(float v) {
    v = fmaxf(v, swz_xor<1>(v)); v = fmaxf(v, swz_xor<2>(v)); v = fmaxf(v, swz_xor<4>(v)); v = fmaxf(v, swz_xor<8>(v)); v = fmaxf(v, swz_xor<16>(v));
    auto rr = __builtin_amdgcn_permlane32_swap(__float_as_uint(v), __float_as_uint(v), false, false);
    return fmaxf(__uint_as_float(rr[0]), __uint_as_float(rr[1]));
}
__device__ __forceinline__ float fast_exp(float x) { return __builtin_amdgcn_exp2f(x * 1.4426950408889634f); }
__device__ __forceinline__ float sigmoidf_(float x) { return __builtin_amdgcn_rcpf(1.f + fast_exp(-x)); }
__device__ __forceinline__ u32x4 pack8(const float* v) { u32x4 w; w.x = cvt_pk_bf16(v[0], v[1]); w.y = cvt_pk_bf16(v[2], v[3]); w.z = cvt_pk_bf16(v[4], v[5]); w.w = cvt_pk_bf16(v[6], v[7]); return w; }
__device__ __forceinline__ unsigned cvt4_fp8(float a, float b, float c, float d) { int p = 0; p = __builtin_amdgcn_cvt_pk_fp8_f32(a, b, p, false); p = __builtin_amdgcn_cvt_pk_fp8_f32(c, d, p, true); return (unsigned)p; }
__device__ __forceinline__ void unpack8(u32x4 w, float* v) {
    v[0] = __uint_as_float(w.x << 16); v[1] = __uint_as_float(w.x & 0xffff0000u); v[2] = __uint_as_float(w.y << 16); v[3] = __uint_as_float(w.y & 0xffff0000u);
    v[4] = __uint_as_float(w.z << 16); v[5] = __uint_as_float(w.z & 0xffff0000u); v[6] = __uint_as_float(w.w << 16); v[7] = __uint_as_float(w.w & 0xffff0000u);
}

__device__ __forceinline__ int fresh_tid(int wv);
#define XB_TMO      128
#define XB_XCNT(j)  (256  + 64 * (j))
#define XB_XSUB(j)  (1280 + 64 * (j))
#define XB_XGEN(j)  (2304 + 64 * (j))
#define XB_TOP      3328
#define XB_TOPGEN   3392
#define XCD_BAR_WORDS 3456
#if NAIVE_GEMM || NAIVE_ATTN
#define XB_SPIN_CAP (1u << 27)
#else
#define XB_SPIN_CAP (1u << 20)
#endif
__device__ __forceinline__ unsigned xb_ld(unsigned* p)              { return __hip_atomic_load(p, __ATOMIC_RELAXED, __HIP_MEMORY_SCOPE_AGENT); }
__device__ __forceinline__ unsigned xb_add(unsigned* p, unsigned v) { return __hip_atomic_fetch_add(p, v, __ATOMIC_RELAXED, __HIP_MEMORY_SCOPE_AGENT); }
__device__ __forceinline__ unsigned xb_xcc_id() { return (unsigned)__builtin_amdgcn_s_getreg((3 << 11) | 20) & 0xFu; }
#define XB_SPIN(cond, bar) do { unsigned _sp = 0; while (cond) { __builtin_amdgcn_s_sleep(1); \
    if ((++_sp & 255u) == 0u) { if (xb_ld(&(bar)[XB_TMO])) break; if (_sp > XB_SPIN_CAP) { atomicAdd(&(bar)[XB_TMO], 1u); break; } } } } while (0)
struct XcdBarrier { unsigned* bar; unsigned x; volatile LAS unsigned* st; };
__device__ __forceinline__ XcdBarrier xcd_barrier_post(unsigned* bar, volatile LAS unsigned* st) {
    XcdBarrier b; b.bar = bar; b.x = xb_xcc_id(); b.st = st;
    if (threadIdx.x == 0) (void)xb_add(&bar[XB_XCNT(b.x)], 1u);
    return b;
}
__device__ __forceinline__ void xcd_barrier_complete(unsigned* bar, unsigned x, unsigned& nloc, unsigned& nx) {
    const unsigned G = gridDim.x * gridDim.y * gridDim.z;
    unsigned sum, cnt, mine, sp = 0u;
    for (;;) {
        sum = 0u; cnt = 0u; mine = 0u;
#pragma unroll
        for (unsigned j = 0; j < 16; ++j) { const unsigned c = xb_ld(&bar[XB_XCNT(j)]); sum += c; cnt += (c > 0u) ? 1u : 0u; mine = (j == x) ? c : mine; }
        if (sum == G) break;
        __builtin_amdgcn_s_sleep(1);
        if ((++sp & 255u) == 0u) { if (xb_ld(&bar[XB_TMO])) break; if (sp > XB_SPIN_CAP) { atomicAdd(&bar[XB_TMO], 1u); break; } }
    }
    nloc = mine > 0u ? mine : 1u; nx = cnt > 0u ? cnt : 1u;
}
__device__ __forceinline__ void xcd_barrier(const XcdBarrier& b) {
    asm volatile("s_waitcnt vmcnt(0)" ::: "memory");
    __syncthreads();
    if (threadIdx.x == 0) {
        unsigned* bar = b.bar;
        __builtin_amdgcn_s_waitcnt(0);
        unsigned nloc = b.st[0], nx = b.st[1];
        if (nloc == 0u) { xcd_barrier_complete(bar, b.x, nloc, nx); b.st[0] = nloc; b.st[1] = nx; }
        const unsigned old = xb_add(&bar[XB_XSUB(b.x)], 1u);
        const unsigned gen = old / nloc;
        if (old + 1u == (gen + 1u) * nloc) {
            __builtin_amdgcn_fence(__ATOMIC_RELEASE, "agent");
            asm volatile("s_waitcnt vmcnt(0)" ::: "memory");
            const unsigned og = xb_add(&bar[XB_TOP], 1u);
            const unsigned tg = og / nx;
            if (og + 1u == (tg + 1u) * nx) xb_add(&bar[XB_TOPGEN], 1u);
            else XB_SPIN(xb_ld(&bar[XB_TOPGEN]) == tg, bar);
            __builtin_amdgcn_fence(__ATOMIC_ACQUIRE, "agent");
            xb_add(&bar[XB_XGEN(b.x)], 1u);
            asm volatile("s_waitcnt vmcnt(0)" ::: "memory");
        } else {
            XB_SPIN(xb_ld(&bar[XB_XGEN(b.x)]) == gen, bar);
            __builtin_amdgcn_fence(__ATOMIC_ACQUIRE, "agent");
            asm volatile("s_waitcnt vmcnt(0)" ::: "memory");
        }
    }
    __syncthreads();
}

namespace pg8 {
constexpr int BM = 256, BK = 64, HALF = 128, HTB = HALF * BK * 2, STAGE_BYTES = 8 * HTB, NXCD = 8, WGM = 8;
__host__ __device__ __forceinline__ int lds_byte(int r, int c) { const int st = (r >> 4) * 2 + (c >> 5), rr = r & 15, cc = c & 31, ob = rr * 64 + cc * 2; return st * 1024 + (ob ^ (((ob >> 9) & 1) << 5)); }
__host__ __device__ __forceinline__ void stage_rc(int b, int& R_, int& C_) { const int st = b / 1024, sb = b % 1024, swz = sb ^ (((sb >> 9) & 1) << 5); R_ = (st >> 1) * 16 + swz / 64; C_ = (st & 1) * 32 + (swz % 64) / 2; }
__host__ __device__ __forceinline__ int perm32(int rho) { const int n = rho >> 4, i = rho & 15; return 8 * (i >> 2) + 4 * n + (i & 3); }

struct Unit { int pm, pn, z; };
template <class T, class = void> struct HasPrep : std::false_type {};
template <class T> struct HasPrep<T, std::void_t<typename T::Prep>> : std::true_type {};

struct GridOrder {
    int nM, nN, nwg, G, c;
    __device__ __forceinline__ void init(int nM_, int nN_, int G_, int c_) { nM = nM_; nN = nN_; nwg = nM * nN; G = G_; c = c_; }
    __device__ __forceinline__ bool next2(int i, int& pm, int& pn) const {
        const int L = i * G + c; if (L >= nwg) return false;
        int wgid = L; { const int q = nwg / NXCD, r = nwg % NXCD, xcd = wgid % NXCD, off = wgid / NXCD; wgid = (xcd < r ? xcd * (q + 1) : r * (q + 1) + (xcd - r) * q) + off; }
        const int nig = WGM * nN, gid = wgid / nig, fm = gid * WGM, gsz = (nM - fm) < WGM ? (nM - fm) : WGM;
        pm = fm + ((wgid % nig) % gsz); pn = (wgid % nig) / gsz; return true;
    }
};

__device__ __forceinline__ const char* uniform_ptr(const char* p) { const unsigned long long v = (unsigned long long)p; const unsigned lo = (unsigned)__builtin_amdgcn_readfirstlane((int)(unsigned)v), hi = (unsigned)__builtin_amdgcn_readfirstlane((int)(unsigned)(v >> 32)); return (const char*)(((unsigned long long)hi << 32) | lo); }
typedef int i32x4 __attribute__((ext_vector_type(4)));
typedef int i32x8 __attribute__((ext_vector_type(8)));
constexpr int FP8_WSHIFT = 8;
constexpr int FP8_SCALE_W = 0x7f7f7f7f, FP8_SCALE_A = 0x7f7f7f7f;
constexpr float FP8_WINV = 1.0f / (float)(1 << FP8_WSHIFT);
#if !NAIVE_GEMM
template <bool FP8, class F, class Sched, bool I8 = false>
__device__ __forceinline__ void gemm_phase(LAS unsigned char* lds, const unsigned char* wsb, const int wv, const int lda, const int ldb, const int nt, const Sched& S, const F& f) {
    constexpr int ES = (FP8 || I8) ? 1 : 2;
    const int tid = fresh_tid(wv), wid = __builtin_amdgcn_readfirstlane(tid >> 6), lane = tid & 63, wr = wid >> 2, wc = wid & 3, fr = lane & 15, fq = lane >> 4;
    unsigned voffA[2], voffB[2];
#pragma unroll
    for (int i = 0; i < 2; ++i) { int R_, C_; stage_rc(tid * 16 + i * 8192, R_, C_); const int Rb = (R_ & ~31) + perm32(R_ & 31);
        voffA[i] = (unsigned)(R_ * lda * ES + C_ * 2); voffB[i] = (unsigned)(Rb * ldb * ES + C_ * 2); }
    const unsigned kstep = (unsigned)(BK * 2);
    const unsigned hsA = (unsigned)(HALF * lda * ES), hsB = (unsigned)(HALF * ldb * ES);
    const __amdgpu_buffer_rsrc_t rsA = __builtin_amdgcn_make_buffer_rsrc((void*)wsb, 0, 0xffffffff, 0x00020000);
    const unsigned ldsw = (unsigned)wid * 1024u;
    const int aoff = lds_byte(wr * 64 + fr, fq * 8), boff = lds_byte(wc * 32 + fr, fq * 8);
#define PG8_SA(b, h) (((b) * 2 + (h)) * HTB)
#define PG8_SB(b, h) ((4 + (b) * 2 + (h)) * HTB)
#define PG8_STAGE(bufoff, goff, voff) do { _Pragma("unroll") for (int _i = 0; _i < 2; ++_i) \
        __builtin_amdgcn_raw_ptr_buffer_load_lds(PG8_RS_##voff, (LAS void*)(lds + (bufoff) + ldsw + _i * 8192), 16, (int)(voff)[_i], (int)(goff), 0, 0); } while (0)
#define PG8_RS_voffA rsA
#define PG8_RS_voffB rsA
#define PG8_LDA(dst, b, h) do { _Pragma("unroll") for (int m = 0; m < 4; ++m) _Pragma("unroll") for (int k = 0; k < 2; ++k) dst[m][k] = *(const LAS bf16x8*)(lds + PG8_SA(b, h) + aoff + m * 2048 + k * 1024); } while (0)
#define PG8_LDB(dst, b, h) do { _Pragma("unroll") for (int n = 0; n < 2; ++n) _Pragma("unroll") for (int k = 0; k < 2; ++k) dst[n][k] = *(const LAS bf16x8*)(lds + PG8_SB(b, h) + boff + n * 2048 + k * 1024); } while (0)
#define PG8_CAT8(x) __builtin_shufflevector(__builtin_bit_cast(i32x4, (x)[0]), __builtin_bit_cast(i32x4, (x)[1]), 0, 1, 2, 3, 4, 5, 6, 7)
#define PG8_MMA(ai, bj, At, Bt) do { __builtin_amdgcn_s_setprio(1); \
        if constexpr (FP8) { _Pragma("unroll") for (int m = 0; m < 4; ++m) _Pragma("unroll") for (int n = 0; n < 2; ++n) \
            acc[ai][bj][m][n] = __builtin_amdgcn_mfma_scale_f32_16x16x128_f8f6f4(PG8_CAT8(Bt[n]), PG8_CAT8(At[m]), acc[ai][bj][m][n], 0, 0, 0, FP8_SCALE_W, 0, FP8_SCALE_A); } \
        else if constexpr (I8) { _Pragma("unroll") for (int m = 0; m < 4; ++m) _Pragma("unroll") for (int n = 0; n < 2; ++n) _Pragma("unroll") for (int k = 0; k < 2; ++k) \
            acc[ai][bj][m][n] = __builtin_bit_cast(f32x4, __builtin_amdgcn_mfma_i32_16x16x64_i8(__builtin_bit_cast(i32x4, Bt[n][k]), __builtin_bit_cast(i32x4, At[m][k]), __builtin_bit_cast(i32x4, acc[ai][bj][m][n]), 0, 0, 0)); } \
        else { _Pragma("unroll") for (int m = 0; m < 4; ++m) _Pragma("unroll") for (int n = 0; n < 2; ++n) _Pragma("unroll") for (int k = 0; k < 2; ++k) \
            acc[ai][bj][m][n] = __builtin_amdgcn_mfma_f32_16x16x32_bf16(Bt[n][k], At[m][k], acc[ai][bj][m][n], 0, 0, 0); } \
        __builtin_amdgcn_s_setprio(0); } while (0)
#define PG8_WAIT_V(n) asm volatile("s_waitcnt vmcnt(" #n ")" ::: "memory")
#define PG8_WAIT_L(n) asm volatile("s_waitcnt lgkmcnt(" #n ")" ::: "memory")
#define PG8_BAR __builtin_amdgcn_s_barrier()
#define PG8_SCHED __builtin_amdgcn_sched_barrier(0)
    Unit cur, nxt; int ui = 0;
    if (!S.next(0, cur)) return;
    f32x4 acc[2][2][4][2];
#pragma unroll
    for (int a = 0; a < 2; ++a)
#pragma unroll
        for (int b = 0; b < 2; ++b)
#pragma unroll
            for (int m = 0; m < 4; ++m)
#pragma unroll
                for (int n = 0; n < 2; ++n) acc[a][b][m][n] = (f32x4){0.f, 0.f, 0.f, 0.f};
    bf16x8 At[4][2], B0[2][2], B1[2][2];
    unsigned cA, cB; { const char* pa; const char* pb; S.ptrs(cur, pa, pb); cA = (unsigned)__builtin_amdgcn_readfirstlane((int)(unsigned)(pa - (const char*)wsb)); cB = (unsigned)__builtin_amdgcn_readfirstlane((int)(unsigned)(pb - (const char*)wsb)); }
    PG8_STAGE(PG8_SB(0, 0), cB, voffB); PG8_STAGE(PG8_SB(0, 1), cB + hsB, voffB); PG8_STAGE(PG8_SA(0, 0), cA, voffA); PG8_STAGE(PG8_SA(0, 1), cA + hsA, voffA);
    if (wr == 1) PG8_BAR;
    PG8_WAIT_V(2); PG8_BAR;
    PG8_STAGE(PG8_SB(1, 0), cB + kstep, voffB); PG8_STAGE(PG8_SA(1, 0), cA + kstep, voffA); PG8_STAGE(PG8_SB(1, 1), cB + hsB + kstep, voffB);
    PG8_WAIT_V(6); PG8_BAR;
    for (;;) {
        const bool has_next = S.next(ui + 1, nxt);
        unsigned nA = cA, nB = cB; if (has_next) { const char* pa; const char* pb; S.ptrs(nxt, pa, pb); nA = (unsigned)__builtin_amdgcn_readfirstlane((int)(unsigned)(pa - (const char*)wsb)); nB = (unsigned)__builtin_amdgcn_readfirstlane((int)(unsigned)(pb - (const char*)wsb)); }
        for (int t = 0; t < nt; t += 2) {
            const bool last = (t == nt - 2);
            const unsigned a1 = cA + (unsigned)(t + 1) * kstep;
            const unsigned a2 = last ? nA : cA + (unsigned)(t + 2) * kstep, b2 = last ? nB : cB + (unsigned)(t + 2) * kstep;
            const unsigned a3 = a2 + kstep, b3 = b2 + kstep;
            PG8_LDB(B0, 0, 0); PG8_LDB(B1, 0, 1); PG8_SCHED; PG8_LDA(At, 0, 0); PG8_STAGE(PG8_SA(1, 1), a1 + hsA, voffA);
            PG8_WAIT_V(8); PG8_WAIT_L(0); PG8_BAR; PG8_MMA(0, 0, At, B0); PG8_MMA(0, 1, At, B1); PG8_BAR; PG8_SCHED;
            PG8_LDA(At, 0, 1); PG8_STAGE(PG8_SB(0, 0), b2, voffB); PG8_STAGE(PG8_SB(0, 1), b2 + hsB, voffB); PG8_STAGE(PG8_SA(0, 0), a2, voffA);
            PG8_WAIT_V(8); PG8_WAIT_L(0); PG8_BAR; PG8_MMA(1, 0, At, B0); PG8_MMA(1, 1, At, B1); PG8_BAR; PG8_SCHED;
            PG8_LDB(B0, 1, 0); PG8_LDB(B1, 1, 1); PG8_SCHED; PG8_LDA(At, 1, 0); PG8_STAGE(PG8_SA(0, 1), a2 + hsA, voffA);
            PG8_WAIT_V(8); PG8_WAIT_L(0); PG8_BAR; PG8_MMA(0, 0, At, B0); PG8_MMA(0, 1, At, B1); PG8_BAR; PG8_SCHED;
            PG8_LDA(At, 1, 1); PG8_STAGE(PG8_SB(1, 0), b3, voffB); PG8_STAGE(PG8_SB(1, 1), b3 + hsB, voffB); PG8_STAGE(PG8_SA(1, 0), a3, voffA);
            PG8_WAIT_V(8); PG8_WAIT_L(0); PG8_BAR; PG8_MMA(1, 0, At, B0); PG8_MMA(1, 1, At, B1); PG8_BAR; PG8_SCHED;
        }
        if (wr == 0) PG8_BAR;
        if constexpr (HasPrep<F>::value) { const auto pr_ = f.prep(cur, wc * 32 + 8 * fq, wr * 64 + fr);
#pragma unroll
        for (int ai = 0; ai < 2; ++ai)
#pragma unroll
            for (int m = 0; m < 4; ++m) {
                f32x4 a[2][2];
#pragma unroll
                for (int bj = 0; bj < 2; ++bj)
#pragma unroll
                    for (int n = 0; n < 2; ++n) { if constexpr (I8) a[bj][n] = __builtin_convertvector(__builtin_bit_cast(i32x4, acc[ai][bj][m][n]), f32x4); else a[bj][n] = acc[ai][bj][m][n]; }
                f.row(cur, ai * HALF + wr * 64 + m * 16 + fr, wc * 32 + 8 * fq, a, pr_, ai * 4 + m);
            }
        } else {
#pragma unroll
        for (int ai = 0; ai < 2; ++ai)
#pragma unroll
            for (int m = 0; m < 4; ++m) {
                f32x4 a[2][2];
#pragma unroll
                for (int bj = 0; bj < 2; ++bj)
#pragma unroll
                    for (int n = 0; n < 2; ++n) { if constexpr (I8) a[bj][n] = __builtin_convertvector(__builtin_bit_cast(i32x4, acc[ai][bj][m][n]), f32x4); else a[bj][n] = acc[ai][bj][m][n]; }
                f.row(cur, ai * HALF + wr * 64 + m * 16 + fr, wc * 32 + 8 * fq, a);
            }
        }
        if (!has_next) break;
#pragma unroll
        for (int a = 0; a < 2; ++a)
#pragma unroll
            for (int b = 0; b < 2; ++b)
#pragma unroll
                for (int m = 0; m < 4; ++m)
#pragma unroll
                    for (int n = 0; n < 2; ++n) acc[a][b][m][n] = (f32x4){0.f, 0.f, 0.f, 0.f};
        cur = nxt; cA = nA; cB = nB; ++ui;
        if (wr == 1) PG8_BAR;
    }
    PG8_WAIT_V(0);
    PG8_BAR;
#undef PG8_SA
#undef PG8_SB
#undef PG8_STAGE
#undef PG8_RS_voffA
#undef PG8_RS_voffB
#undef PG8_LDA
#undef PG8_LDB
#undef PG8_MMA
#undef PG8_CAT8
#undef PG8_WAIT_V
#undef PG8_WAIT_L
#undef PG8_BAR
#undef PG8_SCHED
}
#else
__device__ __forceinline__ float fp8_to_f(unsigned b) { const unsigned e = (b >> 3) & 15u, m = b & 7u; const float v = e ? __uint_as_float(((e + 120u) << 23) | (m << 20)) : (float)m * 0.001953125f; return (b & 128u) ? -v : v; }
template <bool FP8, class F, class Sched, bool I8 = false>
__device__ __forceinline__ void gemm_phase(LAS unsigned char* lds, const unsigned char* wsb, const int wv, const int lda, const int ldb, const int nt_, const Sched& S, const F& f) {
    const int nt = (FP8 || I8) ? nt_ * 2 : nt_;
    const int tid = fresh_tid(wv);
    LAS float* As = (LAS float*)lds;
    LAS float* Bs = As + 64 * 65;
    Unit u;
    for (int i = 0; S.next(i, u); ++i) {
        const char* cA; const char* cB; S.ptrs(u, cA, cB);
        const bf16_t* A = (const bf16_t*)cA; const bf16_t* B = (const bf16_t*)cB; const unsigned char* A8 = (const unsigned char*)cA; const unsigned char* B8 = (const unsigned char*)cB;
        for (int sub = 0; sub < 8; ++sub) {
            const int r0 = (sub >> 1) * 64, c0 = (sub & 1) * 64;
            float acc[2][8];
#pragma unroll
            for (int b = 0; b < 2; ++b)
#pragma unroll
                for (int j = 0; j < 8; ++j) acc[b][j] = 0.f;
            const int tr = tid >> 3, tc = (tid & 7) * 8;
            for (int kt = 0; kt < nt; ++kt) {
                __syncthreads();
                for (int e = tid; e < 4096; e += 512) { const int rr = e >> 6, kk = e & 63;
                    if constexpr (I8) {
                    As[rr * 65 + kk] = (float)(signed char)A8[(size_t)(r0 + rr) * lda + kt * 64 + kk];
                    Bs[rr * 65 + kk] = (float)(signed char)B8[(size_t)(c0 + rr) * ldb + kt * 64 + kk];
                    Bs[(64 + rr) * 65 + kk] = (float)(signed char)B8[(size_t)(128 + c0 + rr) * ldb + kt * 64 + kk]; } else
                    if constexpr (FP8) {
                    As[rr * 65 + kk] = fp8_to_f(A8[(size_t)(r0 + rr) * lda + kt * 64 + kk]);
                    Bs[rr * 65 + kk] = fp8_to_f(B8[(size_t)(c0 + rr) * ldb + kt * 64 + kk]);
                    Bs[(64 + rr) * 65 + kk] = fp8_to_f(B8[(size_t)(128 + c0 + rr) * ldb + kt * 64 + kk]); } else {
                    As[rr * 65 + kk] = bf2f(A[(size_t)(r0 + rr) * lda + kt * 64 + kk]);
                    Bs[rr * 65 + kk] = bf2f(B[(size_t)(c0 + rr) * ldb + kt * 64 + kk]);
                    Bs[(64 + rr) * 65 + kk] = bf2f(B[(size_t)(128 + c0 + rr) * ldb + kt * 64 + kk]); } }
                __syncthreads();
                for (int kk = 0; kk < 64; ++kk) { const float a = As[tr * 65 + kk];
#pragma unroll
                    for (int j = 0; j < 8; ++j) { acc[0][j] += a * Bs[(tc + j) * 65 + kk]; acc[1][j] += a * Bs[(64 + tc + j) * 65 + kk]; } }
            }
            f32x4 a[2][2];
#pragma unroll
            for (int b = 0; b < 2; ++b) { a[b][0] = (f32x4){acc[b][0], acc[b][1], acc[b][2], acc[b][3]}; a[b][1] = (f32x4){acc[b][4], acc[b][5], acc[b][6], acc[b][7]}; }
            f.row(u, r0 + tr, c0 + tc, a);
        }
    }
    __syncthreads();
}
#endif
}

struct Args { const float* in[27]; float* out; unsigned char* ws; };
typedef __attribute__((address_space(4))) const char* kaddr_t;
__device__ __forceinline__ const float* in_ptr(int i) { kaddr_t k = (kaddr_t)__builtin_amdgcn_kernarg_segment_ptr(); asm volatile("" : "+s"(k)); return (const float*)*(__attribute__((address_space(4))) const unsigned long long*)(k + 8 * i); }
struct Frame {
    LAS unsigned char* lds;
    unsigned* ctl;
    unsigned char* ws;
    int vcu, G, wv;
    float* out;
};

__device__ __forceinline__ int fresh_tid(int wv) { int l; asm volatile("v_mbcnt_lo_u32_b32 %0, -1, 0\n\tv_mbcnt_hi_u32_b32 %0, -1, %0" : "=v"(l)); return wv * 64 + l; }
#define PHASE_IDS() const int tid = fresh_tid(F.wv); const int lane = tid & 63; const int wave = __builtin_amdgcn_readfirstlane(tid >> 6); (void)tid; (void)lane; (void)wave
__device__ __forceinline__ int row_t(int row) { return row % TPB; }
__device__ __forceinline__ int row_b(int row) { return row / TPB; }
__device__ __forceinline__ int row_modidx(int row) { return (row % TPB) < CTXL ? 2 : row / TPB; }

__device__ __forceinline__ const float* modp(const Frame& F, int l, int mi, int which) { return (const float*)(F.ws + WS_MOD) + ((size_t)(l * 3 + mi) * 6 + which) * DM; }

struct EpiG1 {
    bf16_t* P; const float* bgate; const float* ropec; const float* ropes; const float* hsc = nullptr; const float* wsc = nullptr;
    struct Prep { f32x4 s[2][2]; float hs[8]; };
    __device__ __forceinline__ Prep prep(const pg8::Unit& u, int cit, int rbase) const { Prep p;
#pragma unroll
        for (int bj = 0; bj < 2; ++bj) { const int col = u.pn * 256 + bj * 128 + cit;
            if (wsc) { p.s[bj][0] = *(const f32x4*)(wsc + col); p.s[bj][1] = *(const f32x4*)(wsc + col + 4); } else { p.s[bj][0] = (f32x4){1.f, 1.f, 1.f, 1.f}; p.s[bj][1] = p.s[bj][0]; } }
#pragma unroll
        for (int k = 0; k < 8; ++k) p.hs[k] = wsc ? hsc[u.pm * 256 + rbase + (k >> 2) * 128 + (k & 3) * 16] : 1.0f;
        return p; }
    __device__ __forceinline__ void row(const pg8::Unit& u, int rit, int cit, const f32x4 (&a)[2][2], const Prep& pp, int k) const {
        const int grow = u.pm * 256 + rit;
        const float hs = pp.hs[k];
#pragma unroll
        for (int bj = 0; bj < 2; ++bj) {
            const int col = u.pn * 256 + bj * 128 + cit;
            if (u.pn == 24 && col >= CKR + 64) continue;
            float v[8] = {a[bj][0][0], a[bj][0][1], a[bj][0][2], a[bj][0][3], a[bj][1][0], a[bj][1][1], a[bj][1][2], a[bj][1][3]};
            if (wsc) { const f32x4 s0 = pp.s[bj][0], s1 = pp.s[bj][1];
                v[0] *= hs * s0[0]; v[1] *= hs * s0[1]; v[2] *= hs * s0[2]; v[3] *= hs * s0[3]; v[4] *= hs * s1[0]; v[5] *= hs * s1[1]; v[6] *= hs * s1[2]; v[7] *= hs * s1[3]; }
            if (u.pn >= 8 && u.pn < 24) {
                const f32x4 b0 = *(const f32x4*)(bgate + col - CGATE), b1 = *(const f32x4*)(bgate + col - CGATE + 4);
                v[0] = sigmoidf_(v[0] + b0[0]); v[1] = sigmoidf_(v[1] + b0[1]); v[2] = sigmoidf_(v[2] + b0[2]); v[3] = sigmoidf_(v[3] + b0[3]);
                v[4] = sigmoidf_(v[4] + b1[0]); v[5] = sigmoidf_(v[5] + b1[1]); v[6] = sigmoidf_(v[6] + b1[2]); v[7] = sigmoidf_(v[7] + b1[3]);
            } else if (u.pn == 24) {
                if (col >= CKR + 64) continue;
                const int t = grow % TPB;
                if (t >= CTXL) { const int s = t - CTXL, i0 = (col - CKR) >> 1;
                    const f32x4 cs = *(const f32x4*)(ropec + s * 32 + i0), sn = *(const f32x4*)(ropes + s * 32 + i0);
#pragma unroll
                    for (int p = 0; p < 4; ++p) { const float x1 = v[2 * p], x2 = v[2 * p + 1]; v[2 * p] = x1 * cs[p] - x2 * sn[p]; v[2 * p + 1] = x1 * sn[p] + x2 * cs[p]; } }
            }
            *(u32x4*)(P + (size_t)grow * INWP + col) = pack8(v);
        }
    }
};
struct EpiQ {
    bf16_t* Q; const float* ropec; const float* ropes;
    __device__ __forceinline__ void row(const pg8::Unit& u, int rit, int cit, const f32x4 (&a)[2][2]) const {
        const int grow = u.pm * 256 + rit; const int t = grow % TPB;
#pragma unroll
        for (int bj = 0; bj < 2; ++bj) {
            const int col = u.pn * 256 + bj * 128 + cit, d = col % DQK;
            float v[8] = {a[bj][0][0], a[bj][0][1], a[bj][0][2], a[bj][0][3], a[bj][1][0], a[bj][1][1], a[bj][1][2], a[bj][1][3]};
            if (d >= DN && t >= CTXL) { const int s = t - CTXL, i0 = (d - DN) >> 1;
                const f32x4 cs = *(const f32x4*)(ropec + s * 32 + i0), sn = *(const f32x4*)(ropes + s * 32 + i0);
#pragma unroll
                for (int p = 0; p < 4; ++p) { const float x1 = v[2 * p], x2 = v[2 * p + 1]; v[2 * p] = x1 * cs[p] - x2 * sn[p]; v[2 * p + 1] = x1 * sn[p] + x2 * cs[p]; } }
            *(u32x4*)(Q + (size_t)grow * 3072 + col) = pack8(v);
        }
    }
};
struct EpiKV {
    bf16_t* KN; bf16_t* V;
    __device__ __forceinline__ void row(const pg8::Unit& u, int rit, int cit, const f32x4 (&a)[2][2]) const {
        const int grow = u.pm * 256 + rit;
#pragma unroll
        for (int bj = 0; bj < 2; ++bj) {
            float v[8] = {a[bj][0][0], a[bj][0][1], a[bj][0][2], a[bj][0][3], a[bj][1][0], a[bj][1][1], a[bj][1][2], a[bj][1][3]};
            bf16_t* dst = (bj == 0 ? KN : V) + (size_t)grow * 2048 + u.pn * 128 + cit;
            *(u32x4*)dst = pack8(v);
        }
    }
};
struct EpiPool {
    bf16_t* POOLM; const bf16_t* P; const float* pscale;
    __device__ __forceinline__ void row(const pg8::Unit& u, int rit, int cit, const f32x4 (&a)[2][2]) const {
        const int grow = u.pm * 256 + rit;
#pragma unroll
        for (int bj = 0; bj < 2; ++bj) {
            const int col = u.pn * 256 + bj * 128 + cit;
            float v[8] = {a[bj][0][0], a[bj][0][1], a[bj][0][2], a[bj][0][3], a[bj][1][0], a[bj][1][1], a[bj][1][2], a[bj][1][3]};
            float g[8]; unpack8(*(const u32x4*)(P + (size_t)grow * INWP + CGATE + 2048 + col), g);
            const f32x4 s0 = *(const f32x4*)(pscale + col), s1 = *(const f32x4*)(pscale + col + 4);
            v[0] *= s0[0] * g[0]; v[1] *= s0[1] * g[1]; v[2] *= s0[2] * g[2]; v[3] *= s0[3] * g[3];
            v[4] *= s1[0] * g[4]; v[5] *= s1[1] * g[5]; v[6] *= s1[2] * g[6]; v[7] *= s1[3] * g[7];
            *(u32x4*)(POOLM + (size_t)grow * 2048 + col) = pack8(v);
        }
    }
};
struct EpiPlain {
    bf16_t* O; int ldc;
    __device__ __forceinline__ void row(const pg8::Unit& u, int rit, int cit, const f32x4 (&a)[2][2]) const {
        const int grow = u.pm * 256 + rit;
#pragma unroll
        for (int bj = 0; bj < 2; ++bj) {
            const int col = u.pn * 256 + bj * 128 + cit;
            float v[8] = {a[bj][0][0], a[bj][0][1], a[bj][0][2], a[bj][0][3], a[bj][1][0], a[bj][1][1], a[bj][1][2], a[bj][1][3]};
            *(u32x4*)(O + (size_t)grow * ldc + col) = pack8(v);
        }
    }
};
struct EpiSwiglu {
    bf16_t* ACT;
    __device__ __forceinline__ void row(const pg8::Unit& u, int rit, int cit, const f32x4 (&a)[2][2]) const {
        const int grow = u.pm * 256 + rit;
        float v[8];
#pragma unroll
        for (int n = 0; n < 2; ++n)
#pragma unroll
            for (int j = 0; j < 4; ++j) { const float g = a[0][n][j], up = a[1][n][j]; v[n * 4 + j] = g * sigmoidf_(g) * up; }
        *(u32x4*)((char*)ACT + (unsigned)(grow * DFF + u.pn * 128 + cit) * 2u) = pack8(v);
    }
};
struct EpiSwigluI8 {
    unsigned char* ws;
    struct Prep { f32x4 g0, g1, u0, u1; float hs[8]; };
    __device__ __forceinline__ Prep prep(const pg8::Unit& u, int cit, int rbase) const { const float* wg = (const float*)(ws + WS_WSC) + u.pn * 128 + cit; const float* wu = wg + DFF;
        Prep p; p.g0 = *(const f32x4*)wg; p.g1 = *(const f32x4*)(wg + 4); p.u0 = *(const f32x4*)wu; p.u1 = *(const f32x4*)(wu + 4);
        const float* hp = (const float*)(ws + WS_HSC) + u.pm * 256 + rbase;
#pragma unroll
        for (int k = 0; k < 8; ++k) p.hs[k] = hp[(k >> 2) * 128 + (k & 3) * 16];
        return p; }
    __device__ __forceinline__ void row(const pg8::Unit& u, int rit, int cit, const f32x4 (&a)[2][2], const Prep& pp, int k) const {
        const int grow = u.pm * 256 + rit, col = u.pn * 128 + cit;
        const float hs = pp.hs[k];
        const f32x4 g0 = pp.g0, g1 = pp.g1, u0 = pp.u0, u1 = pp.u1;
        float v[8];
#pragma unroll
        for (int j = 0; j < 4; ++j) { const float g = a[0][0][j] * (hs * g0[j]), up = a[1][0][j] * (hs * u0[j]); v[j] = g * sigmoidf_(g) * up; }
#pragma unroll
        for (int j = 0; j < 4; ++j) { const float g = a[0][1][j] * (hs * g1[j]), up = a[1][1][j] * (hs * u1[j]); v[4 + j] = g * sigmoidf_(g) * up; }
        *(u32x4*)(ws + WS_ACT + (unsigned)(grow * DFF + col) * 2u) = pack8(v);
    }
};
struct EpiSwiglu8 {
    unsigned char* ws;
    __device__ __forceinline__ void row(const pg8::Unit& u, int rit, int cit, const f32x4 (&a)[2][2]) const {
        const int grow = u.pm * 256 + rit;
        float v[8];
#pragma unroll
        for (int n = 0; n < 2; ++n)
#pragma unroll
            for (int j = 0; j < 4; ++j) { const float g = a[0][n][j] * pg8::FP8_WINV, up = a[1][n][j] * pg8::FP8_WINV; v[n * 4 + j] = g * sigmoidf_(g) * up; }
        u32x2 w; w.x = cvt4_fp8(v[0], v[1], v[2], v[3]); w.y = cvt4_fp8(v[4], v[5], v[6], v[7]);
        *(u32x2*)(ws + WS_ACT + (unsigned)(grow * DFF + u.pn * 128 + cit)) = w;
    }
};
struct EpiDown {
    unsigned char* ws; unsigned zstride; float sc;
    __device__ __forceinline__ void row(const pg8::Unit& u, int rit, int cit, const f32x4 (&a)[2][2]) const {
        const int grow = u.pm * 256 + rit;
#pragma unroll
        for (int bj = 0; bj < 2; ++bj) {
            float v[8] = {a[bj][0][0] * sc, a[bj][0][1] * sc, a[bj][0][2] * sc, a[bj][0][3] * sc, a[bj][1][0] * sc, a[bj][1][1] * sc, a[bj][1][2] * sc, a[bj][1][3] * sc};
            *(u32x4*)((char*)(ws + WS_Y2) + ((unsigned)u.z * zstride + (unsigned)(grow * DM + u.pn * 256 + bj * 128 + cit)) * 2u) = pack8(v);
        }
    }
};

struct SchedDense {
    pg8::GridOrder o; const char* A; const char* B; size_t lda2, ldb2;
    bool lat_only = false;
    __device__ __forceinline__ bool next(int i, pg8::Unit& u) const { u.z = 0; if (!o.next2(i, u.pm, u.pn)) return false; if (lat_only) u.pm += 1 + (u.pm >= 16 ? 1 : 0); return true; }
    __device__ __forceinline__ void ptrs(const pg8::Unit& u, const char*& a, const char*& b) const { a = A + (size_t)u.pm * 256 * lda2; b = B + (size_t)u.pn * 256 * ldb2; }
};
struct SchedG1Last {
    pg8::GridOrder o; const char* A; const char* B; int es = 2;
    __device__ __forceinline__ bool next(int i, pg8::Unit& u) const { u.z = 0;
        if (o.next2(i, u.pm, u.pn)) { u.pm += 1 + (u.pm >= 16 ? 1 : 0); return true; }
        const int k = i * o.G + o.c - o.nwg; if (k < 0 || k >= 6) return false;
        u.pm = (k / 3) * 17; u.pn = (k % 3) == 2 ? 24 : 2 + (k % 3); return true; }
    __device__ __forceinline__ void ptrs(const pg8::Unit& u, const char*& a, const char*& b) const { a = A + (size_t)u.pm * 256 * DM * es; b = B + (size_t)u.pn * 256 * DM * es; }
};
struct SchedPool {
    pg8::GridOrder o; const char* A; const char* B;
    __device__ __forceinline__ bool next(int i, pg8::Unit& u) const { u.z = 0; return o.next2(i, u.pm, u.pn); }
    __device__ __forceinline__ void ptrs(const pg8::Unit& u, const char*& a, const char*& b) const { a = A + ((size_t)u.pm * 256 * POOLW + (size_t)(u.pn >> 1) * 256) * 2; b = B + (size_t)u.pn * 256 * 256 * 2; }
};
struct SchedSplitK {
    pg8::GridOrder o; const char* A; const char* B; int nN;
    __device__ __forceinline__ bool next(int i, pg8::Unit& u) const { int pn2; if (!o.next2(i, u.pm, pn2)) return false; u.pn = pn2 % nN; u.z = pn2 / nN; return true; }
    __device__ __forceinline__ void ptrs(const pg8::Unit& u, const char*& a, const char*& b) const { a = A + ((size_t)u.pm * 256 * DFF + (size_t)u.z * KSPL) * 2; b = B + ((size_t)u.pn * 256 * DFF + (size_t)u.z * KSPL) * 2; }
};
struct SchedCtxSplit {
    pg8::GridOrder o; const char* A; const char* B; size_t lda2, ldb2; int nN; unsigned ksb;
    __device__ __forceinline__ bool next(int i, pg8::Unit& u) const { int c, pn2; if (!o.next2(i, c, pn2)) return false; u.pm = c * 17; u.pn = pn2 % nN; u.z = pn2 / nN; return true; }
    __device__ __forceinline__ void ptrs(const pg8::Unit& u, const char*& a, const char*& b) const { a = A + (size_t)u.pm * 256 * lda2 + (size_t)u.z * ksb; b = B + (size_t)u.pn * 256 * ldb2 + (size_t)u.z * ksb; }
};
struct EpiCtxPart {
    unsigned char* ws;
    __device__ __forceinline__ void row(const pg8::Unit& u, int rit, int cit, const f32x4 (&a)[2][2]) const {
        const int crow = (u.pm ? CTXL : 0) + rit;
#pragma unroll
        for (int bj = 0; bj < 2; ++bj) {
            float* dst = (float*)(ws + WS_YC + ((unsigned)(u.z * (NB * CTXL) + crow) * DM + (unsigned)(u.pn * 256 + bj * 128 + cit)) * 4u);
            *(f32x4*)dst = a[bj][0]; *(f32x4*)(dst + 4) = a[bj][1];
        }
    }
};
struct MoeTiles { const volatile LAS int* tb; int total;
    __device__ __forceinline__ int get(int k) const { return __builtin_amdgcn_readfirstlane(tb[k]); } };
__device__ __forceinline__ int moe_expert_of(const MoeTiles& mt, int pm) { int e = 0;
#pragma unroll
    for (int k = 1; k < NE; ++k) e += (pm >= mt.get(k)) ? 1 : 0;
    return e; }
constexpr int MOE_ES = MOE_FP8 ? 1 : 2;
struct SchedMoeUp {
    pg8::GridOrder o; MoeTiles mt; const char* A; const char* B;
    __device__ __forceinline__ bool next(int i, pg8::Unit& u) const { u.z = 0; return o.next2(i, u.pm, u.pn); }
    __device__ __forceinline__ void ptrs(const pg8::Unit& u, const char*& a, const char*& b) const { const int e = moe_expert_of(mt, u.pm);
#if MOE_DIRECT
        a = A + ((size_t)e * NLAT + (size_t)(u.pm - mt.get(e)) * 256) * DM;
#else
        a = A + (size_t)u.pm * 256 * DM * MOE_ES;
#endif
        b = B + (size_t)e * SZ_WGU + (size_t)u.pn * 256 * DM * MOE_ES; }
};
struct SchedMoeDown {
    pg8::GridOrder o; MoeTiles mt; const char* A; const char* B; int nN;
    __device__ __forceinline__ bool next(int i, pg8::Unit& u) const { int pn2; if (!o.next2(i, u.pm, pn2)) return false; u.pn = pn2 % nN; u.z = pn2 / nN; return true; }
    __device__ __forceinline__ void ptrs(const pg8::Unit& u, const char*& a, const char*& b) const { const int e = moe_expert_of(mt, u.pm);
        a = A + ((size_t)u.pm * 256 * DFF + (size_t)u.z * KSPL) * MOE_ES; b = B + (size_t)e * SZ_WD + ((size_t)u.pn * 256 * DFF + (size_t)u.z * KSPL) * MOE_ES; }
};

namespace att {
constexpr int NW = 8, QBLK = 32, KVBLK = 64;
constexpr int LDQ = 3072, LDKN = 2048, LDKR = INWP, LDV = 2048;
constexpr int SHM_V = 16384, SHM_KN = 16384, SHM_KR = 8192;
constexpr int OFF_V = 0, OFF_KN = 2 * SHM_V, OFF_KR = OFF_KN + 2 * SHM_KN, OFF_WS = OFF_KR + 2 * SHM_KR, OFF_QR = OFF_WS + NW * 64 * 4, ATT_LDS = OFF_QR + NW * 4096;
constexpr float THR = 8.f;
struct Out { unsigned char* ws;
    __device__ __forceinline__ void put(int grow, int hcol, float val) const {
        const bf16_t* P = (const bf16_t*)(ws + WS_P); const bf16_t* POOLM = (const bf16_t*)(ws + WS_POOLM); bf16_t* MB = (bf16_t*)(ws + WS_MB);
        const unsigned op = ((unsigned)grow * INWP + CGATE + hcol) * 2u, om = ((unsigned)grow * 2048u + hcol) * 2u;
        const float ga = bf2f(*(const bf16_t*)((const char*)P + op)), pm = bf2f(*(const bf16_t*)((const char*)POOLM + om));
        *(bf16_t*)((char*)MB + om) = (bf16_t)f2bf(ga * val + pm);
    }
};
#if !NAIVE_ATTN
#define KSWZ(row, colB) ((row) * 256 + ((colB) ^ (((row) & 15) << 4)))
#define KRSWZ(row, ch) ((row) * 128 + ((((ch) ^ (((row) >> 1) & 7))) << 4))
#define SBAR() __builtin_amdgcn_sched_barrier(0)
__device__ __forceinline__ int crow(int r, int hi) { return (r & 3) + 8 * (r >> 2) + 4 * hi; }
__device__ __forceinline__ void partialSM(f32x16& p0, f32x16& p1, float& m_reg, float& mn, float& alpha) {
    constexpr float C = ATTN_SCALE * 1.4426950408889634f;
    float pmax = p0[0];
#pragma unroll
    for (int r = 1; r < 16; ++r) pmax = fmaxf(pmax, p0[r]);
#pragma unroll
    for (int r = 0; r < 16; ++r) pmax = fmaxf(pmax, p1[r]);
    { auto rr = __builtin_amdgcn_permlane32_swap(__float_as_uint(pmax), __float_as_uint(pmax), false, false);
      pmax = fmaxf(__uint_as_float(rr[0]), __uint_as_float(rr[1])); }
    if (__builtin_expect(__all(pmax - m_reg <= THR / ATTN_SCALE), 1)) { mn = m_reg; alpha = 1.f; }
    else { mn = fmaxf(m_reg, pmax); alpha = __builtin_amdgcn_exp2f((m_reg - mn) * C); m_reg = mn; }
    const float mnC = -mn * C;
#pragma unroll
    for (int r = 0; r < 16; ++r) p0[r] = fmaf(p0[r], C, mnC);
#pragma unroll
    for (int r = 0; r < 16; ++r) p1[r] = fmaf(p1[r], C, mnC);
#pragma unroll
    for (int r = 0; r < 16; ++r) p0[r] = __builtin_amdgcn_exp2f(p0[r]);
}
__device__ __forceinline__ void finishSM(f32x16& p0, f32x16& p1, float alpha, float& l_reg, bf16x8& pa0, bf16x8& pa1, bf16x8& pa2, bf16x8& pa3) {
#pragma unroll
    for (int r = 0; r < 16; ++r) p1[r] = __builtin_amdgcn_exp2f(p1[r]);
    float ps = 0;
#pragma unroll
    for (int r = 0; r < 16; ++r) ps += p0[r];
#pragma unroll
    for (int r = 0; r < 16; ++r) ps += p1[r];
    { auto rr = __builtin_amdgcn_permlane32_swap(__float_as_uint(ps), __float_as_uint(ps), false, false);
      ps = __uint_as_float(rr[0]) + __uint_as_float(rr[1]); }
    l_reg = l_reg * alpha + ps;
#define PK4(P_, BASE, OUT) do { unsigned a0 = cvt_pk_bf16(P_[BASE + 0], P_[BASE + 1]), a1 = cvt_pk_bf16(P_[BASE + 2], P_[BASE + 3]);   \
    unsigned b0 = cvt_pk_bf16(P_[BASE + 4], P_[BASE + 5]), b1 = cvt_pk_bf16(P_[BASE + 6], P_[BASE + 7]);                              \
    auto r0 = __builtin_amdgcn_permlane32_swap(a0, b0, false, false); auto r1 = __builtin_amdgcn_permlane32_swap(a1, b1, false, false); \
    u32x4 w = {r0[0], r1[0], r0[1], r1[1]}; OUT = *reinterpret_cast<bf16x8*>(&w); } while (0)
    PK4(p0, 0, pa0); PK4(p0, 8, pa1); PK4(p1, 0, pa2); PK4(p1, 8, pa3);
#undef PK4
}
__device__ __forceinline__ void kfrag(const char* Kn, const char* Kr, int d0, int r32, int hi, bf16x8& b0, bf16x8& b1) {
    if (d0 < 8) { const int cb = (d0 * 16 + hi * 8) * 2; b0 = *reinterpret_cast<const bf16x8*>(Kn + KSWZ(r32, cb)); b1 = *reinterpret_cast<const bf16x8*>(Kn + KSWZ(32 + r32, cb)); }
    else { const int ch = (d0 - 8) * 2 + hi; b0 = *reinterpret_cast<const bf16x8*>(Kr + KRSWZ(r32, ch)); b1 = *reinterpret_cast<const bf16x8*>(Kr + KRSWZ(32 + r32, ch)); }
}
struct NoPiece { __device__ __forceinline__ void operator()(int) const {} };
template <class PF>
__device__ __forceinline__ void qkt(f32x16& p0, f32x16& p1, const char* Kn, const char* Kr, const bf16x8* qr, int r32, int hi, const PF& piece) {
    p0 = f32x16{}; p1 = f32x16{};
    bf16x8 a0, a1, c0, c1, n0, n1;
    kfrag(Kn, Kr, 0, r32, hi, a0, a1); kfrag(Kn, Kr, 1, r32, hi, c0, c1);
#pragma unroll
    for (int d0 = 0; d0 < 12; ++d0) {
        if (d0 + 2 < 12) kfrag(Kn, Kr, d0 + 2, r32, hi, n0, n1);
        __builtin_amdgcn_sched_barrier(0);
        p0 = __builtin_amdgcn_mfma_f32_32x32x16_bf16(a0, qr[d0], p0, 0, 0, 0);
        p1 = __builtin_amdgcn_mfma_f32_32x32x16_bf16(a1, qr[d0], p1, 0, 0, 0);
        __builtin_amdgcn_sched_barrier(0);
        piece(d0);
        __builtin_amdgcn_sched_barrier(0);
        a0 = c0; a1 = c1; c0 = n0; c1 = n1;
    }
}
__device__ __forceinline__ int v_st(int k, int c) { const int kk = (k & ~0xC) | ((k & 4) << 1) | ((k & 8) >> 1); return ((kk >> 3) * 4 + (c >> 5)) * 512 + ((kk & 7) * 32 + (c & 31)) * 2; }
__device__ __forceinline__ int v_rd_base(int lane) { return ((lane & 3) << 3) | (((lane >> 2) & 3) << 6) | (((lane >> 4) & 1) << 5) | (((lane >> 5) & 1) << 8); }
constexpr int v_rd_off(int d0, int ks, int half) { return d0 * 512 + ks * 4096 + half * 2048; }
template <int OFF> __device__ __forceinline__ s16x4 tr_read(int vb) {
    s16x4 r; asm volatile("ds_read_b64_tr_b16 %0, %1 offset:%2" : "=&v"(r) : "v"(vb), "i"(OFF) : "memory"); return r;
}
template <int D0> __device__ __forceinline__ void pv_one(f32x16& od, int vb, bf16x8 pa0, bf16x8 pa1, bf16x8 pa2, bf16x8 pa3) {
    const s16x4 l0 = tr_read<v_rd_off(D0, 0, 0)>(vb), h0 = tr_read<v_rd_off(D0, 0, 1)>(vb), l1 = tr_read<v_rd_off(D0, 1, 0)>(vb), h1 = tr_read<v_rd_off(D0, 1, 1)>(vb);
    const s16x4 l2 = tr_read<v_rd_off(D0, 2, 0)>(vb), h2 = tr_read<v_rd_off(D0, 2, 1)>(vb), l3 = tr_read<v_rd_off(D0, 3, 0)>(vb), h3 = tr_read<v_rd_off(D0, 3, 1)>(vb);
    asm volatile("s_waitcnt lgkmcnt(0)" ::: "memory"); SBAR();
#define PK(L, H) (bf16x8){L[0], L[1], L[2], L[3], H[0], H[1], H[2], H[3]}
    od = __builtin_amdgcn_mfma_f32_32x32x16_bf16(pa0, PK(l0, h0), od, 0, 0, 0);
    od = __builtin_amdgcn_mfma_f32_32x32x16_bf16(pa1, PK(l1, h1), od, 0, 0, 0);
    od = __builtin_amdgcn_mfma_f32_32x32x16_bf16(pa2, PK(l2, h2), od, 0, 0, 0);
    od = __builtin_amdgcn_mfma_f32_32x32x16_bf16(pa3, PK(l3, h3), od, 0, 0, 0);
#undef PK
}
template <class PF>
__device__ __forceinline__ void pv_d0(f32x16* o, int vb, bf16x8 pa0, bf16x8 pa1, bf16x8 pa2, bf16x8 pa3, const PF& piece) {
    pv_one<0>(o[0], vb, pa0, pa1, pa2, pa3); SBAR(); piece(0); SBAR(); pv_one<1>(o[1], vb, pa0, pa1, pa2, pa3); SBAR(); piece(1); SBAR();
    pv_one<2>(o[2], vb, pa0, pa1, pa2, pa3); SBAR(); piece(2); SBAR(); pv_one<3>(o[3], vb, pa0, pa1, pa2, pa3); SBAR(); piece(3); SBAR();
}
constexpr int SLOTB = 40960, SL_V = 0, SL_KN = 16384, SL_KR = 32768, OFF_WS3 = 3 * SLOTB, ATT_LDS3 = OFF_WS3 + NW * 64 * 4;
constexpr int AC_JOBS = 18, AC_STRIPS_PER_JOB = (DM / 32) * (DFF / 32) / (8 * 32), AC_STRIPS = AC_JOBS * AC_STRIPS_PER_JOB, AC_STEPS = 32;
static_assert(AC_STRIPS_PER_JOB == 56 && AC_STRIPS <= 4 * 256 && 2 * AC_STEPS + 2 <= TPB / KVBLK - 2, "conversion strips fit the attention units' tile steps (one item per two steps)");
constexpr int AC_STG_HI = MISC_OFF + 1024;
static_assert(ATT_LDS3 + 4096 <= LDSCTL_OFF && AC_STG_HI + 7 * 4096 <= LDS_BYTES && AC_STG_HI % 16 == 0, "conversion staging blocks");
__device__ __forceinline__ void attn_unit(int qrow0, int krow0, int nkeys, int h, char* lds, LAS unsigned char* lds3, const Out& O, int wv, int ac_slot) {
    const bf16_t* __restrict__ Qg = (const bf16_t*)(O.ws + WS_Q);
    const int tid = fresh_tid(wv), wid = __builtin_amdgcn_readfirstlane(tid >> 6), lane = tid & 63, r32 = lane & 31, hi = lane >> 5;
    float* ws = (float*)(lds + OFF_WS3) + wid * 64; float* li_l = ws; float* al_l = ws + 32;
    float m_reg = -1e30f, l_reg = 0; f32x16 o[4] = {}; bf16x8 qr[12];
    { const char* Qb = (const char*)(Qg + (size_t)(qrow0 + wid * QBLK) * LDQ + h * DQK); const unsigned qo = (unsigned)(r32 * LDQ + hi * 8) * 2u;
#pragma unroll
      for (int d0 = 0; d0 < 12; ++d0) qr[d0] = *reinterpret_cast<const bf16x8*>(Qb + qo + d0 * 32); }
    unsigned vofV[1], vofK[1], vofR;
#pragma unroll
    for (int i = 0; i < 1; ++i) { const int p = (i * 8 + wid) * 1024 + lane * 16;
        { const int sub = p >> 9, kkh = sub >> 2, ch = sub & 3, within = p & 511, kkl = within >> 6, cl = (within & 63) >> 1, kk = kkh * 8 + kkl;
          const int k = (kk & ~0xC) | ((kk & 4) << 1) | ((kk & 8) >> 1), c = ch * 32 + cl; vofV[i] = (unsigned)(k * LDV + c) * 2u; }
        { const int row = p >> 8, cs = (p & 255) >> 4, c16 = cs ^ (row & 15); vofK[i] = (unsigned)(row * LDKN + c16 * 8) * 2u; } }
    { const int p = wid * 1024 + lane * 16, row = p >> 7, cs = (p & 127) >> 4, chh = cs ^ ((row >> 1) & 7); vofR = (unsigned)(row * LDKR + chh * 8) * 2u; }
    const __amdgpu_buffer_rsrc_t rs = __builtin_amdgcn_make_buffer_rsrc((void*)O.ws, 0, 0xffffffff, 0x00020000);
    const unsigned sV0 = (unsigned)(WS_V + ((size_t)krow0 * LDV + h * DV) * 2), sK0 = (unsigned)(WS_KN + ((size_t)krow0 * LDKN + h * DN) * 2), sR0 = (unsigned)(WS_P + ((size_t)krow0 * LDKR + CKR) * 2);
#define DMA(t, slot) do { const unsigned tv_ = sV0 + (unsigned)(t) * (KVBLK * LDV * 2), tk_ = sK0 + (unsigned)(t) * (KVBLK * LDKN * 2), tr_ = sR0 + (unsigned)(t) * (KVBLK * LDKR * 2); \
    _Pragma("unroll") for (int i_ = 0; i_ < 2; ++i_) __builtin_amdgcn_raw_ptr_buffer_load_lds(rs, (LAS void*)(lds3 + (slot) + SL_V + (i_ * 8 + wid) * 1024), 16, (int)vofV[0], (int)(tv_ + (unsigned)i_ * (32u * LDV * 2u)), 0, 0); \
    _Pragma("unroll") for (int i_ = 0; i_ < 2; ++i_) __builtin_amdgcn_raw_ptr_buffer_load_lds(rs, (LAS void*)(lds3 + (slot) + SL_KN + (i_ * 8 + wid) * 1024), 16, (int)vofK[0], (int)(tk_ + (unsigned)i_ * (32u * LDKN * 2u)), 0, 0); \
    __builtin_amdgcn_raw_ptr_buffer_load_lds(rs, (LAS void*)(lds3 + (slot) + SL_KR + wid * 1024), 16, (int)vofR, (int)tr_, 0, 0); } while (0)
#define LANDED() do { asm volatile("s_waitcnt vmcnt(0)" ::: "memory"); __syncthreads(); } while (0)
#define RESC(a) do { if (__any((a) < 1.f)) { if (hi == 0) al_l[r32] = (a); asm volatile("s_waitcnt lgkmcnt(0)" ::: "memory"); \
    _Pragma("unroll") for (int d = 0; d < 4; ++d) _Pragma("unroll") for (int r = 0; r < 16; ++r) o[d][r] *= al_l[crow(r, hi)]; } } while (0)
#define ROT3() do { const int t_ = s_prev; s_prev = s_cur; s_cur = s_next; s_next = t_; } while (0)
    const int vbl = (int)(uintptr_t)lds + SL_V + v_rd_base(lane);
    f32x16 pA0, pA1, pB0, pB1; float mnA, mnB, alA, alB; bf16x8 pa0, pa1, pa2, pa3; const int NT = nkeys / KVBLK;
    int s_prev = 0, s_cur = SLOTB, s_next = 2 * SLOTB;
    int ac_left = 0, ac_pend = 0, ac_N = DFF, ac_K = DM, ac_t = 0; unsigned ac_src = 0, ac_dst = 0;
    { const int sl = __builtin_amdgcn_readfirstlane(ac_slot);
      if (sl >= 0 && sl < AC_STRIPS) { const int jb = sl / AC_STRIPS_PER_JOB, r = sl - jb * AC_STRIPS_PER_JOB, e = jb / 3; ac_t = jb - e * 3;
          if (ac_t < 2) { const int kh = r / (DFF / 256), ns = r - kh * (DFF / 256), n0 = (ns * 8 + wid) * 32, k0 = kh * (AC_STEPS * 32);
              ac_src = (unsigned)e * (unsigned)(DM * DFF * 4) + ((unsigned)k0 * (unsigned)DFF + (unsigned)n0) * 4u;
              ac_dst = (unsigned)(WS_WEGU + (size_t)e * SZ_WGU) + (unsigned)((n0 >> 7) * 256 + ac_t * 128 + (n0 & 127)) * (unsigned)DM + (unsigned)k0; }
          else { const int part = r >> 3, ns = r & 7, n0 = (ns * 8 + wid) * 32, k0 = part * (AC_STEPS * 32); ac_N = DM; ac_K = DFF;
              ac_src = (unsigned)e * (unsigned)(DM * DFF * 4) + ((unsigned)k0 * (unsigned)DM + (unsigned)n0) * 4u;
              ac_dst = (unsigned)(WS_WED + (size_t)e * SZ_WD) + (unsigned)n0 * (unsigned)DFF + (unsigned)k0; }
          ac_left = AC_STEPS; } }
    const __amdgpu_buffer_rsrc_t ac_rs = __builtin_amdgcn_make_buffer_rsrc((void*)in_ptr(24 + ac_t), 0, 0xffffffff, 0x00020000);
    const int ac_stg = wid == 0 ? ATT_LDS3 : AC_STG_HI + (wid - 1) * 4096;
#define AC_PROC() do { \
        if (ac_pend) { const unsigned a0_ = (unsigned)(uintptr_t)(lds3 + ac_stg) + (unsigned)((16 * hi) * 32 + r32) * 4u, a1_ = a0_ + 1024u; f32x2 q0_, q1_, q2_, q3_, q4_, q5_, q6_, q7_; \
            asm volatile("ds_read2_b32 %0, %8 offset1:32\n\tds_read2_b32 %1, %8 offset0:64 offset1:96\n\tds_read2_b32 %2, %8 offset0:128 offset1:160\n\tds_read2_b32 %3, %8 offset0:192 offset1:224\n\t" \
                         "ds_read2_b32 %4, %9 offset1:32\n\tds_read2_b32 %5, %9 offset0:64 offset1:96\n\tds_read2_b32 %6, %9 offset0:128 offset1:160\n\tds_read2_b32 %7, %9 offset0:192 offset1:224\n\ts_waitcnt lgkmcnt(0)" \
                         : "=&v"(q0_), "=&v"(q1_), "=&v"(q2_), "=&v"(q3_), "=&v"(q4_), "=&v"(q5_), "=&v"(q6_), "=&v"(q7_) : "v"(a0_), "v"(a1_) : "memory"); \
            const float sc_ = (float)(1 << pg8::FP8_WSHIFT); q0_ *= sc_; q1_ *= sc_; q2_ *= sc_; q3_ *= sc_; q4_ *= sc_; q5_ *= sc_; q6_ *= sc_; q7_ *= sc_; \
            u32x4 w_; w_.x = cvt4_fp8(q0_.x, q0_.y, q1_.x, q1_.y); w_.y = cvt4_fp8(q2_.x, q2_.y, q3_.x, q3_.y); w_.z = cvt4_fp8(q4_.x, q4_.y, q5_.x, q5_.y); w_.w = cvt4_fp8(q6_.x, q6_.y, q7_.x, q7_.y); \
            *(u32x4*)(O.ws + (ac_dst - 32u + (unsigned)(r32 * ac_K + 16 * hi))) = w_; } \
        if (ac_pend) asm volatile("s_waitcnt lgkmcnt(0)" ::: "memory"); \
        ac_pend = 0; } while (0)
#define AC_PIECE(i_) do { const unsigned vo_ = (unsigned)((lane >> 3) * ac_N + (lane & 7) * 4) * 4u; \
        __builtin_amdgcn_raw_ptr_buffer_load_lds(ac_rs, (LAS void*)(lds3 + ac_stg + (i_) * 1024), 16, (int)vo_, (int)(ac_src + (unsigned)((i_) * 8 * 4) * (unsigned)ac_N), 0, 2); } while (0)
#define AC_ADV() do { ac_src += (unsigned)(32 * 4) * (unsigned)ac_N; ac_dst += 32u; ac_pend = 1; --ac_left; } while (0)
#define AC_STEP() do { AC_PROC(); if (ac_left) { AC_PIECE(0); AC_PIECE(1); AC_PIECE(2); AC_PIECE(3); AC_ADV(); } } while (0)
#define KVPIECE(pi_, tv_, tk_, tr_, slot_) do { \
        if ((pi_) < 2) __builtin_amdgcn_raw_ptr_buffer_load_lds(rs, (LAS void*)(lds3 + (slot_) + SL_V + ((pi_) * 8 + wid) * 1024), 16, (int)vofV[0], (int)((tv_) + (unsigned)((pi_) & 1) * (32u * LDV * 2u)), 0, 0); \
        else if ((pi_) < 4) __builtin_amdgcn_raw_ptr_buffer_load_lds(rs, (LAS void*)(lds3 + (slot_) + SL_KN + (((pi_) - 2) * 8 + wid) * 1024), 16, (int)vofK[0], (int)((tk_) + (unsigned)((pi_) & 1) * (32u * LDKN * 2u)), 0, 0); \
        else __builtin_amdgcn_raw_ptr_buffer_load_lds(rs, (LAS void*)(lds3 + (slot_) + SL_KR + wid * 1024), 16, (int)vofR, (int)(tr_), 0, 0); } while (0)
#define KVSPREAD(d0_, tq_, tv_, tk_, tr_, sn_) do { if ((tq_) >= 0) { if ((d0_) == 0) KVPIECE(0, tv_, tk_, tr_, sn_); else if ((d0_) == 3) KVPIECE(1, tv_, tk_, tr_, sn_); else if ((d0_) == 6) KVPIECE(2, tv_, tk_, tr_, sn_); \
        else if ((d0_) == 9) KVPIECE(3, tv_, tk_, tr_, sn_); else if ((d0_) == 11) KVPIECE(4, tv_, tk_, tr_, sn_); } } while (0)
    DMA(0, 0); DMA(1, SLOTB);
    LANDED();
    if (2 < NT) DMA(2, 2 * SLOTB);
    qkt(pA0, pA1, lds + SL_KN, lds + SL_KR, qr, r32, hi, NoPiece{}); partialSM(pA0, pA1, m_reg, mnA, alA);
    int pend_t = -1;
    for (int j = 1; j + 1 < NT; j += 2) {
        { const int tq = pend_t, tc = tq < 0 ? 0 : tq, sn = s_next; const unsigned tv_ = sV0 + (unsigned)tc * (KVBLK * LDV * 2), tk_ = sK0 + (unsigned)tc * (KVBLK * LDKN * 2), tr_ = sR0 + (unsigned)tc * (KVBLK * LDKR * 2);
          SBAR(); qkt(pB0, pB1, lds + s_cur + SL_KN, lds + s_cur + SL_KR, qr, r32, hi, [&](int d0) { KVSPREAD(d0, tq, tv_, tk_, tr_, sn); }); }
        finishSM(pA0, pA1, alA, l_reg, pa0, pa1, pa2, pa3); SBAR();
        pv_d0(o, vbl + s_prev, pa0, pa1, pa2, pa3, NoPiece{}); partialSM(pB0, pB1, m_reg, mnB, alB);
        RESC(alB);
        LANDED();
        AC_PROC();
        ROT3();
        { const int tq = j + 2 < NT ? j + 2 : -1, tc = tq < 0 ? 0 : tq, sn = s_next; const unsigned tv_ = sV0 + (unsigned)tc * (KVBLK * LDV * 2), tk_ = sK0 + (unsigned)tc * (KVBLK * LDKN * 2), tr_ = sR0 + (unsigned)tc * (KVBLK * LDKR * 2);
          SBAR(); qkt(pA0, pA1, lds + s_cur + SL_KN, lds + s_cur + SL_KR, qr, r32, hi, [&](int d0) { KVSPREAD(d0, tq, tv_, tk_, tr_, sn); }); }
        finishSM(pB0, pB1, alB, l_reg, pa0, pa1, pa2, pa3); SBAR();
        pv_d0(o, vbl + s_prev, pa0, pa1, pa2, pa3, NoPiece{});
        partialSM(pA0, pA1, m_reg, mnA, alA);
        RESC(alA);
        if (ac_left) { AC_PIECE(0); AC_PIECE(1); AC_PIECE(2); AC_PIECE(3); AC_ADV(); }
        if (ac_pend) asm volatile("s_waitcnt vmcnt(4)\n\ts_waitcnt lgkmcnt(0)" ::: "memory"); else asm volatile("s_waitcnt vmcnt(0)\n\ts_waitcnt lgkmcnt(0)" ::: "memory");
        __builtin_amdgcn_s_barrier(); asm volatile("" ::: "memory");
        ROT3();
        pend_t = j + 3 < NT ? j + 3 : -1;
    }
    SBAR(); qkt(pB0, pB1, lds + s_cur + SL_KN, lds + s_cur + SL_KR, qr, r32, hi, NoPiece{});
    finishSM(pA0, pA1, alA, l_reg, pa0, pa1, pa2, pa3); SBAR();
    pv_d0(o, vbl + s_prev, pa0, pa1, pa2, pa3, NoPiece{}); partialSM(pB0, pB1, m_reg, mnB, alB);
    RESC(alB);
    finishSM(pB0, pB1, alB, l_reg, pa0, pa1, pa2, pa3); SBAR();
    pv_d0(o, vbl + s_cur, pa0, pa1, pa2, pa3, NoPiece{});
    while (ac_pend) { asm volatile("s_waitcnt vmcnt(0)" ::: "memory"); AC_STEP(); }
    if (hi == 0) li_l[r32] = l_reg; asm volatile("s_waitcnt lgkmcnt(0)" ::: "memory");
    float rli[16];
#pragma unroll
    for (int r = 0; r < 16; ++r) rli[r] = __builtin_amdgcn_rcpf(li_l[crow(r, hi)]);
    __syncthreads();
    { LAS float* so = (LAS float*)lds3 + wid * 4096;
#pragma unroll
      for (int r = 0; r < 16; ++r)
#pragma unroll
          for (int d0 = 0; d0 < 4; ++d0) so[crow(r, hi) * 128 + d0 * 32 + r32] = o[d0][r] * rli[r];
      asm volatile("s_waitcnt lgkmcnt(0)" ::: "memory");
      int ln_; asm volatile("v_mbcnt_lo_u32_b32 %0, -1, 0\n\tv_mbcnt_hi_u32_b32 %0, -1, %0" : "=v"(ln_));
      const int rr = ln_ >> 4, c8 = (ln_ & 15) * 8;
      const unsigned og = ((unsigned)(qrow0 + wid * QBLK + rr) * INWP + CGATE + h * DV + c8) * 2u, om = ((unsigned)(qrow0 + wid * QBLK + rr) * 2048u + h * DV + c8) * 2u;
      const char* Pb = (const char*)(O.ws + WS_P); const char* PMb = (const char*)(O.ws + WS_POOLM); char* MBb = (char*)(O.ws + WS_MB);
#pragma unroll
      for (int hb = 0; hb < 8; hb += 4) {
      u32x4 g[4], pm[4];
#pragma unroll
      for (int q = 0; q < 4; ++q) { const int it = hb + q; g[q] = *(const u32x4*)(Pb + og + (unsigned)it * (4u * INWP * 2u)); pm[q] = *(const u32x4*)(PMb + om + (unsigned)it * (4u * 2048u * 2u)); }
      asm volatile("" ::: "memory");
#pragma unroll
      for (int q = 0; q < 4; ++q) { const int it = hb + q; const LAS float* sp = so + (it * 4 + rr) * 128 + c8; const f32x4 v0 = *(const LAS f32x4*)sp, v1 = *(const LAS f32x4*)(sp + 4);
          float gf[8], pf[8], ov[8]; unpack8(g[q], gf); unpack8(pm[q], pf);
          ov[0] = gf[0] * v0[0] + pf[0]; ov[1] = gf[1] * v0[1] + pf[1]; ov[2] = gf[2] * v0[2] + pf[2]; ov[3] = gf[3] * v0[3] + pf[3];
          ov[4] = gf[4] * v1[0] + pf[4]; ov[5] = gf[5] * v1[1] + pf[5]; ov[6] = gf[6] * v1[2] + pf[6]; ov[7] = gf[7] * v1[3] + pf[7];
          *(u32x4*)(MBb + om + (unsigned)it * (4u * 2048u * 2u)) = pack8(ov); }
      asm volatile("" ::: "memory"); } }
    __syncthreads();
#undef DMA
#undef LANDED
#undef RESC
#undef ROT3
#undef AC_STEP
#undef AC_PROC
#undef AC_PIECE
#undef AC_ADV
#undef KVPIECE
#undef KVSPREAD
}
#undef SBAR
#else
__device__ __forceinline__ void attn_naive_item(const bf16_t* Qg, const bf16_t* KNg, const bf16_t* Pg, const bf16_t* Vg, int grow, int krow0, int nkeys, int h,
                                                LAS float* sc, LAS float* qs, int lane, const Out& O) {
#pragma unroll
    for (int i = 0; i < 3; ++i) qs[lane + 64 * i] = bf2f(Qg[(size_t)grow * LDQ + h * DQK + lane + 64 * i]);
    asm volatile("s_waitcnt lgkmcnt(0)" ::: "memory");
    float mx = -1e30f;
    for (int k = lane; k < nkeys; k += 64) {
        const bf16_t* kn = KNg + (size_t)(krow0 + k) * LDKN + h * DN; const bf16_t* kr = Pg + (size_t)(krow0 + k) * LDKR + CKR;
        float s = 0.f;
        for (int c = 0; c < 16; ++c) { float kv[8]; unpack8(*(const u32x4*)(kn + c * 8), kv);
#pragma unroll
            for (int j = 0; j < 8; ++j) s += kv[j] * qs[c * 8 + j]; }
        for (int c = 0; c < 8; ++c) { float kv[8]; unpack8(*(const u32x4*)(kr + c * 8), kv);
#pragma unroll
            for (int j = 0; j < 8; ++j) s += kv[j] * qs[128 + c * 8 + j]; }
        s *= ATTN_SCALE; sc[k] = s; mx = fmaxf(mx, s);
    }
    mx = wave_max(mx);
    float sum = 0.f;
    for (int k = lane; k < nkeys; k += 64) { const float p = fast_exp(sc[k] - mx); sc[k] = p; sum += p; }
    sum = wave_sum(sum);
    asm volatile("s_waitcnt lgkmcnt(0)" ::: "memory");
    float o0 = 0.f, o1 = 0.f;
    for (int k = 0; k < nkeys; ++k) { const float p = sc[k]; const bf16_t* v = Vg + (size_t)(krow0 + k) * LDV + h * DV;
        o0 += p * bf2f(v[lane]); o1 += p * bf2f(v[lane + 64]); }
    const float inv = 1.f / sum;
    O.put(grow, h * DV + lane, o0 * inv); O.put(grow, h * DV + lane + 64, o1 * inv);
    asm volatile("s_waitcnt lgkmcnt(0)" ::: "memory");
}
#endif
}

__device__ __forceinline__ void ld_row_f32(const float* p, f32x4 (&v)[8], int lane) {
#pragma unroll
    for (int j = 0; j < 8; ++j) v[j] = *(const f32x4*)(p + 4 * lane + 256 * j);
}
__device__ __forceinline__ void st_row_f32(float* p, const f32x4 (&v)[8], int lane) {
#pragma unroll
    for (int j = 0; j < 8; ++j) *(f32x4*)(p + 4 * lane + 256 * j) = v[j];
}
__device__ __forceinline__ void ld_row_bf16(const bf16_t* p, f32x4 (&v)[8], int lane) {
#pragma unroll
    for (int j = 0; j < 8; ++j) { const u32x2 w = *(const u32x2*)(p + 4 * lane + 256 * j);
        v[j] = (f32x4){__uint_as_float(w.x << 16), __uint_as_float(w.x & 0xffff0000u), __uint_as_float(w.y << 16), __uint_as_float(w.y & 0xffff0000u)}; }
}
__device__ __forceinline__ void st_row_bf16(bf16_t* p, const f32x4 (&v)[8], int lane) {
#pragma unroll
    for (int j = 0; j < 8; ++j) { u32x2 w; w.x = cvt_pk_bf16(v[j][0], v[j][1]); w.y = cvt_pk_bf16(v[j][2], v[j][3]); *(u32x2*)(p + 4 * lane + 256 * j) = w; }
}
__device__ __forceinline__ float row_rstd(const f32x4 (&v)[8]) {
    float s = 0.f;
#pragma unroll
    for (int j = 0; j < 8; ++j) s += (v[j][0] * v[j][0] + v[j][1] * v[j][1]) + (v[j][2] * v[j][2] + v[j][3] * v[j][3]);
    s = wave_sum(s);
    return 1.0f / sqrtf(s * (1.0f / DM) + EPS);
}
__device__ __forceinline__ void norm_mod(const f32x4 (&x)[8], f32x4 (&o)[8], const float* gain, const float* shift, const float* scale, int lane) {
    const float rs = row_rstd(x);
#pragma unroll
    for (int j = 0; j < 8; ++j) { const int c = 4 * lane + 256 * j; const f32x4 g = *(const f32x4*)(gain + c), sh = *(const f32x4*)(shift + c), sc = *(const f32x4*)(scale + c);
        o[j] = x[j] * rs * g * (sc + 1.0f) + sh; }
}

#define LV_A(F) ((LAS float*)(F).lds)
#define LV_B(F) ((LAS float*)(F).lds + 3 * DM)
#define LV_C(F) ((LAS float*)(F).lds + 6 * DM)
#define LV_G1(F) ((LAS float*)(F).lds + 9 * DM)
#define LV_G2(F) ((LAS float*)(F).lds + 10 * DM)
__device__ __forceinline__ void stage3(LAS float* dst, const float* src, int tid) {
#pragma unroll
    for (int mi = 0; mi < 3; ++mi) *(LAS f32x4*)(dst + mi * DM + 4 * tid) = *(const f32x4*)(src + (size_t)mi * 6 * DM + 4 * tid);
}
__device__ __forceinline__ void stage1(LAS float* dst, const float* src, int tid) { *(LAS f32x4*)(dst + 4 * tid) = *(const f32x4*)(src + 4 * tid); }
__device__ __forceinline__ void norm_mod_l(const f32x4 (&x)[8], f32x4 (&o)[8], const LAS float* gain, const LAS float* shift, const LAS float* scale, int lane) {
    const float rs = row_rstd(x);
#pragma unroll
    for (int j = 0; j < 8; ++j) { const int c = 4 * lane + 256 * j; const f32x4 g = *(const LAS f32x4*)(gain + c), sh = *(const LAS f32x4*)(shift + c), sc = *(const LAS f32x4*)(scale + c);
        o[j] = x[j] * rs * g * (sc + 1.0f) + sh; }
}
__device__ __forceinline__ void st_row_i8(const Frame& F, int row, const f32x4 (&o)[8], int lane) {
    float mx = 0.f;
#pragma unroll
    for (int j = 0; j < 8; ++j) mx = fmaxf(fmaxf(mx, fmaxf(fabsf(o[j][0]), fabsf(o[j][1]))), fmaxf(fabsf(o[j][2]), fabsf(o[j][3])));
    mx = fmaxf(wave_max(mx), 1e-20f); const float inv = 127.0f / mx;
    unsigned char* h8 = F.ws + WS_H + (size_t)row * DM;
#pragma unroll
    for (int j = 0; j < 8; ++j) { const int q0 = (int)rintf(o[j][0] * inv), q1 = (int)rintf(o[j][1] * inv), q2 = (int)rintf(o[j][2] * inv), q3 = (int)rintf(o[j][3] * inv);
        *(unsigned*)(h8 + 4 * lane + 256 * j) = (unsigned)(q0 & 255) | ((unsigned)(q1 & 255) << 8) | ((unsigned)(q2 & 255) << 16) | ((unsigned)(q3 & 255) << 24); }
    if (lane == 0) ((float*)(F.ws + WS_HSC))[row] = mx * (1.0f / 127.0f);
}
__device__ __forceinline__ void phase_norm1_l0(const Frame& F) {
    PHASE_IDS(); const int gw = F.vcu * 8 + wave, NGW = F.G * 8;
    float* XRES = (float*)(F.ws + WS_XRES); bf16_t* H = (bf16_t*)(F.ws + WS_H);
    __syncthreads();
    stage3(LV_B(F), modp(F, 0, 0, 0), tid); stage3(LV_C(F), modp(F, 0, 0, 1), tid); stage1(LV_G1(F), in_ptr(6), tid);
    __syncthreads();
    for (int row = gw; row < R; row += NGW) {
        const int b = row / TPB, t = row % TPB;
        const float* src = t < CTXL ? in_ptr(2) + ((size_t)b * CTXL + t) * DM : in_ptr(0) + ((size_t)b * SEQ + (t - CTXL)) * DM;
        f32x4 x[8], o[8]; ld_row_f32(src, x, lane);
        const int mi = t < CTXL ? 2 : b;
        norm_mod_l(x, o, LV_G1(F), LV_B(F) + mi * DM, LV_C(F) + mi * DM, lane);
#if WIN_I8
        st_row_i8(F, row, o, lane);
#else
        st_row_bf16(H + (size_t)row * DM, o, lane);
#endif
    }
}
struct T2Row { u32x4 qv, kvv, wv[15], sv[4]; };
__device__ __forceinline__ void t2_load(const bf16_t* P, int row, int lane, T2Row& d) {
    const bf16_t* pr = P + (size_t)row * INWP; const int hv = lane >> 5, l32 = lane & 31;
    const int b = row / TPB, t = row % TPB, segrow0 = t < CTXL ? b * TPB : b * TPB + CTXL, L = t < CTXL ? CTXL : SEQ, tt = t < CTXL ? t : t - CTXL;
    d.qv = *(const u32x4*)(pr + CQ + 8 * lane); d.kvv = *(const u32x4*)(pr + CKV + 8 * lane);
#pragma unroll
    for (int gi = 0; gi < 4; ++gi) { const int w = 2 << gi, col = CPOOL + gi * 256 + 8 * l32;
#pragma unroll
        for (int q = 0; q < w / 2; ++q) { const int rr = tt - w / 2 + 2 * q + hv; const int rc = rr < 0 ? 0 : (rr >= L ? L - 1 : rr);
            d.wv[(w / 2 - 1) + q] = *(const u32x4*)(P + (size_t)(segrow0 + rc) * INWP + col); }
        d.sv[gi] = *(const u32x4*)(pr + col); }
}
__device__ __forceinline__ void t2_compute(const Frame& F, int row, int lane, const T2Row& d, const LAS float* GQ, const LAS float* GKV) {
    bf16_t* QLN = (bf16_t*)(F.ws + WS_QLN); bf16_t* KVLN = (bf16_t*)(F.ws + WS_KVLN); bf16_t* PL = (bf16_t*)(F.ws + WS_PL);
    const int hv = lane >> 5, l32 = lane & 31;
    const int t = row % TPB, L = t < CTXL ? CTXL : SEQ, tt = t < CTXL ? t : t - CTXL;
#pragma unroll
    for (int w = 0; w < 2; ++w) {
        float v[8]; unpack8(w == 0 ? d.qv : d.kvv, v);
        float s = 0.f;
#pragma unroll
        for (int j = 0; j < 8; ++j) s += v[j] * v[j];
        s = wave_sum(s); const float rs = 1.0f / sqrtf(s * (1.0f / 512.f) + EPS);
        const LAS float* g = (w == 0 ? GQ : GKV) + 8 * lane; const f32x4 g0 = *(const LAS f32x4*)g, g1 = *(const LAS f32x4*)(g + 4);
        v[0] *= rs * g0[0]; v[1] *= rs * g0[1]; v[2] *= rs * g0[2]; v[3] *= rs * g0[3]; v[4] *= rs * g1[0]; v[5] *= rs * g1[1]; v[6] *= rs * g1[2]; v[7] *= rs * g1[3];
        *(u32x4*)((w == 0 ? QLN : KVLN) + (size_t)row * 512 + 8 * lane) = pack8(v);
    }
#pragma unroll
    for (int gi = 0; gi < 4; ++gi) {
        const int w = 2 << gi; int lo = tt - w / 2, hi = tt - w / 2 + w; lo = lo < 0 ? 0 : lo; hi = hi > L ? L : hi;
        float a[8];
#pragma unroll
        for (int i = 0; i < 8; ++i) a[i] = 0.f;
#pragma unroll
        for (int q = 0; q < w / 2; ++q) { const int rr = tt - w / 2 + 2 * q + hv; const bool ok = rr >= 0 && rr < L;
            float v[8]; unpack8(d.wv[(w / 2 - 1) + q], v); const float m = ok ? 1.f : 0.f;
#pragma unroll
            for (int i = 0; i < 8; ++i) a[i] += m * v[i]; }
#pragma unroll
        for (int i = 0; i < 8; ++i) { auto sw = __builtin_amdgcn_permlane32_swap(__float_as_uint(a[i]), __float_as_uint(a[i]), false, false); a[i] = __uint_as_float(sw[0]) + __uint_as_float(sw[1]); }
        const float ic = 1.0f / (float)(hi - lo);
        float s8[8]; unpack8(d.sv[gi], s8);
#pragma unroll
        for (int i = 0; i < 8; ++i) a[i] = a[i] * ic - s8[i];
        if (hv == 0) *(u32x4*)(PL + (size_t)row * POOLW + gi * 256 + 8 * l32) = pack8(a);
    }
}
__device__ __forceinline__ void phase_thin2(const Frame& F, int l) {
    PHASE_IDS(); const int gw = F.vcu * 8 + wave, NGW = F.G * 8;
    const bf16_t* P = (const bf16_t*)(F.ws + WS_P);
    LAS float* const GQ = (LAS float*)F.lds; LAS float* const GKV = GQ + QL;
    if (tid < 128) *(LAS f32x4*)(GQ + 4 * tid) = *(const f32x4*)(in_ptr(12) + l * QL + 4 * tid); else if (tid < 256) *(LAS f32x4*)(GKV + 4 * (tid - 128)) = *(const f32x4*)(in_ptr(13) + l * KVL + 4 * (tid - 128));
    __syncthreads();
    for (int row = gw; row < R; row += 2 * NGW) { const int r2 = row + NGW; const bool h2 = r2 < R;
        T2Row A, B; t2_load(P, row, lane, A); t2_load(P, h2 ? r2 : row, lane, B);
        asm volatile("" ::: "memory");
        t2_compute(F, row, lane, A, GQ, GKV);
        if (h2) t2_compute(F, r2, lane, B, GQ, GKV);
    }
}
#ifndef MOD_DEFER
#define MOD_DEFER 1
#endif
__device__ __forceinline__ void mod_partial_item(const Frame& F, int it, int lane) {
    float* MODP = (float*)(F.ws + WS_MODP); const float* cvec = in_ptr(1); const float* cctx = in_ptr(3);
    const int l = it / (16 * 48), kc = (it / 48) % 16, cb = it % 48, n0 = cb * 256 + 4 * lane;
    const float* W = in_ptr(4) + (size_t)l * DM * 12288 + (size_t)(kc * 128) * 12288 + n0;
    f32x4 a0 = {0.f, 0.f, 0.f, 0.f}, a1 = a0, a2 = a0;
    for (int k = 0; k < 128; ++k) { const int kk = kc * 128 + k; const f32x4 w = *(const f32x4*)(W + (size_t)k * 12288);
        const float c0 = cvec[kk], c1 = cvec[DM + kk], c2 = cctx[kk];
        a0 += w * (c0 * sigmoidf_(c0)); a1 += w * (c1 * sigmoidf_(c1)); a2 += w * (c2 * sigmoidf_(c2)); }
    float* o = MODP + (((size_t)kc * 2 + l) * 3) * 12288 + n0;
    *(f32x4*)(o) = a0; *(f32x4*)(o + 12288) = a1; *(f32x4*)(o + 2 * 12288) = a2;
}
__device__ __forceinline__ void mod_reduce_layer(const Frame& F, int l, int tid) {
    const float* MODP = (const float*)(F.ws + WS_MODP); float* MOD = (float*)(F.ws + WS_MOD); const float* bmod = in_ptr(5);
    for (int j = F.vcu * 512 + tid; j < 3 * 12288; j += F.G * 512) { const int i = l * 3 * 12288 + j, n = j % 12288;
        float s = bmod[l * 12288 + n];
        for (int kc = 0; kc < 16; ++kc) s += MODP[(size_t)kc * (2 * 3 * 12288) + i];
        MOD[i] = s; }
}
__device__ __forceinline__ void phase_thin3_dense(const Frame& F, int l) {
    PHASE_IDS();
    const int gw = F.vcu * 8 + wave, NGW = F.G * 8;
    if (MOD_DEFER && F.G == 256) mod_reduce_layer(F, 1, tid);
    float* XRES = (float*)(F.ws + WS_XRES); bf16_t* H = (bf16_t*)(F.ws + WS_H); const bf16_t* Y = (const bf16_t*)(F.ws + WS_Y);
    stage3(LV_A(F), modp(F, l, 0, 2), tid); stage3(LV_B(F), modp(F, l, 0, 3), tid); stage3(LV_C(F), modp(F, l, 0, 4), tid); stage1(LV_G1(F), in_ptr(7) + l * DM, tid); stage1(LV_G2(F), in_ptr(8) + l * DM, tid);
    __syncthreads();
    const int nlr = (NLAT + NGW - 1) / NGW;
    for (int it = 0; ; ++it) { int row;
        if (it < nlr) { const int lat = it * NGW + gw; if (lat >= NLAT) continue; row = (lat / SEQ) * TPB + CTXL + lat % SEQ; }
        else { const int c = (it - nlr) * NGW + wave * F.G + F.vcu; if (c >= NB * CTXL) break; row = (c / CTXL) * TPB + c % CTXL; }
        const int mi = row_modidx(row);
        f32x4 y[8], x[8], o[8];
        if (row % TPB < CTXL) { const float* yc = (const float*)(F.ws + WS_YC) + (size_t)((row / TPB) * CTXL + row % TPB) * DM;
            ld_row_f32(yc, y, lane);
            for (int z = 1; z < ZS_G3; ++z) { f32x4 t[8]; ld_row_f32(yc + (size_t)z * (NB * CTXL) * DM, t, lane);
#pragma unroll
                for (int j = 0; j < 8; ++j) y[j] = y[j] + t[j]; } }
        else ld_row_bf16(Y + (size_t)row * DM, y, lane);
        { const int b_ = row / TPB, t_ = row % TPB;
          const float* src = t_ < CTXL ? in_ptr(2) + ((size_t)b_ * CTXL + t_) * DM : in_ptr(0) + ((size_t)b_ * SEQ + (t_ - CTXL)) * DM;
          ld_row_f32(src, x, lane); }
        const float rs = row_rstd(y); const LAS float* gp = LV_G1(F); const LAS float* g1 = LV_A(F) + mi * DM;
#pragma unroll
        for (int j = 0; j < 8; ++j) { const int c = 4 * lane + 256 * j; x[j] = x[j] + *(const LAS f32x4*)(g1 + c) * (y[j] * rs * *(const LAS f32x4*)(gp + c)); }
        st_row_f32(XRES + (size_t)row * DM, x, lane);
        norm_mod_l(x, o, LV_G2(F), LV_B(F) + mi * DM, LV_C(F) + mi * DM, lane);
#if DENSE_I8
        st_row_i8(F, row, o, lane);
#else
        st_row_bf16(H + (size_t)row * DM, o, lane);
#endif
    }
}
__device__ __forceinline__ void phase_thin3_moe(const Frame& F, int l) {
    PHASE_IDS(); const int gw = F.vcu * 8 + wave, NGW = F.G * 8;
    float* XRES = (float*)(F.ws + WS_XRES); const bf16_t* Y = (const bf16_t*)(F.ws + WS_Y);
    unsigned* TOK = (unsigned*)(F.ws + WS_TOK);
    const float* wr = in_ptr(22); const float* br = in_ptr(23);
    __syncthreads();
    LAS float* const VA = (LAS float*)F.lds; LAS float* const VB = VA + 2 * DM; LAS float* const VC = VA + 4 * DM; LAS float* const VG1 = VA + 6 * DM; LAS float* const VG2 = VA + 7 * DM; LAS float* const WE = VA + 8 * DM;
#pragma unroll
    for (int m2 = 0; m2 < 2; ++m2) { stage1(VA + m2 * DM, modp(F, l, m2, 2), tid); stage1(VB + m2 * DM, modp(F, l, m2, 3), tid); stage1(VC + m2 * DM, modp(F, l, m2, 4), tid); }
    stage1(VG1, in_ptr(7) + l * DM, tid); stage1(VG2, in_ptr(8) + l * DM, tid);
#pragma unroll
    for (int i = 0; i < 8; ++i) { const int c = i * 512 + tid, k = c >> 1, e0 = (c & 1) * 4; const f32x4 v = *(const f32x4*)(wr + (size_t)c * 4);
        WE[(e0 + 0) * DM + k] = v[0]; WE[(e0 + 1) * DM + k] = v[1]; WE[(e0 + 2) * DM + k] = v[2]; WE[(e0 + 3) * DM + k] = v[3]; }
    __syncthreads();
    for (int tok = gw; tok < NLAT; tok += NGW) {
        const int b = tok / SEQ, s = tok % SEQ, row = b * TPB + CTXL + s, mi = b;
        f32x4 y[8], x[8], o[8]; ld_row_bf16(Y + (size_t)row * DM, y, lane); ld_row_f32(XRES + (size_t)row * DM, x, lane);
        const float rs = row_rstd(y); const LAS float* gp = VG1; const LAS float* g1 = VA + mi * DM;
#pragma unroll
        for (int j = 0; j < 8; ++j) { const int c = 4 * lane + 256 * j; x[j] = x[j] + *(const LAS f32x4*)(g1 + c) * (y[j] * rs * *(const LAS f32x4*)(gp + c)); }
        st_row_f32(XRES + (size_t)row * DM, x, lane);
        norm_mod_l(x, o, VG2, VB + mi * DM, VC + mi * DM, lane);
        float lg[8];
#pragma unroll
        for (int e = 0; e < 8; ++e) lg[e] = 0.f;
#pragma unroll
        for (int j = 0; j < 8; ++j) {
#pragma unroll
            for (int e = 0; e < 8; ++e) { const f32x4 w = *(const LAS f32x4*)(WE + e * DM + 4 * lane + 256 * j);
                lg[e] += (o[j][0] * w[0] + o[j][1] * w[1]) + (o[j][2] * w[2] + o[j][3] * w[3]); }
            asm volatile("" ::: "memory"); }
#pragma unroll
        for (int e = 0; e < 8; ++e) lg[e] = wave_sum(lg[e]) + br[e];
        int e1 = 0; float m1 = lg[0];
#pragma unroll
        for (int e = 1; e < 8; ++e) if (lg[e] > m1) { m1 = lg[e]; e1 = e; }
        int e2 = -1; float m2 = -3.0e38f;
#pragma unroll
        for (int e = 0; e < 8; ++e) if (e != e1 && lg[e] > m2) { m2 = lg[e]; e2 = e; }
        const float p2 = fast_exp(m2 - m1), w1n = 1.0f / (1.0f + p2), w2n = p2 / (1.0f + p2);
        unsigned r1 = 0u, r2 = 0u;
        if (lane == 0) {
            r1 = __hip_atomic_fetch_add(F.ctl + CW_CNT + 64 * e1, 1u, RLX_AGENT);
            r2 = __hip_atomic_fetch_add(F.ctl + CW_CNT + 64 * e2, 1u, RLX_AGENT);
            u32x4 a; a.x = (unsigned)e1; a.y = r1; a.z = __float_as_uint(w1n); a.w = (unsigned)e2; u32x4 c2; c2.x = r2; c2.y = __float_as_uint(w2n); c2.z = 0u; c2.w = 0u;
            *(u32x4*)(TOK + (size_t)tok * 8) = a; *(u32x4*)(TOK + (size_t)tok * 8 + 4) = c2;
        }
#if MOE_DIRECT
        { r1 = (unsigned)__builtin_amdgcn_readfirstlane((int)r1); r2 = (unsigned)__builtin_amdgcn_readfirstlane((int)r2);
          const int e1u = __builtin_amdgcn_readfirstlane(e1), e2u = __builtin_amdgcn_readfirstlane(e2);
          unsigned char* h1 = F.ws + WS_HS2 + ((size_t)e1u * NLAT + r1) * DM; unsigned char* h2 = F.ws + WS_HS2 + ((size_t)e2u * NLAT + r2) * DM;
#pragma unroll
          for (int j = 0; j < 8; ++j) { const unsigned w = cvt4_fp8(o[j][0], o[j][1], o[j][2], o[j][3]); *(unsigned*)(h1 + 4 * lane + 256 * j) = w; *(unsigned*)(h2 + 4 * lane + 256 * j) = w; } }
#endif
    }
}
__device__ __forceinline__ MoeTiles moe_tiles(const Frame& F) {
    volatile LAS int* tbl = (volatile LAS int*)(F.lds + MISC_OFF + 64);
    __syncthreads();
    if (threadIdx.x == 0) { int acc = 0;
        for (int e = 0; e < NE; ++e) { tbl[e] = acc; const unsigned c = __hip_atomic_load(F.ctl + CW_CNT + 64 * e, RLX_AGENT); acc += (int)((c + 255u) >> 8); }
        tbl[NE] = acc; }
    __syncthreads();
    MoeTiles mt; mt.tb = tbl; mt.total = __builtin_amdgcn_readfirstlane(tbl[NE]); return mt;
}
__device__ __forceinline__ void phase_moe_scatter(const Frame& F, int l, const MoeTiles& mt) {
    PHASE_IDS(); const int gw = F.vcu * 8 + wave, NGW = F.G * 8;
    const float* XRES = (const float*)(F.ws + WS_XRES); bf16_t* HS = (bf16_t*)(F.ws + WS_HS);
    const unsigned* TOK = (const unsigned*)(F.ws + WS_TOK);
    for (int tok = gw; tok < NLAT; tok += NGW) {
        const int b = tok / SEQ, s = tok % SEQ, row = b * TPB + CTXL + s, mi = b;
        f32x4 x[8], o[8]; ld_row_f32(XRES + (size_t)row * DM, x, lane);
        norm_mod(x, o, in_ptr(8) + l * DM, modp(F, l, mi, 3), modp(F, l, mi, 4), lane);
        const u32x4 a = *(const u32x4*)(TOK + (size_t)tok * 8); const u32x4 c2 = *(const u32x4*)(TOK + (size_t)tok * 8 + 4);
        int base1 = 0, base2 = 0;
        base1 = mt.tb[(int)a.x]; base2 = mt.tb[(int)a.w];
        const int s1 = base1 * 256 + (int)a.y, s2 = base2 * 256 + (int)c2.x;
#if MOE_FP8
        { unsigned char* h1 = (unsigned char*)HS + (size_t)s1 * DM; unsigned char* h2 = (unsigned char*)HS + (size_t)s2 * DM;
#pragma unroll
          for (int j = 0; j < 8; ++j) { const unsigned w = cvt4_fp8(o[j][0], o[j][1], o[j][2], o[j][3]); *(unsigned*)(h1 + 4 * lane + 256 * j) = w; *(unsigned*)(h2 + 4 * lane + 256 * j) = w; } }
#else
        st_row_bf16(HS + (size_t)s1 * DM, o, lane); st_row_bf16(HS + (size_t)s2 * DM, o, lane);
#endif
    }
}
__device__ __forceinline__ void phase_thin4_dense(const Frame& F, int l) {
    PHASE_IDS(); const int gw = F.vcu * 8 + wave, NGW = F.G * 8;
    float* XRES = (float*)(F.ws + WS_XRES); bf16_t* H = (bf16_t*)(F.ws + WS_H); const float* Y2 = (const float*)(F.ws + WS_Y2);
    stage3(LV_A(F), modp(F, l, 0, 5), tid); stage3(LV_B(F), modp(F, l + 1, 0, 0), tid); stage3(LV_C(F), modp(F, l + 1, 0, 1), tid); stage1(LV_G1(F), in_ptr(9) + l * DM, tid); stage1(LV_G2(F), in_ptr(6) + (l + 1) * DM, tid);
    __syncthreads();
    const int nlr = (NLAT + NGW - 1) / NGW;
    for (int it = 0; ; ++it) { int row;
        if (it < nlr) { const int lat = it * NGW + gw; if (lat >= NLAT) continue; row = (lat / SEQ) * TPB + CTXL + lat % SEQ; }
        else { const int c = (it - nlr) * NGW + wave * F.G + F.vcu; if (c >= NB * CTXL) break; row = (c / CTXL) * TPB + c % CTXL; }
        const int mi = row_modidx(row);
        f32x4 y[8], x[8], o[8];
        if (row % TPB < CTXL) { const float* yc = (const float*)(F.ws + WS_YC) + (size_t)((row / TPB) * CTXL + row % TPB) * DM;
            ld_row_f32(yc, y, lane);
            for (int z = 1; z < ZS_G5; ++z) { f32x4 t[8]; ld_row_f32(yc + (size_t)z * (NB * CTXL) * DM, t, lane);
#pragma unroll
                for (int j = 0; j < 8; ++j) y[j] = y[j] + t[j]; } }
        else ld_row_bf16((const bf16_t*)Y2 + (size_t)row * DM, y, lane);
        ld_row_f32(XRES + (size_t)row * DM, x, lane);
        const float rs = row_rstd(y); const LAS float* gp = LV_G1(F); const LAS float* g2 = LV_A(F) + mi * DM;
#pragma unroll
        for (int j = 0; j < 8; ++j) { const int c = 4 * lane + 256 * j; x[j] = x[j] + *(const LAS f32x4*)(g2 + c) * (y[j] * rs * *(const LAS f32x4*)(gp + c)); }
        st_row_f32(XRES + (size_t)row * DM, x, lane);
        norm_mod_l(x, o, LV_G2(F), LV_B(F) + mi * DM, LV_C(F) + mi * DM, lane);
#if WIN_I8
        st_row_i8(F, row, o, lane);
#else
        st_row_bf16(H + (size_t)row * DM, o, lane);
#endif
    }
}
__device__ __forceinline__ void phase_final_moe(const Frame& F, int l, const MoeTiles& mt) {
    PHASE_IDS(); const int gw = F.vcu * 8 + wave, NGW = F.G * 8;
    const float* XRES = (const float*)(F.ws + WS_XRES); const float* Y2 = (const float*)(F.ws + WS_Y2);
    const unsigned* TOK = (const unsigned*)(F.ws + WS_TOK);
    for (int tok = gw; tok < NLAT; tok += NGW) {
        const int b = tok / SEQ, s = tok % SEQ, row = b * TPB + CTXL + s, mi = b;
        const u32x4 a = *(const u32x4*)(TOK + (size_t)tok * 8); const u32x4 c2 = *(const u32x4*)(TOK + (size_t)tok * 8 + 4);
        int base1 = 0, base2 = 0;
        base1 = mt.tb[(int)a.x]; base2 = mt.tb[(int)a.w];
        const int s1 = base1 * 256 + (int)a.y, s2 = base2 * 256 + (int)c2.x;
        const float w1 = __uint_as_float(a.z), w2 = __uint_as_float(c2.y);
        f32x4 y[8], t0[8], x[8];
        ld_row_bf16((const bf16_t*)Y2 + (size_t)s1 * DM, y, lane); ld_row_bf16((const bf16_t*)Y2 + (size_t)MOE_ROWS * DM + (size_t)s1 * DM, t0, lane);
#pragma unroll
        for (int j = 0; j < 8; ++j) y[j] = (y[j] + t0[j]) * w1;
        ld_row_bf16((const bf16_t*)Y2 + (size_t)s2 * DM, t0, lane);
#pragma unroll
        for (int j = 0; j < 8; ++j) y[j] = y[j] + t0[j] * w2;
        ld_row_bf16((const bf16_t*)Y2 + (size_t)MOE_ROWS * DM + (size_t)s2 * DM, t0, lane);
#pragma unroll
        for (int j = 0; j < 8; ++j) y[j] = y[j] + t0[j] * w2;
        ld_row_f32(XRES + (size_t)row * DM, x, lane);
        const float rs = row_rstd(y); const float* gp = in_ptr(9) + l * DM; const float* g2 = modp(F, l, mi, 5);
#pragma unroll
        for (int j = 0; j < 8; ++j) { const int c = 4 * lane + 256 * j; x[j] = x[j] + *(const f32x4*)(g2 + c) * (y[j] * rs * *(const f32x4*)(gp + c)); }
        st_row_f32(F.out + (size_t)tok * DM, x, lane);
    }
}

enum { MAP_ID = 0, MAP_WIN = 1, MAP_QUP = 2, MAP_GATE = 3, MAP_UP = 4 };
__device__ __forceinline__ int dst_row(int kind, int n) {
    if (kind == MAP_WIN) {
        if (n < 1024) return n;
        if (n < 1088) { const int i = n - 1024; return i < 32 ? CKR + 2 * i : CKR + 2 * (i - 32) + 1; }
        if (n < 2112) return CPOOL + (n - 1088);
        return CGATE + (n - 2112);
    }
    if (kind == MAP_QUP) { const int h = n / DQK, d = n % DQK; if (d < DN) return n; const int i = d - DN; return h * DQK + DN + (i < 32 ? 2 * i : 2 * (i - 32) + 1); }
    if (kind == MAP_GATE) return (n >> 7) * 256 + (n & 127);
    if (kind == MAP_UP) return (n >> 7) * 256 + 128 + (n & 127);
    return n;
}
__device__ __forceinline__ void titem_load(const float* W, int N, int item, int lane, float (&v)[32]) {
    const int nblk = N / 32, kb = item / nblk, nb = item % nblk;
    const float* p = W + (size_t)(64 * kb + (lane >> 5)) * N + 32 * nb + (lane & 31);
#pragma unroll
    for (int i = 0; i < 32; ++i) v[i] = __builtin_nontemporal_load(p + (size_t)(2 * i) * N);
}
__device__ __forceinline__ void titem_store(const float (&v)[32], int K, int N, bf16_t* WT, int kind, LAS float* scr, int item, int lane) {
    const int nblk = N / 32, kb = item / nblk, nb = item % nblk, k0 = 64 * kb, n0 = 32 * nb;
#pragma unroll
    for (int i = 0; i < 32; ++i) scr[(2 * i + (lane >> 5)) * 33 + (lane & 31)] = v[i];
    asm volatile("s_waitcnt lgkmcnt(0)" ::: "memory");
    const int c = lane & 7;
#pragma unroll
    for (int j = 0; j < 4; ++j) { const int n = (lane >> 3) + 8 * j; const LAS float* s = scr + (8 * c) * 33 + n;
        u32x4 o; o.x = cvt_pk_bf16(s[0 * 33], s[1 * 33]); o.y = cvt_pk_bf16(s[2 * 33], s[3 * 33]); o.z = cvt_pk_bf16(s[4 * 33], s[5 * 33]); o.w = cvt_pk_bf16(s[6 * 33], s[7 * 33]);
        *(u32x4*)(WT + (size_t)dst_row(kind, n0 + n) * K + k0 + 8 * c) = o; }
    asm volatile("s_waitcnt lgkmcnt(0)" ::: "memory");
}
__device__ __forceinline__ void titem_store8(const float (&v)[32], int K, int N, unsigned char* WT, int kind, LAS float* scr, int item, int lane) {
    const int nblk = N / 32, kb = item / nblk, nb = item % nblk, k0 = 64 * kb, n0 = 32 * nb;
#pragma unroll
    for (int i = 0; i < 32; ++i) scr[(2 * i + (lane >> 5)) * 33 + (lane & 31)] = v[i] * (float)(1 << pg8::FP8_WSHIFT);
    asm volatile("s_waitcnt lgkmcnt(0)" ::: "memory");
    const int c = lane & 3;
#pragma unroll
    for (int j = 0; j < 2; ++j) { const int n = (lane >> 2) + 16 * j; const LAS float* s = scr + (16 * c) * 33 + n;
        u32x4 o; o.x = cvt4_fp8(s[0 * 33], s[1 * 33], s[2 * 33], s[3 * 33]); o.y = cvt4_fp8(s[4 * 33], s[5 * 33], s[6 * 33], s[7 * 33]);
        o.z = cvt4_fp8(s[8 * 33], s[9 * 33], s[10 * 33], s[11 * 33]); o.w = cvt4_fp8(s[12 * 33], s[13 * 33], s[14 * 33], s[15 * 33]);
        *(u32x4*)(WT + (size_t)dst_row(kind, n0 + n) * K + k0 + 16 * c) = o; }
    asm volatile("s_waitcnt lgkmcnt(0)" ::: "memory");
}
__device__ __forceinline__ void titem_store_i8(const float (&v)[32], int K, int N, unsigned char* WT, int kind, const float* inv_scale, LAS float* scr, int item, int lane) {
    const int nblk = N / 32, kb = item / nblk, nb = item % nblk, k0 = 64 * kb, n0 = 32 * nb;
    const float isc = inv_scale[n0 + (lane & 31)];
#pragma unroll
    for (int i = 0; i < 32; ++i) scr[(2 * i + (lane >> 5)) * 33 + (lane & 31)] = rintf(v[i] * isc);
    asm volatile("s_waitcnt lgkmcnt(0)" ::: "memory");
    const int c = lane & 3;
#pragma unroll
    for (int j = 0; j < 2; ++j) { const int n = (lane >> 2) + 16 * j; const LAS float* s = scr + (16 * c) * 33 + n;
        unsigned w[4];
#pragma unroll
        for (int q = 0; q < 4; ++q) w[q] = (unsigned)((int)s[(4 * q) * 33] & 255) | ((unsigned)((int)s[(4 * q + 1) * 33] & 255) << 8) | ((unsigned)((int)s[(4 * q + 2) * 33] & 255) << 16) | ((unsigned)((int)s[(4 * q + 3) * 33] & 255) << 24);
        *(u32x4*)(WT + (size_t)dst_row(kind, n0 + n) * K + k0 + 16 * c) = (u32x4){w[0], w[1], w[2], w[3]}; }
    asm volatile("s_waitcnt lgkmcnt(0)" ::: "memory");
}
struct Job { const float* src; bf16_t* dst; int K, N, kind, items; const float* isc; };
__device__ __forceinline__ Job make_job(const float* src, bf16_t* dst, int K, int N, int kind) { Job j; j.src = src; j.dst = dst; j.K = K; j.N = N; j.kind = kind; j.items = (K / 64) * (N / 32); j.isc = nullptr; return j; }
constexpr int NJOBS = 43;
#ifndef AC_CONVERT
#define AC_CONVERT 1
#endif
#ifndef BG_CONVERT
#define BG_CONVERT 1
#endif
constexpr int NJOBS_FG = BG_CONVERT ? 19 : NJOBS;
constexpr int EXP_ITEMS_PER_JOB = (DM / 64) * (DFF / 32), EXP_ITEMS = 24 * EXP_ITEMS_PER_JOB;
static_assert((DFF / 64) * (DM / 32) == EXP_ITEMS_PER_JOB && EXP_ITEMS_PER_JOB % 32 == 0, "expert jobs have equal item counts, whole 32-item rounds");
__device__ __forceinline__ Job get_job(const Frame& F, int jid) {
    unsigned char* ws = F.ws;
    if (jid < 16) { const int l = jid >> 3, k = jid & 7;
        if (k == 0) { Job j = make_job(in_ptr(10) + (size_t)l * DM * INW, (bf16_t*)(ws + WS_WIN + l * SZ_WIN), DM, INW, MAP_WIN + (WIN_I8 ? 64 : 0)); j.isc = (const float*)(ws + WS_WSC2) + 2 * INWP + l * INW; return j; }
        if (k == 1) return make_job(in_ptr(14) + (size_t)l * QL * 3072, (bf16_t*)(ws + WS_WQUP + l * SZ_WQUP), QL, 3072, MAP_QUP);
        if (k == 2) return make_job(in_ptr(15) + (size_t)l * KVL * 4096, (bf16_t*)(ws + WS_WKVUP + l * SZ_WKVUP), KVL, 4096, MAP_ID);
        if (k == 3) return make_job(in_ptr(18) + (size_t)l * DM * DM, (bf16_t*)(ws + WS_WOUT + l * SZ_WOUT), DM, DM, MAP_ID);
        const int g = k - 4; return make_job(in_ptr(16) + ((size_t)l * 4 + g) * 256 * 512, (bf16_t*)(ws + WS_WPOOL + l * SZ_WPOOL) + (size_t)g * 512 * 256, 256, 512, MAP_ID);
    }
    if (jid == 16) { Job j = make_job(in_ptr(19), (bf16_t*)(ws + WS_WFFGU), DM, DFF, MAP_GATE + (DENSE_I8 ? 64 : 0)); j.isc = (const float*)(ws + WS_WSC) + 2 * DFF; return j; }
    if (jid == 17) { Job j = make_job(in_ptr(20), (bf16_t*)(ws + WS_WFFGU), DM, DFF, MAP_UP + (DENSE_I8 ? 64 : 0)); j.isc = (const float*)(ws + WS_WSC) + 3 * DFF; return j; }
    if (jid == 18) return make_job(in_ptr(21), (bf16_t*)(ws + WS_WFFD), DFF, DM, MAP_ID);
    const int e = (jid - 19) / 3, k = (jid - 19) % 3;
    constexpr int FK = MOE_FP8 ? 16 : 0;
    if (k == 0) return make_job(in_ptr(24) + (size_t)e * DM * DFF, (bf16_t*)(ws + WS_WEGU + e * SZ_WGU), DM, DFF, MAP_GATE + FK);
    if (k == 1) return make_job(in_ptr(25) + (size_t)e * DM * DFF, (bf16_t*)(ws + WS_WEGU + e * SZ_WGU), DM, DFF, MAP_UP + FK);
    return make_job(in_ptr(26) + (size_t)e * DFF * DM, (bf16_t*)(ws + WS_WED + e * SZ_WD), DFF, DM, MAP_ID + FK);
}
template <int PART>
__device__ __forceinline__ void phase_prologue(const Frame& F) {
    PHASE_IDS(); const int gw = F.vcu * 8 + wave, NGW = F.G * 8;
    LAS float* scr = (LAS float*)(F.lds + wave * 16384); (void)scr;
    if constexpr (PART == 1) {
    { int total = 0;
      for (int jid = 0; jid < NJOBS_FG; ++jid) total += get_job(F, jid).items;
      int jid = 0, jbase = 0; Job J = get_job(F, 0);
      float cur[32], nxt[32];
      int g = gw;
      Job Jc = J; int itc = 0;
      if (g < total) { while (g >= jbase + J.items) { jbase += J.items; ++jid; J = get_job(F, jid); } Jc = J; itc = g - jbase; titem_load(Jc.src, Jc.N, itc, lane, cur); }
      while (g < total) {
          const int gn = g + NGW; Job Jn = J; int itn = 0; const bool hn = gn < total;
          if (hn) { while (gn >= jbase + J.items) { jbase += J.items; ++jid; J = get_job(F, jid); } Jn = J; itn = gn - jbase; titem_load(Jn.src, Jn.N, itn, lane, nxt); }
          if (Jc.kind >= 64) titem_store_i8(cur, Jc.K, Jc.N, (unsigned char*)Jc.dst, Jc.kind - 64, Jc.isc, scr, itc, lane);
          else if (MOE_FP8 && Jc.kind >= 16) titem_store8(cur, Jc.K, Jc.N, (unsigned char*)Jc.dst, Jc.kind - 16, scr, itc, lane);
          else titem_store(cur, Jc.K, Jc.N, Jc.dst, Jc.kind, scr, itc, lane);
#pragma unroll
          for (int i = 0; i < 32; ++i) cur[i] = nxt[i];
          Jc = Jn; itc = itn; g = gn;
      } }
    for (int l = 0; l < 2; ++l) { constexpr int WES = WIN_I8 ? 1 : 2; u32x4* z = (u32x4*)(F.ws + WS_WIN + l * SZ_WIN + (size_t)INW * DM * WES); const int n16 = (INWP - INW) * DM * WES / 16;
        for (int i = gw * 64 + lane; i < n16; i += NGW * 64) z[i] = (u32x4){0u, 0u, 0u, 0u}; }
    } else {
    { const int nit = (MOD_DEFER && F.G == 256) ? 16 * 48 : 2 * 16 * 48;
      for (int it = gw; it < nit; it += NGW) mod_partial_item(F, it, lane); }
#if DENSE_I8
    { float* WSCP = (float*)(F.ws + WS_WSCP);
      for (int it = gw; it < 2 * 16 * 28; it += NGW) { const int m = it / (16 * 28), kc = (it / 28) % 16, cb = it % 28, n0 = cb * 256 + 4 * lane;
          const float* W = in_ptr(19 + m) + (size_t)(kc * 128) * DFF + n0;
          f32x4 mx = {0.f, 0.f, 0.f, 0.f};
          for (int k = 0; k < 128; ++k) { const f32x4 w = *(const f32x4*)(W + (size_t)k * DFF); mx = __builtin_elementwise_max(mx, __builtin_elementwise_abs(w)); }
          *(f32x4*)(WSCP + ((size_t)kc * 2 + m) * DFF + n0) = mx; } }
#endif
#if WIN_I8
    { float* WSCP2 = (float*)(F.ws + WS_WSCP2);
      for (int it = gw; it < 2 * 16 * 25; it += NGW) { const int l = it / (16 * 25), kc = (it / 25) % 16, cb = it % 25, n0 = cb * 256 + 4 * lane;
          if (n0 < INW) { const float* W = in_ptr(10) + (size_t)l * DM * INW + (size_t)(kc * 128) * INW + n0;
              f32x4 mx = {0.f, 0.f, 0.f, 0.f};
              for (int k = 0; k < 128; ++k) { const f32x4 w = *(const f32x4*)(W + (size_t)k * INW); mx = __builtin_elementwise_max(mx, __builtin_elementwise_abs(w)); }
              *(f32x4*)(WSCP2 + ((size_t)kc * 2 + l) * INWP + n0) = mx; } } }
#endif
    { float* rc = (float*)(F.ws + WS_ROPE); float* rsn = rc + SEQ * 32;
      for (int i = gw * 64 + lane; i < SEQ * 32; i += NGW * 64) { const int s = i >> 5, f = i & 31, jf = f & 15;
          const float inv = __builtin_amdgcn_exp2f(-(float)jf * (13.287712379549449f / 16.0f));
          const float pos = (float)(f < 16 ? (s >> 6) : (s & 63)); const float ang = pos * inv;
          const float rev = ang * 0.15915494309189535f; const float fr = rev - floorf(rev);
          rc[i] = __builtin_amdgcn_cosf(fr); rsn[i] = __builtin_amdgcn_sinf(fr); } }
    }
}
__device__ __forceinline__ void witem_load(const float* W, int N, int item, int lane, f32x4 (&v)[8]) {
    const int nblk = N / 32, kb = item / nblk, nb = item % nblk;
    const float* p = W + (size_t)(64 * kb + (lane >> 3)) * N + 32 * nb + 4 * (lane & 7);
#pragma unroll
    for (int i = 0; i < 8; ++i) v[i] = __builtin_nontemporal_load((const f32x4*)(p + (size_t)(8 * i) * N));
}
__device__ __forceinline__ void witem_store8(const f32x4 (&v)[8], int K, int N, unsigned char* WT, int kind, LAS float* scr, int item, int lane) {
    const int nblk = N / 32, kb = item / nblk, nb = item % nblk, k0 = 64 * kb, n0 = 32 * nb;
#pragma unroll
    for (int i = 0; i < 8; ++i) *(LAS f32x4*)(scr + ((lane >> 3) + 8 * i) * 36 + 4 * (lane & 7)) = v[i] * (float)(1 << pg8::FP8_WSHIFT);
    asm volatile("s_waitcnt lgkmcnt(0)" ::: "memory");
    const int c = lane & 3;
#pragma unroll
    for (int j = 0; j < 2; ++j) { const int n = (lane >> 2) + 16 * j; const LAS float* s = scr + (16 * c) * 36 + n;
        u32x4 o; o.x = cvt4_fp8(s[0 * 36], s[1 * 36], s[2 * 36], s[3 * 36]); o.y = cvt4_fp8(s[4 * 36], s[5 * 36], s[6 * 36], s[7 * 36]);
        o.z = cvt4_fp8(s[8 * 36], s[9 * 36], s[10 * 36], s[11 * 36]); o.w = cvt4_fp8(s[12 * 36], s[13 * 36], s[14 * 36], s[15 * 36]);
        *(u32x4*)(WT + (size_t)dst_row(kind, n0 + n) * K + k0 + 16 * c) = o; }
    asm volatile("s_waitcnt lgkmcnt(0)" ::: "memory");
}
constexpr int QBATCH = 8;
__device__ __forceinline__ int queue_grab(unsigned* qh, int lane) { int v = 0; if (lane == 0) v = (int)__hip_atomic_fetch_add(qh, (unsigned)QBATCH, RLX_AGENT); return __builtin_amdgcn_readfirstlane(v); }
__device__ __forceinline__ void bg_item_load(const Frame& F, int g, int lane, float (&v)[32]) { const Job J = get_job(F, 19 + g / EXP_ITEMS_PER_JOB); titem_load(J.src, J.N, g % EXP_ITEMS_PER_JOB, lane, v); }
__device__ __forceinline__ void bg_item_store(const Frame& F, int g, int lane, const float (&v)[32], LAS float* scr) { const Job J = get_job(F, 19 + g / EXP_ITEMS_PER_JOB);
    if (MOE_FP8) titem_store8(v, J.K, J.N, (unsigned char*)J.dst, J.kind - 16, scr, g % EXP_ITEMS_PER_JOB, lane);
    else titem_store(v, J.K, J.N, J.dst, J.kind, scr, g % EXP_ITEMS_PER_JOB, lane); }
__device__ __forceinline__ void convert_bg(const Frame& F, int ph, unsigned thr) {
#if BG_CONVERT
    const int qoff = (AC_CONVERT && F.G == 256) ? att::AC_JOBS * EXP_ITEMS_PER_JOB : 0;
    if (ph >= 0 && thr == 0u) return;
    PHASE_IDS();
    LAS float* scr = (LAS float*)(F.lds + wave * 16384);
    unsigned* qh = F.ctl + CW_QHEAD; unsigned* dn = F.ctl + CW_DONE + 64 * (ph < 0 ? 0 : ph);
    float cur[32], nxt[32];
    if (ph < 0) {
        const int h = __builtin_amdgcn_readfirstlane((int)__hip_atomic_load(qh, RLX_AGENT)) + qoff;
        const int gw = F.vcu * 8 + wave, NGW = F.G * 8;
        int g = h + gw;
        if (g < EXP_ITEMS) bg_item_load(F, g, lane, cur);
        while (g < EXP_ITEMS) { const int gn = g + NGW;
            if (gn < EXP_ITEMS) bg_item_load(F, gn, lane, nxt);
            bg_item_store(F, g, lane, cur, scr);
#pragma unroll
            for (int i = 0; i < 32; ++i) cur[i] = nxt[i];
            g = gn; }
        return;
    }
    volatile LAS int* qw = (volatile LAS int*)(F.lds + MISC_OFF + 128);
    for (;;) {
        __syncthreads();
        if (tid == 0) { int g0 = EXP_ITEMS;
            if (__hip_atomic_load(dn, RLX_AGENT) < thr) g0 = (int)__hip_atomic_fetch_add(qh, 32u, RLX_AGENT) + qoff;
            qw[0] = g0; }
        __syncthreads();
        const int g0 = __builtin_amdgcn_readfirstlane(qw[0]);
        if (g0 >= EXP_ITEMS) break;
        const int gb = g0 + wave * 4;
#if MOE_FP8
        f32x4 w0[8], w1[8], w2[8], w3[8];
        { const Job J = get_job(F, 19 + gb / EXP_ITEMS_PER_JOB); const int it = gb % EXP_ITEMS_PER_JOB;
          witem_load(J.src, J.N, it, lane, w0); witem_load(J.src, J.N, it + 1, lane, w1); witem_load(J.src, J.N, it + 2, lane, w2); witem_load(J.src, J.N, it + 3, lane, w3);
          witem_store8(w0, J.K, J.N, (unsigned char*)J.dst, J.kind - 16, scr, it, lane); witem_store8(w1, J.K, J.N, (unsigned char*)J.dst, J.kind - 16, scr, it + 1, lane);
          witem_store8(w2, J.K, J.N, (unsigned char*)J.dst, J.kind - 16, scr, it + 2, lane); witem_store8(w3, J.K, J.N, (unsigned char*)J.dst, J.kind - 16, scr, it + 3, lane); }
#else
#pragma unroll 1
        for (int q = 0; q < 4; ++q) { bg_item_load(F, gb + q, lane, cur); bg_item_store(F, gb + q, lane, cur, scr); }
#endif
    }
#endif
}
__device__ __forceinline__ void report_done(const Frame& F, int ph) {
#if BG_CONVERT
    if (threadIdx.x == 0) __hip_atomic_fetch_add(F.ctl + CW_DONE + 64 * ph, 1u, RLX_AGENT);
#endif
}
__device__ __forceinline__ unsigned bg_thr(int units, int G) { const int rem = units % G; return rem ? (unsigned)(G - rem + 1) : 0u; }
__device__ __forceinline__ void phase_mod_reduce(const Frame& F) {
    const float* MODP = (const float*)(F.ws + WS_MODP); float* MOD = (float*)(F.ws + WS_MOD);
    PHASE_IDS(); const float* bmod = in_ptr(5);
    mod_reduce_layer(F, 0, tid);
    if (!(MOD_DEFER && F.G == 256)) mod_reduce_layer(F, 1, tid);
#if DENSE_I8
    { const float* WSCP = (const float*)(F.ws + WS_WSCP); float* WSC = (float*)(F.ws + WS_WSC);
      for (int i = (F.vcu * 8 + wave) * 64 + lane; i < 2 * DFF; i += F.G * 512) { float mx = 1e-30f;
          for (int kc = 0; kc < 16; ++kc) mx = fmaxf(mx, WSCP[(size_t)kc * 2 * DFF + i]);
          WSC[i] = mx * (1.0f / 127.0f); WSC[2 * DFF + i] = 127.0f / mx; } }
#endif
#if WIN_I8
    { const float* WSCP2 = (const float*)(F.ws + WS_WSCP2); float* WSC2 = (float*)(F.ws + WS_WSC2);
      for (int i = (F.vcu * 8 + wave) * 64 + lane; i < 2 * INW; i += F.G * 512) { const int l = i / INW, n = i % INW; float mx = 1e-30f;
          for (int kc = 0; kc < 16; ++kc) mx = fmaxf(mx, WSCP2[((size_t)kc * 2 + l) * INWP + n]);
          WSC2[l * INWP + dst_row(MAP_WIN, n)] = mx * (1.0f / 127.0f); WSC2[2 * INWP + l * INW + n] = 127.0f / mx; }
      for (int i = (F.vcu * 8 + wave) * 64 + lane; i < 2 * (INWP - INW); i += F.G * 512) WSC2[(i / (INWP - INW)) * INWP + INW + i % (INWP - INW)] = 1.0f; }
#endif
}

template <int L>
__device__ __forceinline__ void layer_body(const Frame& F, const XcdBarrier& bar, char* lds_gen) {
    unsigned char* ws = F.ws;
    const float* ropec = (const float*)(ws + WS_ROPE); const float* ropes = ropec + SEQ * 32;
    constexpr int l = L;
    if constexpr (L == 0) {
      constexpr int WES = WIN_I8 ? 1 : 2;
      SchedDense S; S.o.init(R / 256, INWP / 256, F.G, (int)blockIdx.x); S.A = (const char*)(ws + WS_H); S.B = (const char*)(ws + WS_WIN + l * SZ_WIN); S.lda2 = DM * WES; S.ldb2 = DM * WES;
      EpiG1 E{(bf16_t*)(ws + WS_P), in_ptr(11) + l * 4096, ropec, ropes, WIN_I8 ? (const float*)(ws + WS_HSC) : nullptr, WIN_I8 ? (const float*)(ws + WS_WSC2) + l * INWP : nullptr};
      pg8::gemm_phase<false, EpiG1, SchedDense, WIN_I8 != 0>(F.lds, F.ws, F.wv, DM, DM, DM / (WIN_I8 ? 128 : 64), S, E);
      report_done(F, l * 8 + 0); convert_bg(F, l * 8 + 0, bg_thr((R / 256) * (INWP / 256), F.G));
    } else {
      SchedG1Last S; S.o.init(NLAT / 256, INWP / 256, F.G, (int)blockIdx.x); S.A = (const char*)(ws + WS_H); S.B = (const char*)(ws + WS_WIN + l * SZ_WIN); S.es = WIN_I8 ? 1 : 2;
      EpiG1 E{(bf16_t*)(ws + WS_P), in_ptr(11) + l * 4096, ropec, ropes, WIN_I8 ? (const float*)(ws + WS_HSC) : nullptr, WIN_I8 ? (const float*)(ws + WS_WSC2) + l * INWP : nullptr};
      pg8::gemm_phase<false, EpiG1, SchedG1Last, WIN_I8 != 0>(F.lds, F.ws, F.wv, DM, DM, DM / (WIN_I8 ? 128 : 64), S, E);
      report_done(F, l * 8 + 0); convert_bg(F, l * 8 + 0, bg_thr((NLAT / 256) * (INWP / 256) + 6, F.G));
    }
    xcd_barrier(bar);
    phase_thin2(F, l);
    xcd_barrier(bar);
    { SchedDense S; S.o.init(R / 256, 3072 / 256, F.G, (int)blockIdx.x); S.A = (const char*)(ws + WS_QLN); S.B = (const char*)(ws + WS_WQUP + l * SZ_WQUP); S.lda2 = QL * 2; S.ldb2 = QL * 2;
      EpiQ E{(bf16_t*)(ws + WS_Q), ropec, ropes};
      pg8::gemm_phase<false>(F.lds, F.ws, F.wv, QL, QL, QL / 64, S, E); }
    { SchedDense S; S.o.init(R / 256, 4096 / 256, F.G, F.G == 256 ? ((int)blockIdx.x + 104) & 255 : (int)blockIdx.x); S.A = (const char*)(ws + WS_KVLN); S.B = (const char*)(ws + WS_WKVUP + l * SZ_WKVUP); S.lda2 = KVL * 2; S.ldb2 = KVL * 2;
      EpiKV E{(bf16_t*)(ws + WS_KN), (bf16_t*)(ws + WS_V)};
      pg8::gemm_phase<false>(F.lds, F.ws, F.wv, KVL, KVL, KVL / 64, S, E); }
    { SchedPool S; S.o.init(R / 256, 2048 / 256, F.G, F.G == 256 ? ((int)blockIdx.x + 72) & 255 : (int)blockIdx.x); S.A = (const char*)(ws + WS_PL); S.B = (const char*)(ws + WS_WPOOL + l * SZ_WPOOL);
      EpiPool E{(bf16_t*)(ws + WS_POOLM), (const bf16_t*)(ws + WS_P), in_ptr(17) + l * DM};
      pg8::gemm_phase<false>(F.lds, F.ws, F.wv, POOLW, 256, 4, S, E); }
    report_done(F, l * 8 + 1); convert_bg(F, l * 8 + 1, F.G == 256 ? 73u : 0u);
    xcd_barrier(bar);
    { const att::Out O{ws};
#if !NAIVE_ATTN
      int slot = 0;
      for (int uid = F.vcu; uid < 512; uid += F.G, ++slot) { const int b = uid >> 8, h = (uid >> 4) & 15, qt = uid & 15;
          const bool ac = AC_CONVERT && F.G == 256;
          att::attn_unit(b * TPB + CTXL + qt * 256, b * TPB, TPB, h, lds_gen, F.lds, O, F.wv, ac ? (l * 2 + slot) * 256 + F.vcu : -1); }
      if (l == 0) for (int j = 0; j < 32; ++j) if ((j * 8) % F.G == F.vcu) { const int b = j >> 4, h = j & 15;
          att::attn_unit(b * TPB, b * TPB, CTXL, h, lds_gen, F.lds, O, F.wv, -1); }
      if constexpr (L == 0) if (MOD_DEFER && F.G == 256 && (F.vcu & 7) != 0) {
          PHASE_IDS(); const int idx = F.vcu - (F.vcu / 8 + 1), it = wave * 224 + idx;
          if (wave < 4 && it < 16 * 48) mod_partial_item(F, 16 * 48 + it, lane); }
#else
      const bf16_t* Qg = (const bf16_t*)(ws + WS_Q); const bf16_t* KNg = (const bf16_t*)(ws + WS_KN); const bf16_t* Pg = (const bf16_t*)(ws + WS_P); const bf16_t* Vg = (const bf16_t*)(ws + WS_V);
      PHASE_IDS();
      if (wave < 7) { LAS float* sc = (LAS float*)(F.lds) + wave * (TPB + DQK); LAS float* qs = sc + TPB;
          const int gw7 = F.vcu * 7 + wave, NG7 = F.G * 7;
          for (int it = gw7; it < NLAT * NH; it += NG7) { const int tok = it >> 4, h = it & 15, b = tok / SEQ, s = tok % SEQ;
              att::attn_naive_item(Qg, KNg, Pg, Vg, b * TPB + CTXL + s, b * TPB, TPB, h, sc, qs, lane, O); }
          if (l == 0) for (int it = gw7; it < NB * CTXL * NH; it += NG7) { const int tok = it >> 4, h = it & 15, b = tok / CTXL, t = tok % CTXL;
              att::attn_naive_item(Qg, KNg, Pg, Vg, b * TPB + t, b * TPB, CTXL, h, sc, qs, lane, O); } }
      __syncthreads();
#endif
    }
    xcd_barrier(bar);
    { SchedDense S; S.o.init(NLAT / 256, DM / 256, F.G, (int)blockIdx.x); S.lat_only = true;
      S.A = (const char*)(ws + WS_MB); S.B = (const char*)(ws + WS_WOUT + l * SZ_WOUT); S.lda2 = DM * 2; S.ldb2 = DM * 2;
      EpiPlain E{(bf16_t*)(ws + WS_Y), DM};
      pg8::gemm_phase<false>(F.lds, F.ws, F.wv, DM, DM, DM / 64, S, E); }
    if constexpr (L == 0) {
      SchedCtxSplit S; S.o.init(2, (DM / 256) * ZS_G3, F.G, (int)blockIdx.x); S.A = (const char*)(ws + WS_MB); S.B = (const char*)(ws + WS_WOUT + l * SZ_WOUT); S.lda2 = DM * 2; S.ldb2 = DM * 2; S.nN = DM / 256; S.ksb = (DM / ZS_G3) * 2;
      EpiCtxPart E{ws};
      pg8::gemm_phase<false>(F.lds, F.ws, F.wv, DM, DM, DM / ZS_G3 / 64, S, E); }
    xcd_barrier(bar);
    if constexpr (L == 0) {
        phase_thin3_dense(F, l);
        xcd_barrier(bar);
#if DENSE_I8
        { SchedDense S; S.o.init(R / 256, 14336 / 256, F.G, (int)blockIdx.x); S.A = (const char*)(ws + WS_H); S.B = (const char*)(ws + WS_WFFGU); S.lda2 = DM; S.ldb2 = DM;
          EpiSwigluI8 E{ws};
          pg8::gemm_phase<false, EpiSwigluI8, SchedDense, true>(F.lds, F.ws, F.wv, DM, DM, DM / 128, S, E); }
#else
        { SchedDense S; S.o.init(R / 256, 14336 / 256, F.G, (int)blockIdx.x); S.A = (const char*)(ws + WS_H); S.B = (const char*)(ws + WS_WFFGU); S.lda2 = DM * 2; S.ldb2 = DM * 2;
          EpiSwiglu E{(bf16_t*)(ws + WS_ACT)};
          pg8::gemm_phase<false>(F.lds, F.ws, F.wv, DM, DM, DM / 64, S, E); }
#endif
        report_done(F, 3); convert_bg(F, 3, bg_thr((R / 256) * (14336 / 256), F.G));
        xcd_barrier(bar);
        { SchedDense S; S.o.init(NLAT / 256, DM / 256, F.G, (int)blockIdx.x); S.lat_only = true;
          S.A = (const char*)(ws + WS_ACT); S.B = (const char*)(ws + WS_WFFD); S.lda2 = DFF * 2; S.ldb2 = DFF * 2;
          EpiDown E{ws, (unsigned)(MOE_ROWS * DM), 1.0f};
          pg8::gemm_phase<false>(F.lds, F.ws, F.wv, DFF, DFF, DFF / 64, S, E); }
        { SchedCtxSplit S; S.o.init(2, (DM / 256) * ZS_G5, F.G, (int)blockIdx.x); S.A = (const char*)(ws + WS_ACT); S.B = (const char*)(ws + WS_WFFD); S.lda2 = DFF * 2; S.ldb2 = DFF * 2; S.nN = DM / 256; S.ksb = (DFF / ZS_G5) * 2;
          EpiCtxPart E{ws};
          pg8::gemm_phase<false>(F.lds, F.ws, F.wv, DFF, DFF, DFF / ZS_G5 / 64, S, E); }
        report_done(F, 4); convert_bg(F, 4, bg_thr(2 * (DM / 256) * ZS_G5, F.G));
        xcd_barrier(bar);
        phase_thin4_dense(F, l);
        xcd_barrier(bar);
    } else {
        convert_bg(F, -1, 0u);
        phase_thin3_moe(F, l);
        xcd_barrier(bar);
        const MoeTiles mt = moe_tiles(F);
#if !MOE_DIRECT
        phase_moe_scatter(F, l, mt);
        xcd_barrier(bar);
#endif
        { SchedMoeUp S; S.o.init(mt.total, 14336 / 256, F.G, (int)blockIdx.x); S.mt = mt; S.A = (const char*)(ws + (MOE_DIRECT ? WS_HS2 : WS_HS)); S.B = (const char*)(ws + WS_WEGU);
#if MOE_FP8
          EpiSwiglu8 E{ws};
          pg8::gemm_phase<true>(F.lds, F.ws, F.wv, DM, DM, DM / 128, S, E); }
#else
          EpiSwiglu E{(bf16_t*)(ws + WS_ACT)};
          pg8::gemm_phase<false>(F.lds, F.ws, F.wv, DM, DM, DM / 64, S, E); }
#endif
        xcd_barrier(bar);
        { SchedMoeDown S; S.o.init(mt.total, (DM / 256) * ZK, F.G, (int)blockIdx.x); S.mt = mt; S.A = (const char*)(ws + WS_ACT); S.B = (const char*)(ws + WS_WED); S.nN = DM / 256;
          EpiDown E{ws, (unsigned)(MOE_ROWS * DM), MOE_FP8 ? pg8::FP8_WINV : 1.0f};
          pg8::gemm_phase<MOE_FP8 != 0>(F.lds, F.ws, F.wv, DFF, DFF, KSPL / (MOE_FP8 ? 128 : 64), S, E); }
        xcd_barrier(bar);
        phase_final_moe(F, l, mt);
    }
}

__global__ void __launch_bounds__(512, 2) fwd_kernel(Args args) {
    extern __shared__ __attribute__((aligned(16))) unsigned char lds_raw[];
    const int G = gridDim.x, bx = blockIdx.x;
    const Frame F{(LAS unsigned char*)lds_raw, (unsigned*)(args.ws + WS_CTL), args.ws, (G % 8 == 0) ? (bx % 8) * (G / 8) + bx / 8 : bx, G, __builtin_amdgcn_readfirstlane((int)threadIdx.x >> 6), args.out};
    volatile LAS unsigned* MISC = (volatile LAS unsigned*)(F.lds + MISC_OFF);
    for (int u = threadIdx.x; u < (LDS_BYTES - LDSCTL_OFF) / 4; u += 512) ((LAS unsigned*)(F.lds + LDSCTL_OFF))[u] = 0u;
    __syncthreads();
    const XcdBarrier bar = xcd_barrier_post(F.ctl + CW_BAR, MISC + 8);

    phase_prologue<0>(F);
    xcd_barrier(bar);
    phase_mod_reduce(F);
    xcd_barrier(bar);
    phase_prologue<1>(F);
    phase_norm1_l0(F);
    xcd_barrier(bar);
    layer_body<0>(F, bar, (char*)lds_raw);
    layer_body<1>(F, bar, (char*)lds_raw);
}

extern "C" void kernel_launch(void* const* d_in, const int* in_sizes, int n_in, void* d_out, int out_size, void* d_ws, size_t ws_size, hipStream_t stream) {
    static int grid = 0;
    if (grid == 0) {
        if (n_in != 27 || out_size != NLAT * DM || ws_size < WS_END) { fprintf(stderr, "kernel_launch: shape mismatch n_in %d out %d ws %zu (need %zu)\n", n_in, out_size, ws_size, (size_t)WS_END); grid = -1; return; }
        int dev = 0, cus = 0;
        if (hipGetDevice(&dev) != hipSuccess || hipDeviceGetAttribute(&cus, hipDeviceAttributeMultiprocessorCount, dev) != hipSuccess) { grid = -1; return; }
        if (hipFuncSetAttribute((const void*)fwd_kernel, hipFuncAttributeMaxDynamicSharedMemorySize, LDS_BYTES) != hipSuccess) { fprintf(stderr, "kernel_launch: hipFuncSetAttribute failed\n"); grid = -1; return; }
        int per_cu = 0;
        if (hipOccupancyMaxActiveBlocksPerMultiprocessor(&per_cu, (const void*)fwd_kernel, 512, LDS_BYTES) != hipSuccess || per_cu < 1) fprintf(stderr, "kernel_launch: occupancy query says %d\n", per_cu);
        (void)hipGetLastError();
        grid = cus;
    }
    if (grid < 0) return;
    (void)hipMemsetAsync((char*)d_ws + WS_CTL, 0, CTL_BYTES, stream);
    Args a{};
    for (int i = 0; i < 27; ++i) a.in[i] = (const float*)d_in[i];
    a.out = (float*)d_out; a.ws = (unsigned char*)d_ws;
    hipLaunchKernelGGL(fwd_kernel, dim3(grid), dim3(512), LDS_BYTES, stream, a);
    const hipError_t le = hipPeekAtLastError();
    if (le != hipSuccess) fprintf(stderr, "kernel_launch: launch failed: %s\n", hipGetErrorName(le));
}
```

```cpp
#include <hip/hip_runtime.h>
#include <cstdio>
#include <cstdint>
#include <type_traits>

#ifndef NAIVE_GEMM
#define NAIVE_GEMM 0
#endif
#ifndef MOE_FP8
#define MOE_FP8 1
#endif
#ifndef MOE_DIRECT
#define MOE_DIRECT (MOE_FP8)
#endif
#ifndef DENSE_I8
#define DENSE_I8 1
#endif
#define AMAX_STRIDE 8
#define AMAX_MARGIN 1.2f
#ifndef WIN_I8
#define WIN_I8 1
#endif
#ifndef NAIVE_ATTN
#define NAIVE_ATTN 0
#endif

#define GAS __attribute__((address_space(1)))
#define LAS __attribute__((address_space(3)))
typedef unsigned short bf16_t;
typedef short bf16x8 __attribute__((ext_vector_type(8)));
typedef short s16x4 __attribute__((ext_vector_type(4)));
typedef float f32x4 __attribute__((ext_vector_type(4)));
typedef float f32x2 __attribute__((ext_vector_type(2)));
typedef float f32x16 __attribute__((ext_vector_type(16)));
typedef unsigned u32x4 __attribute__((ext_vector_type(4)));
typedef unsigned u32x2 __attribute__((ext_vector_type(2)));

constexpr int DM = 2048, NB = 2, SEQ = 4096, CTXL = 256, TPB = SEQ + CTXL, R = NB * TPB;
constexpr int NH = 16, DN = 128, DRP = 64, DV = 128, DQK = 192, QL = 512, KVL = 512;
constexpr int POOLW = 1024, INW = 6208, INWP = 6400;
constexpr int DFF = 7168, NE = 8;
constexpr int NLAT = NB * SEQ;
constexpr int MOE_ROWS = 18432;
constexpr float EPS = 1e-6f;
constexpr float ATTN_SCALE = 0.07216878364870322f;
constexpr int CQ = 0, CKV = 512, CPOOL = 1024, CGATE = 2048, CKR = 6144;
constexpr int ZK = 2, KSPL = DFF / ZK;

constexpr size_t MiB = 1u << 20;
constexpr size_t WS_CTL = 0, CTL_BYTES = 1 * MiB;
constexpr size_t WS_MODP = 1 * MiB;
constexpr size_t WS_MOD = 6 * MiB;
constexpr size_t WS_ROPE = 7 * MiB;
constexpr size_t WS_WSCP = 9 * MiB;
constexpr size_t WS_WSC = 10 * MiB;
constexpr size_t WS_HSC = 11 * MiB;
constexpr size_t WS_WSCP2 = 12 * MiB;
constexpr size_t WS_WSC2 = 13 * MiB;
constexpr size_t WS_TOK = 8 * MiB;
constexpr size_t WS_WIN = 16 * MiB;
constexpr size_t SZ_WIN = (size_t)INWP * DM * 2;
constexpr size_t WS_WQUP = WS_WIN + 2 * SZ_WIN;
constexpr size_t SZ_WQUP = (size_t)3072 * 512 * 2;
constexpr size_t WS_WKVUP = WS_WQUP + 2 * SZ_WQUP;
constexpr size_t SZ_WKVUP = (size_t)4096 * 512 * 2;
constexpr size_t WS_WPOOL = WS_WKVUP + 2 * SZ_WKVUP;
constexpr size_t SZ_WPOOL = (size_t)2048 * 256 * 2;
constexpr size_t WS_WOUT = WS_WPOOL + 2 * SZ_WPOOL;
constexpr size_t SZ_WOUT = (size_t)2048 * 2048 * 2;
constexpr size_t WS_WFFGU = WS_WOUT + 2 * SZ_WOUT;
constexpr size_t SZ_WGU = (size_t)14336 * 2048 * 2;
constexpr size_t WS_WFFD = WS_WFFGU + SZ_WGU;
constexpr size_t SZ_WD = (size_t)2048 * 7168 * 2;
constexpr size_t WS_WEGU = WS_WFFD + SZ_WD;
constexpr size_t WS_WED = WS_WEGU + 8 * SZ_WGU;
constexpr size_t WS_WEND = WS_WED + 8 * SZ_WD;
constexpr size_t WS_XRES = (WS_WEND + MiB - 1) / MiB * MiB;
constexpr size_t WS_H = WS_XRES + (size_t)R * DM * 4;
constexpr size_t WS_U = WS_H + (size_t)R * DM * 2;
constexpr size_t WS_P = WS_U;
constexpr size_t WS_QLN = WS_P + (size_t)R * INWP * 2;
constexpr size_t WS_KVLN = WS_QLN + (size_t)R * 512 * 2;
constexpr size_t WS_PL = WS_KVLN + (size_t)R * 512 * 2;
constexpr size_t WS_Q = WS_PL + (size_t)R * 1024 * 2;
constexpr size_t WS_KN = WS_Q + (size_t)R * 3072 * 2;
constexpr size_t WS_V = WS_KN + (size_t)R * 2048 * 2;
constexpr size_t WS_POOLM = WS_V + (size_t)R * 2048 * 2;
constexpr size_t WS_MB = WS_POOLM + (size_t)R * 2048 * 2;
constexpr size_t WS_Y = WS_MB + (size_t)R * 2048 * 2;
constexpr size_t WS_MIXEND = WS_Y + (size_t)R * 2048 * 2;
constexpr size_t WS_ACT = WS_U;
constexpr size_t WS_Y2 = WS_ACT + (size_t)MOE_ROWS * DFF * 2;
constexpr size_t WS_HS = WS_Y2 + (size_t)ZK * MOE_ROWS * DM * 4;
constexpr size_t WS_FFNEND = WS_HS + (size_t)MOE_ROWS * DM * 2;
constexpr size_t WS_HS2 = WS_U + 400 * MiB;
static_assert(WS_HS2 + (size_t)NE * NLAT * DM <= WS_FFNEND && WS_HS2 >= WS_MIXEND && WS_HS2 >= WS_Y2 + (size_t)ZK * MOE_ROWS * DM * 2, "fixed-capacity expert rows");
constexpr size_t WS_YC = WS_U + 400 * MiB;
constexpr int ZS_G5 = 14, ZS_G3 = 16;
static_assert(WS_YC >= WS_MIXEND && WS_YC >= WS_Y2 + (size_t)R * DM * 4 && WS_YC + (size_t)16 * 512 * DM * 4 <= WS_FFNEND, "YC placement");
constexpr size_t WS_END = WS_FFNEND > WS_MIXEND ? WS_FFNEND : WS_MIXEND;
static_assert(WS_Y + (size_t)R * 2048 * 2 <= WS_HS || true, "");
constexpr int CW_BAR = 4096;
constexpr int CW_QHEAD = 20480;
constexpr int CW_DONE = 24576;
constexpr int CW_CNT = 16384;

constexpr int RING_BYTES = 131072;
constexpr int LDSCTL_OFF = RING_BYTES, MISC_OFF = LDSCTL_OFF + 320;
constexpr int LDS_BYTES = 163840;

#define RLX_AGENT __ATOMIC_RELAXED, __HIP_MEMORY_SCOPE_AGENT
__device__ __forceinline__ float bf2f(unsigned h) { return __uint_as_float(h << 16); }
__device__ __forceinline__ unsigned f2bf(float f) { unsigned u = __float_as_uint(f); return (u + 0x7fffu + ((u >> 16) & 1u)) >> 16; }
__device__ __forceinline__ unsigned pk2(float lo, float hi) { return f2bf(lo) | (f2bf(hi) << 16); }
__device__ __forceinline__ unsigned cvt_pk_bf16(float lo, float hi) { unsigned r; asm volatile("v_cvt_pk_bf16_f32 %0, %1, %2" : "=v"(r) : "v"(lo), "v"(hi)); return r; }
template <int M> __device__ __forceinline__ float swz_xor(float v) { return __int_as_float(__builtin_amdgcn_ds_swizzle(__float_as_int(v), (M << 10) | 0x1f)); }
__device__ __forceinline__ float wave_sum(float v) {
    v += swz_xor<1>(v); v += swz_xor<2>(v); v += swz_xor<4>(v); v += swz_xor<8>(v); v += swz_xor<16>(v);
    auto rr = __builtin_amdgcn_permlane32_swap(__float_as_uint(v), __float_as_uint(v), false, false);
    return __uint_as_float(rr[0]) + __uint_as_float(rr[1]);
}
__device__ __forceinline__ float wave_max(float v) {
    v = fmaxf(v, swz_xor<1>(v)); v = fmaxf(v, swz_xor<2>(v)); v = fmaxf(v, swz_xor<4>(v)); v = fmaxf(v, swz_xor<8>(v)); v = fmaxf(v, swz_xor<16>(v));
    auto rr = __builtin_amdgcn_permlane32_swap(__float_as_uint(v), __float_as_uint(v), false, false);
    return fmaxf(__uint_as_float(rr[0]), __uint_as_float(rr[1]));
}
__device__ __forceinline__ float fast_exp(float x) { return __builtin_amdgcn_exp2f(x * 1.4426950408889634f); }
__device__ __forceinline__ float sigmoidf_(float x) { return __builtin_amdgcn_rcpf(1.f + fast_exp(-x)); }
__device__ __forceinline__ u32x4 pack8(const float* v) { u32x4 w; w.x = cvt_pk_bf16(v[0], v[1]); w.y = cvt_pk_bf16(v[2], v[3]); w.z = cvt_pk_bf16(v[4], v[5]); w.w = cvt_pk_bf16(v[6], v[7]); return w; }
__device__ __forceinline__ unsigned cvt4_fp8(float a, float b, float c, float d) { int p = 0; p = __builtin_amdgcn_cvt_pk_fp8_f32(a, b, p, false); p = __builtin_amdgcn_cvt_pk_fp8_f32(c, d, p, true); return (unsigned)p; }
__device__ __forceinline__ void unpack8(u32x4 w, float* v) {
    v[0] = __uint_as_float(w.x << 16); v[1] = __uint_as_float(w.x & 0xffff0000u); v[2] = __uint_as_float(w.y << 16); v[3] = __uint_as_float(w.y & 0xffff0000u);
    v[4] = __uint_as_float(w.z << 16); v[5] = __uint_as_float(w.z & 0xffff0000u); v[6] = __uint_as_float(w.w << 16); v[7] = __uint_as_float(w.w & 0xffff0000u);
}

__device__ __forceinline__ int fresh_tid(int wv);
#define XB_TMO      128
#define XB_XCNT(j)  (256  + 64 * (j))
#define XB_XSUB(j)  (1280 + 64 * (j))
#define XB_XGEN(j)  (2304 + 64 * (j))
#define XB_TOP      3328
#define XB_TOPGEN   3392
#define XCD_BAR_WORDS 3456
#if NAIVE_GEMM || NAIVE_ATTN
#define XB_SPIN_CAP (1u << 27)
#else
#define XB_SPIN_CAP (1u << 20)
#endif
__device__ __forceinline__ unsigned xb_ld(unsigned* p)              { return __hip_atomic_load(p, __ATOMIC_RELAXED, __HIP_MEMORY_SCOPE_AGENT); }
__device__ __forceinline__ unsigned xb_add(unsigned* p, unsigned v) { return __hip_atomic_fetch_add(p, v, __ATOMIC_RELAXED, __HIP_MEMORY_SCOPE_AGENT); }
__device__ __forceinline__ unsigned xb_xcc_id() { return (unsigned)__builtin_amdgcn_s_getreg((3 << 11) | 20) & 0xFu; }
#define XB_SPIN(cond, bar) do { unsigned _sp = 0; while (cond) { __builtin_amdgcn_s_sleep(1); \
    if ((++_sp & 255u) == 0u) { if (xb_ld(&(bar)[XB_TMO])) break; if (_sp > XB_SPIN_CAP) { atomicAdd(&(bar)[XB_TMO], 1u); break; } } } } while (0)
struct XcdBarrier { unsigned* bar; unsigned x; volatile LAS unsigned* st; };
__device__ __forceinline__ XcdBarrier xcd_barrier_post(unsigned* bar, volatile LAS unsigned* st) {
    XcdBarrier b; b.bar = bar; b.x = xb_xcc_id(); b.st = st;
    if (threadIdx.x == 0) (void)xb_add(&bar[XB_XCNT(b.x)], 1u);
    return b;
}
__device__ __forceinline__ void xcd_barrier_complete(unsigned* bar, unsigned x, unsigned& nloc, unsigned& nx) {
    const unsigned G = gridDim.x * gridDim.y * gridDim.z;
    unsigned sum, cnt, mine, sp = 0u;
    for (;;) {
        sum = 0u; cnt = 0u; mine = 0u;
#pragma unroll
        for (unsigned j = 0; j < 16; ++j) { const unsigned c = xb_ld(&bar[XB_XCNT(j)]); sum += c; cnt += (c > 0u) ? 1u : 0u; mine = (j == x) ? c : mine; }
        if (sum == G) break;
        __builtin_amdgcn_s_sleep(1);
        if ((++sp & 255u) == 0u) { if (xb_ld(&bar[XB_TMO])) break; if (sp > XB_SPIN_CAP) { atomicAdd(&bar[XB_TMO], 1u); break; } }
    }
    nloc = mine > 0u ? mine : 1u; nx = cnt > 0u ? cnt : 1u;
}
__device__ __forceinline__ void xcd_barrier(const XcdBarrier& b) {
    asm volatile("s_waitcnt vmcnt(0)" ::: "memory");
    __syncthreads();
    if (threadIdx.x == 0) {
        unsigned* bar = b.bar;
        __builtin_amdgcn_s_waitcnt(0);
        unsigned nloc = b.st[0], nx = b.st[1];
        if (nloc == 0u) { xcd_barrier_complete(bar, b.x, nloc, nx); b.st[0] = nloc; b.st[1] = nx; }
        const unsigned old = xb_add(&bar[XB_XSUB(b.x)], 1u);
        const unsigned gen = old / nloc;
        if (old + 1u == (gen + 1u) * nloc) {
            __builtin_amdgcn_fence(__ATOMIC_RELEASE, "agent");
            asm volatile("s_waitcnt vmcnt(0)" ::: "memory");
            const unsigned og = xb_add(&bar[XB_TOP], 1u);
            const unsigned tg = og / nx;
            if (og + 1u == (tg + 1u) * nx) xb_add(&bar[XB_TOPGEN], 1u);
            else XB_SPIN(xb_ld(&bar[XB_TOPGEN]) == tg, bar);
            __builtin_amdgcn_fence(__ATOMIC_ACQUIRE, "agent");
            xb_add(&bar[XB_XGEN(b.x)], 1u);
            asm volatile("s_waitcnt vmcnt(0)" ::: "memory");
        } else {
            XB_SPIN(xb_ld(&bar[XB_XGEN(b.x)]) == gen, bar);
            __builtin_amdgcn_fence(__ATOMIC_ACQUIRE, "agent");
            asm volatile("s_waitcnt vmcnt(0)" ::: "memory");
        }
    }
    __syncthreads();
}

namespace pg8 {
constexpr int BM = 256, BK = 64, HALF = 128, HTB = HALF * BK * 2, STAGE_BYTES = 8 * HTB, NXCD = 8, WGM = 8;
__host__ __device__ __forceinline__ int lds_byte(int r, int c) { const int st = (r >> 4) * 2 + (c >> 5), rr = r & 15, cc = c & 31, ob = rr * 64 + cc * 2; return st * 1024 + (ob ^ (((ob >> 9) & 1) << 5)); }
__host__ __device__ __forceinline__ void stage_rc(int b, int& R_, int& C_) { const int st = b / 1024, sb = b % 1024, swz = sb ^ (((sb >> 9) & 1) << 5); R_ = (st >> 1) * 16 + swz / 64; C_ = (st & 1) * 32 + (swz % 64) / 2; }
__host__ __device__ __forceinline__ int perm32(int rho) { const int n = rho >> 4, i = rho & 15; return 8 * (i >> 2) + 4 * n + (i & 3); }

struct Unit { int pm, pn, z; };
template <class T, class = void> struct HasPrep : std::false_type {};
template <class T> struct HasPrep<T, std::void_t<typename T::Prep>> : std::true_type {};

struct GridOrder {
    int nM, nN, nwg, G, c;
    __device__ __forceinline__ void init(int nM_, int nN_, int G_, int c_) { nM = nM_; nN = nN_; nwg = nM * nN; G = G_; c = c_; }
    __device__ __forceinline__ bool next2(int i, int& pm, int& pn) const {
        const int L = i * G + c; if (L >= nwg) return false;
        int wgid = L; { const int q = nwg / NXCD, r = nwg % NXCD, xcd = wgid % NXCD, off = wgid / NXCD; wgid = (xcd < r ? xcd * (q + 1) : r * (q + 1) + (xcd - r) * q) + off; }
        const int nig = WGM * nN, gid = wgid / nig, fm = gid * WGM, gsz = (nM - fm) < WGM ? (nM - fm) : WGM;
        pm = fm + ((wgid % nig) % gsz); pn = (wgid % nig) / gsz; return true;
    }
};

__device__ __forceinline__ const char* uniform_ptr(const char* p) { const unsigned long long v = (unsigned long long)p; const unsigned lo = (unsigned)__builtin_amdgcn_readfirstlane((int)(unsigned)v), hi = (unsigned)__builtin_amdgcn_readfirstlane((int)(unsigned)(v >> 32)); return (const char*)(((unsigned long long)hi << 32) | lo); }
typedef int i32x4 __attribute__((ext_vector_type(4)));
typedef int i32x8 __attribute__((ext_vector_type(8)));
constexpr int FP8_WSHIFT = 8;
constexpr int FP8_SCALE_W = 0x7f7f7f7f, FP8_SCALE_A = 0x7f7f7f7f;
constexpr float FP8_WINV = 1.0f / (float)(1 << FP8_WSHIFT);
#if !NAIVE_GEMM
template <bool FP8, class F, class Sched, bool I8 = false>
__device__ __forceinline__ void gemm_phase(LAS unsigned char* lds, const unsigned char* wsb, const int wv, const int lda, const int ldb, const int nt, const Sched& S, const F& f) {
    constexpr int ES = (FP8 || I8) ? 1 : 2;
    const int tid = fresh_tid(wv), wid = __builtin_amdgcn_readfirstlane(tid >> 6), lane = tid & 63, wr = wid >> 2, wc = wid & 3, fr = lane & 15, fq = lane >> 4;
    unsigned voffA[2], voffB[2];
#pragma unroll
    for (int i = 0; i < 2; ++i) { int R_, C_; stage_rc(tid * 16 + i * 8192, R_, C_); const int Rb = (R_ & ~31) + perm32(R_ & 31);
        voffA[i] = (unsigned)(R_ * lda * ES + C_ * 2); voffB[i] = (unsigned)(Rb * ldb * ES + C_ * 2); }
    const unsigned kstep = (unsigned)(BK * 2);
    const unsigned hsA = (unsigned)(HALF * lda * ES), hsB = (unsigned)(HALF * ldb * ES);
    const __amdgpu_buffer_rsrc_t rsA = __builtin_amdgcn_make_buffer_rsrc((void*)wsb, 0, 0xffffffff, 0x00020000);
    const unsigned ldsw = (unsigned)wid * 1024u;
    const int aoff = lds_byte(wr * 64 + fr, fq * 8), boff = lds_byte(wc * 32 + fr, fq * 8);
#define PG8_SA(b, h) (((b) * 2 + (h)) * HTB)
#define PG8_SB(b, h) ((4 + (b) * 2 + (h)) * HTB)
#define PG8_STAGE(bufoff, goff, voff) do { _Pragma("unroll") for (int _i = 0; _i < 2; ++_i) \
        __builtin_amdgcn_raw_ptr_buffer_load_lds(PG8_RS_##voff, (LAS void*)(lds + (bufoff) + ldsw + _i * 8192), 16, (int)(voff)[_i], (int)(goff), 0, 0); } while (0)
#define PG8_RS_voffA rsA
#define PG8_RS_voffB rsA
#define PG8_LDA(dst, b, h) do { _Pragma("unroll") for (int m = 0; m < 4; ++m) _Pragma("unroll") for (int k = 0; k < 2; ++k) dst[m][k] = *(const LAS bf16x8*)(lds + PG8_SA(b, h) + aoff + m * 2048 + k * 1024); } while (0)
#define PG8_LDB(dst, b, h) do { _Pragma("unroll") for (int n = 0; n < 2; ++n) _Pragma("unroll") for (int k = 0; k < 2; ++k) dst[n][k] = *(const LAS bf16x8*)(lds + PG8_SB(b, h) + boff + n * 2048 + k * 1024); } while (0)
#define PG8_CAT8(x) __builtin_shufflevector(__builtin_bit_cast(i32x4, (x)[0]), __builtin_bit_cast(i32x4, (x)[1]), 0, 1, 2, 3, 4, 5, 6, 7)
#define PG8_MMA(ai, bj, At, Bt) do { __builtin_amdgcn_s_setprio(1); \
        if constexpr (FP8) { _Pragma("unroll") for (int m = 0; m < 4; ++m) _Pragma("unroll") for (int n = 0; n < 2; ++n) \
            acc[ai][bj][m][n] = __builtin_amdgcn_mfma_scale_f32_16x16x128_f8f6f4(PG8_CAT8(Bt[n]), PG8_CAT8(At[m]), acc[ai][bj][m][n], 0, 0, 0, FP8_SCALE_W, 0, FP8_SCALE_A); } \
        else if constexpr (I8) { _Pragma("unroll") for (int m = 0; m < 4; ++m) _Pragma("unroll") for (int n = 0; n < 2; ++n) _Pragma("unroll") for (int k = 0; k < 2; ++k) \
            acc[ai][bj][m][n] = __builtin_bit_cast(f32x4, __builtin_amdgcn_mfma_i32_16x16x64_i8(__builtin_bit_cast(i32x4, Bt[n][k]), __builtin_bit_cast(i32x4, At[m][k]), __builtin_bit_cast(i32x4, acc[ai][bj][m][n]), 0, 0, 0)); } \
        else { _Pragma("unroll") for (int m = 0; m < 4; ++m) _Pragma("unroll") for (int n = 0; n < 2; ++n) _Pragma("unroll") for (int k = 0; k < 2; ++k) \
            acc[ai][bj][m][n] = __builtin_amdgcn_mfma_f32_16x16x32_bf16(Bt[n][k], At[m][k], acc[ai][bj][m][n], 0, 0, 0); } \
        __builtin_amdgcn_s_setprio(0); } while (0)
#define PG8_WAIT_V(n) asm volatile("s_waitcnt vmcnt(" #n ")" ::: "memory")
#define PG8_WAIT_L(n) asm volatile("s_waitcnt lgkmcnt(" #n ")" ::: "memory")
#define PG8_BAR __builtin_amdgcn_s_barrier()
#define PG8_SCHED __builtin_amdgcn_sched_barrier(0)
    Unit cur, nxt; int ui = 0;
    if (!S.next(0, cur)) return;
    f32x4 acc[2][2][4][2];
#pragma unroll
    for (int a = 0; a < 2; ++a)
#pragma unroll
        for (int b = 0; b < 2; ++b)
#pragma unroll
            for (int m = 0; m < 4; ++m)
#pragma unroll
                for (int n = 0; n < 2; ++n) acc[a][b][m][n] = (f32x4){0.f, 0.f, 0.f, 0.f};
    bf16x8 At[4][2], B0[2][2], B1[2][2];
    unsigned cA, cB; { const char* pa; const char* pb; S.ptrs(cur, pa, pb); cA = (unsigned)__builtin_amdgcn_readfirstlane((int)(unsigned)(pa - (const char*)wsb)); cB = (unsigned)__builtin_amdgcn_readfirstlane((int)(unsigned)(pb - (const char*)wsb)); }
    PG8_STAGE(PG8_SB(0, 0), cB, voffB); PG8_STAGE(PG8_SB(0, 1), cB + hsB, voffB); PG8_STAGE(PG8_SA(0, 0), cA, voffA); PG8_STAGE(PG8_SA(0, 1), cA + hsA, voffA);
    if (wr == 1) PG8_BAR;
    PG8_WAIT_V(2); PG8_BAR;
    PG8_STAGE(PG8_SB(1, 0), cB + kstep, voffB); PG8_STAGE(PG8_SA(1, 0), cA + kstep, voffA); PG8_STAGE(PG8_SB(1, 1), cB + hsB + kstep, voffB);
    PG8_WAIT_V(6); PG8_BAR;
    for (;;) {
        const bool has_next = S.next(ui + 1, nxt);
        unsigned nA = cA, nB = cB; if (has_next) { const char* pa; const char* pb; S.ptrs(nxt, pa, pb); nA = (unsigned)__builtin_amdgcn_readfirstlane((int)(unsigned)(pa - (const char*)wsb)); nB = (unsigned)__builtin_amdgcn_readfirstlane((int)(unsigned)(pb - (const char*)wsb)); }
        for (int t = 0; t < nt; t += 2) {
            const bool last = (t == nt - 2);
            const unsigned a1 = cA + (unsigned)(t + 1) * kstep;
            const unsigned a2 = last ? nA : cA + (unsigned)(t + 2) * kstep, b2 = last ? nB : cB + (unsigned)(t + 2) * kstep;
            const unsigned a3 = a2 + kstep, b3 = b2 + kstep;
            PG8_LDB(B0, 0, 0); PG8_LDB(B1, 0, 1); PG8_SCHED; PG8_LDA(At, 0, 0); PG8_STAGE(PG8_SA(1, 1), a1 + hsA, voffA);
            PG8_WAIT_V(8); PG8_WAIT_L(0); PG8_BAR; PG8_MMA(0, 0, At, B0); PG8_MMA(0, 1, At, B1); PG8_BAR; PG8_SCHED;
            PG8_LDA(At, 0, 1); PG8_STAGE(PG8_SB(0, 0), b2, voffB); PG8_STAGE(PG8_SB(0, 1), b2 + hsB, voffB); PG8_STAGE(PG8_SA(0, 0), a2, voffA);
            PG8_WAIT_V(8); PG8_WAIT_L(0); PG8_BAR; PG8_MMA(1, 0, At, B0); PG8_MMA(1, 1, At, B1); PG8_BAR; PG8_SCHED;
            PG8_LDB(B0, 1, 0); PG8_LDB(B1, 1, 1); PG8_SCHED; PG8_LDA(At, 1, 0); PG8_STAGE(PG8_SA(0, 1), a2 + hsA, voffA);
            PG8_WAIT_V(8); PG8_WAIT_L(0); PG8_BAR; PG8_MMA(0, 0, At, B0); PG8_MMA(0, 1, At, B1); PG8_BAR; PG8_SCHED;
            PG8_LDA(At, 1, 1); PG8_STAGE(PG8_SB(1, 0), b3, voffB); PG8_STAGE(PG8_SB(1, 1), b3 + hsB, voffB); PG8_STAGE(PG8_SA(1, 0), a3, voffA);
            PG8_WAIT_V(8); PG8_WAIT_L(0); PG8_BAR; PG8_MMA(1, 0, At, B0); PG8_MMA(1, 1, At, B1); PG8_BAR; PG8_SCHED;
        }
        if (wr == 0) PG8_BAR;
        if constexpr (HasPrep<F>::value) { const auto pr_ = f.prep(cur, wc * 32 + 8 * fq, wr * 64 + fr);
#pragma unroll
        for (int ai = 0; ai < 2; ++ai)
#pragma unroll
            for (int m = 0; m < 4; ++m) {
                f32x4 a[2][2];
#pragma unroll
                for (int bj = 0; bj < 2; ++bj)
#pragma unroll
                    for (int n = 0; n < 2; ++n) { if constexpr (I8) a[bj][n] = __builtin_convertvector(__builtin_bit_cast(i32x4, acc[ai][bj][m][n]), f32x4); else a[bj][n] = acc[ai][bj][m][n]; }
                f.row(cur, ai * HALF + wr * 64 + m * 16 + fr, wc * 32 + 8 * fq, a, pr_, ai * 4 + m);
            }
        } else {
#pragma unroll
        for (int ai = 0; ai < 2; ++ai)
#pragma unroll
            for (int m = 0; m < 4; ++m) {
                f32x4 a[2][2];
#pragma unroll
                for (int bj = 0; bj < 2; ++bj)
#pragma unroll
                    for (int n = 0; n < 2; ++n) { if constexpr (I8) a[bj][n] = __builtin_convertvector(__builtin_bit_cast(i32x4, acc[ai][bj][m][n]), f32x4); else a[bj][n] = acc[ai][bj][m][n]; }
                f.row(cur, ai * HALF + wr * 64 + m * 16 + fr, wc * 32 + 8 * fq, a);
            }
        }
        if (!has_next) break;
#pragma unroll
        for (int a = 0; a < 2; ++a)
#pragma unroll
            for (int b = 0; b < 2; ++b)
#pragma unroll
                for (int m = 0; m < 4; ++m)
#pragma unroll
                    for (int n = 0; n < 2; ++n) acc[a][b][m][n] = (f32x4){0.f, 0.f, 0.f, 0.f};
        cur = nxt; cA = nA; cB = nB; ++ui;
        if (wr == 1) PG8_BAR;
    }
    PG8_WAIT_V(0);
    PG8_BAR;
#undef PG8_SA
#undef PG8_SB
#undef PG8_STAGE
#undef PG8_RS_voffA
#undef PG8_RS_voffB
#undef PG8_LDA
#undef PG8_LDB
#undef PG8_MMA
#undef PG8_CAT8
#undef PG8_WAIT_V
#undef PG8_WAIT_L
#undef PG8_BAR
#undef PG8_SCHED
}
#else
__device__ __forceinline__ float fp8_to_f(unsigned b) { const unsigned e = (b >> 3) & 15u, m = b & 7u; const float v = e ? __uint_as_float(((e + 120u) << 23) | (m << 20)) : (float)m * 0.001953125f; return (b & 128u) ? -v : v; }
template <bool FP8, class F, class Sched, bool I8 = false>
__device__ __forceinline__ void gemm_phase(LAS unsigned char* lds, const unsigned char* wsb, const int wv, const int lda, const int ldb, const int nt_, const Sched& S, const F& f) {
    const int nt = (FP8 || I8) ? nt_ * 2 : nt_;
    const int tid = fresh_tid(wv);
    LAS float* As = (LAS float*)lds;
    LAS float* Bs = As + 64 * 65;
    Unit u;
    for (int i = 0; S.next(i, u); ++i) {
        const char* cA; const char* cB; S.ptrs(u, cA, cB);
        const bf16_t* A = (const bf16_t*)cA; const bf16_t* B = (const bf16_t*)cB; const unsigned char* A8 = (const unsigned char*)cA; const unsigned char* B8 = (const unsigned char*)cB;
        for (int sub = 0; sub < 8; ++sub) {
            const int r0 = (sub >> 1) * 64, c0 = (sub & 1) * 64;
            float acc[2][8];
#pragma unroll
            for (int b = 0; b < 2; ++b)
#pragma unroll
                for (int j = 0; j < 8; ++j) acc[b][j] = 0.f;
            const int tr = tid >> 3, tc = (tid & 7) * 8;
            for (int kt = 0; kt < nt; ++kt) {
                __syncthreads();
                for (int e = tid; e < 4096; e += 512) { const int rr = e >> 6, kk = e & 63;
                    if constexpr (I8) {
                    As[rr * 65 + kk] = (float)(signed char)A8[(size_t)(r0 + rr) * lda + kt * 64 + kk];
                    Bs[rr * 65 + kk] = (float)(signed char)B8[(size_t)(c0 + rr) * ldb + kt * 64 + kk];
                    Bs[(64 + rr) * 65 + kk] = (float)(signed char)B8[(size_t)(128 + c0 + rr) * ldb + kt * 64 + kk]; } else
                    if constexpr (FP8) {
                    As[rr * 65 + kk] = fp8_to_f(A8[(size_t)(r0 + rr) * lda + kt * 64 + kk]);
                    Bs[rr * 65 + kk] = fp8_to_f(B8[(size_t)(c0 + rr) * ldb + kt * 64 + kk]);
                    Bs[(64 + rr) * 65 + kk] = fp8_to_f(B8[(size_t)(128 + c0 + rr) * ldb + kt * 64 + kk]); } else {
                    As[rr * 65 + kk] = bf2f(A[(size_t)(r0 + rr) * lda + kt * 64 + kk]);
                    Bs[rr * 65 + kk] = bf2f(B[(size_t)(c0 + rr) * ldb + kt * 64 + kk]);
                    Bs[(64 + rr) * 65 + kk] = bf2f(B[(size_t)(128 + c0 + rr) * ldb + kt * 64 + kk]); } }
                __syncthreads();
                for (int kk = 0; kk < 64; ++kk) { const float a = As[tr * 65 + kk];
#pragma unroll
                    for (int j = 0; j < 8; ++j) { acc[0][j] += a * Bs[(tc + j) * 65 + kk]; acc[1][j] += a * Bs[(64 + tc + j) * 65 + kk]; } }
            }
            f32x4 a[2][2];
#pragma unroll
            for (int b = 0; b < 2; ++b) { a[b][0] = (f32x4){acc[b][0], acc[b][1], acc[b][2], acc[b][3]}; a[b][1] = (f32x4){acc[b][4], acc[b][5], acc[b][6], acc[b][7]}; }
            f.row(u, r0 + tr, c0 + tc, a);
        }
    }
    __syncthreads();
}
#endif
}

struct Args { const float* in[27]; float* out; unsigned char* ws; };
typedef __attribute__((address_space(4))) const char* kaddr_t;
__device__ __forceinline__ const float* in_ptr(int i) { kaddr_t k = (kaddr_t)__builtin_amdgcn_kernarg_segment_ptr(); asm volatile("" : "+s"(k)); return (const float*)*(__attribute__((address_space(4))) const unsigned long long*)(k + 8 * i); }
struct Frame {
    LAS unsigned char* lds;
    unsigned* ctl;
    unsigned char* ws;
    int vcu, G, wv;
    float* out;
};

__device__ __forceinline__ int fresh_tid(int wv) { int l; asm volatile("v_mbcnt_lo_u32_b32 %0, -1, 0\n\tv_mbcnt_hi_u32_b32 %0, -1, %0" : "=v"(l)); return wv * 64 + l; }
#define PHASE_IDS() const int tid = fresh_tid(F.wv); const int lane = tid & 63; const int wave = __builtin_amdgcn_readfirstlane(tid >> 6); (void)tid; (void)lane; (void)wave
__device__ __forceinline__ int row_t(int row) { return row % TPB; }
__device__ __forceinline__ int row_b(int row) { return row / TPB; }
__device__ __forceinline__ int row_modidx(int row) { return (row % TPB) < CTXL ? 2 : row / TPB; }

__device__ __forceinline__ const float* modp(const Frame& F, int l, int mi, int which) { return (const float*)(F.ws + WS_MOD) + ((size_t)(l * 3 + mi) * 6 + which) * DM; }

struct EpiG1 {
    bf16_t* P; const float* bgate; const float* ropec; const float* ropes; const float* hsc = nullptr; const float* wsc = nullptr;
    struct Prep { f32x4 s[2][2]; float hs[8]; };
    __device__ __forceinline__ Prep prep(const pg8::Unit& u, int cit, int rbase) const { Prep p;
#pragma unroll
        for (int bj = 0; bj < 2; ++bj) { const int col = u.pn * 256 + bj * 128 + cit;
            if (wsc) { p.s[bj][0] = *(const f32x4*)(wsc + col); p.s[bj][1] = *(const f32x4*)(wsc + col + 4); } else { p.s[bj][0] = (f32x4){1.f, 1.f, 1.f, 1.f}; p.s[bj][1] = p.s[bj][0]; } }
#pragma unroll
        for (int k = 0; k < 8; ++k) p.hs[k] = wsc ? hsc[u.pm * 256 + rbase + (k >> 2) * 128 + (k & 3) * 16] : 1.0f;
        return p; }
    __device__ __forceinline__ void row(const pg8::Unit& u, int rit, int cit, const f32x4 (&a)[2][2], const Prep& pp, int k) const {
        const int grow = u.pm * 256 + rit;
        const float hs = pp.hs[k];
#pragma unroll
        for (int bj = 0; bj < 2; ++bj) {
            const int col = u.pn * 256 + bj * 128 + cit;
            if (u.pn == 24 && col >= CKR + 64) continue;
            float v[8] = {a[bj][0][0], a[bj][0][1], a[bj][0][2], a[bj][0][3], a[bj][1][0], a[bj][1][1], a[bj][1][2], a[bj][1][3]};
            if (wsc) { const f32x4 s0 = pp.s[bj][0], s1 = pp.s[bj][1];
                v[0] *= hs * s0[0]; v[1] *= hs * s0[1]; v[2] *= hs * s0[2]; v[3] *= hs * s0[3]; v[4] *= hs * s1[0]; v[5] *= hs * s1[1]; v[6] *= hs * s1[2]; v[7] *= hs * s1[3]; }
            if (u.pn >= 8 && u.pn < 24) {
                const f32x4 b0 = *(const f32x4*)(bgate + col - CGATE), b1 = *(const f32x4*)(bgate + col - CGATE + 4);
                v[0] = sigmoidf_(v[0] + b0[0]); v[1] = sigmoidf_(v[1] + b0[1]); v[2] = sigmoidf_(v[2] + b0[2]); v[3] = sigmoidf_(v[3] + b0[3]);
                v[4] = sigmoidf_(v[4] + b1[0]); v[5] = sigmoidf_(v[5] + b1[1]); v[6] = sigmoidf_(v[6] + b1[2]); v[7] = sigmoidf_(v[7] + b1[3]);
            } else if (u.pn == 24) {
                if (col >= CKR + 64) continue;
                const int t = grow % TPB;
                if (t >= CTXL) { const int s = t - CTXL, i0 = (col - CKR) >> 1;
                    const f32x4 cs = *(const f32x4*)(ropec + s * 32 + i0), sn = *(const f32x4*)(ropes + s * 32 + i0);
#pragma unroll
                    for (int p = 0; p < 4; ++p) { const float x1 = v[2 * p], x2 = v[2 * p + 1]; v[2 * p] = x1 * cs[p] - x2 * sn[p]; v[2 * p + 1] = x1 * sn[p] + x2 * cs[p]; } }
            }
            *(u32x4*)(P + (size_t)grow * INWP + col) = pack8(v);
        }
    }
};
struct EpiQ {
    bf16_t* Q; const float* ropec; const float* ropes;
    __device__ __forceinline__ void row(const pg8::Unit& u, int rit, int cit, const f32x4 (&a)[2][2]) const {
        const int grow = u.pm * 256 + rit; const int t = grow % TPB;
#pragma unroll
        for (int bj = 0; bj < 2; ++bj) {
            const int col = u.pn * 256 + bj * 128 + cit, d = col % DQK;
            float v[8] = {a[bj][0][0], a[bj][0][1], a[bj][0][2], a[bj][0][3], a[bj][1][0], a[bj][1][1], a[bj][1][2], a[bj][1][3]};
            if (d >= DN && t >= CTXL) { const int s = t - CTXL, i0 = (d - DN) >> 1;
                const f32x4 cs = *(const f32x4*)(ropec + s * 32 + i0), sn = *(const f32x4*)(ropes + s * 32 + i0);
#pragma unroll
                for (int p = 0; p < 4; ++p) { const float x1 = v[2 * p], x2 = v[2 * p + 1]; v[2 * p] = x1 * cs[p] - x2 * sn[p]; v[2 * p + 1] = x1 * sn[p] + x2 * cs[p]; } }
            *(u32x4*)(Q + (size_t)grow * 3072 + col) = pack8(v);
        }
    }
};
struct EpiKV {
    bf16_t* KN; bf16_t* V;
    __device__ __forceinline__ void row(const pg8::Unit& u, int rit, int cit, const f32x4 (&a)[2][2]) const {
        const int grow = u.pm * 256 + rit;
#pragma unroll
        for (int bj = 0; bj < 2; ++bj) {
            float v[8] = {a[bj][0][0], a[bj][0][1], a[bj][0][2], a[bj][0][3], a[bj][1][0], a[bj][1][1], a[bj][1][2], a[bj][1][3]};
            bf16_t* dst = (bj == 0 ? KN : V) + (size_t)grow * 2048 + u.pn * 128 + cit;
            *(u32x4*)dst = pack8(v);
        }
    }
};
struct EpiPool {
    bf16_t* POOLM; const bf16_t* P; const float* pscale;
    __device__ __forceinline__ void row(const pg8::Unit& u, int rit, int cit, const f32x4 (&a)[2][2]) const {
        const int grow = u.pm * 256 + rit;
#pragma unroll
        for (int bj = 0; bj < 2; ++bj) {
            const int col = u.pn * 256 + bj * 128 + cit;
            float v[8] = {a[bj][0][0], a[bj][0][1], a[bj][0][2], a[bj][0][3], a[bj][1][0], a[bj][1][1], a[bj][1][2], a[bj][1][3]};
            float g[8]; unpack8(*(const u32x4*)(P + (size_t)grow * INWP + CGATE + 2048 + col), g);
            const f32x4 s0 = *(const f32x4*)(pscale + col), s1 = *(const f32x4*)(pscale + col + 4);
            v[0] *= s0[0] * g[0]; v[1] *= s0[1] * g[1]; v[2] *= s0[2] * g[2]; v[3] *= s0[3] * g[3];
            v[4] *= s1[0] * g[4]; v[5] *= s1[1] * g[5]; v[6] *= s1[2] * g[6]; v[7] *= s1[3] * g[7];
            *(u32x4*)(POOLM + (size_t)grow * 2048 + col) = pack8(v);
        }
    }
};
struct EpiPlain {
    bf16_t* O; int ldc;
    __device__ __forceinline__ void row(const pg8::Unit& u, int rit, int cit, const f32x4 (&a)[2][2]) const {
        const int grow = u.pm * 256 + rit;
#pragma unroll
        for (int bj = 0; bj < 2; ++bj) {
            const int col = u.pn * 256 + bj * 128 + cit;
            float v[8] = {a[bj][0][0], a[bj][0][1], a[bj][0][2], a[bj][0][3], a[bj][1][0], a[bj][1][1], a[bj][1][2], a[bj][1][3]};
            *(u32x4*)(O + (size_t)grow * ldc + col) = pack8(v);
        }
    }
};
struct EpiSwiglu {
    bf16_t* ACT;
    __device__ __forceinline__ void row(const pg8::Unit& u, int rit, int cit, const f32x4 (&a)[2][2]) const {
        const int grow = u.pm * 256 + rit;
        float v[8];
#pragma unroll
        for (int n = 0; n < 2; ++n)
#pragma unroll
            for (int j = 0; j < 4; ++j) { const float g = a[0][n][j], up = a[1][n][j]; v[n * 4 + j] = g * sigmoidf_(g) * up; }
        *(u32x4*)((char*)ACT + (unsigned)(grow * DFF + u.pn * 128 + cit) * 2u) = pack8(v);
    }
};
__device__ __forceinline__ f32x2 swiglu2(f32x2 a, f32x2 b, f32x2 ce, f32x2 cp) {
    const f32x2 t = a * ce; f32x2 d; d.x = __builtin_amdgcn_exp2f(t.x); d.y = __builtin_amdgcn_exp2f(t.y); d = d + 1.0f;
    f32x2 r; r.x = __builtin_amdgcn_rcpf(d.x); r.y = __builtin_amdgcn_rcpf(d.y);
    return ((a * b) * cp) * r;
}
struct EpiSwigluI8 {
    unsigned char* ws;
    struct Prep { f32x4 g0, g1, u0, u1; float hs[8]; };
    __device__ __forceinline__ Prep prep(const pg8::Unit& u, int cit, int rbase) const { const float* wg = (const float*)(ws + WS_WSC) + u.pn * 128 + cit; const float* wu = wg + DFF;
        Prep p; p.g0 = *(const f32x4*)wg; p.g1 = *(const f32x4*)(wg + 4); p.u0 = *(const f32x4*)wu; p.u1 = *(const f32x4*)(wu + 4);
        const float* hp = (const float*)(ws + WS_HSC) + u.pm * 256 + rbase;
#pragma unroll
        for (int k = 0; k < 8; ++k) p.hs[k] = hp[(k >> 2) * 128 + (k & 3) * 16];
        return p; }
    __device__ __forceinline__ void row(const pg8::Unit& u, int rit, int cit, const f32x4 (&a)[2][2], const Prep& pp, int k) const {
        const int grow = u.pm * 256 + rit, col = u.pn * 128 + cit;
        const float hs = pp.hs[k];
        const f32x4 g0 = pp.g0, g1 = pp.g1, u0 = pp.u0, u1 = pp.u1;
        float v[8];
        { const f32x4 sg0 = g0 * hs, sg1 = g1 * hs, ce0 = sg0 * -1.4426950408889634f, ce1 = sg1 * -1.4426950408889634f, cp0 = sg0 * (u0 * hs), cp1 = sg1 * (u1 * hs);
#pragma unroll
          for (int j = 0; j < 4; j += 2) {
              const f32x2 o0 = swiglu2((f32x2){a[0][0][j], a[0][0][j + 1]}, (f32x2){a[1][0][j], a[1][0][j + 1]}, (f32x2){ce0[j], ce0[j + 1]}, (f32x2){cp0[j], cp0[j + 1]});
              const f32x2 o1 = swiglu2((f32x2){a[0][1][j], a[0][1][j + 1]}, (f32x2){a[1][1][j], a[1][1][j + 1]}, (f32x2){ce1[j], ce1[j + 1]}, (f32x2){cp1[j], cp1[j + 1]});
              v[j] = o0.x; v[j + 1] = o0.y; v[4 + j] = o1.x; v[4 + j + 1] = o1.y; } }
        *(u32x4*)(ws + WS_ACT + (unsigned)(grow * DFF + col) * 2u) = pack8(v);
    }
};
struct EpiSwiglu8 {
    unsigned char* ws;
    __device__ __forceinline__ void row(const pg8::Unit& u, int rit, int cit, const f32x4 (&a)[2][2]) const {
        const int grow = u.pm * 256 + rit;
        float v[8];
#pragma unroll
        for (int n = 0; n < 2; ++n)
#pragma unroll
            for (int j = 0; j < 4; j += 2) { const f32x2 ce = {pg8::FP8_WINV * -1.4426950408889634f, pg8::FP8_WINV * -1.4426950408889634f}, cp = {pg8::FP8_WINV * pg8::FP8_WINV, pg8::FP8_WINV * pg8::FP8_WINV};
                const f32x2 o2 = swiglu2((f32x2){a[0][n][j], a[0][n][j + 1]}, (f32x2){a[1][n][j], a[1][n][j + 1]}, ce, cp); v[n * 4 + j] = o2.x; v[n * 4 + j + 1] = o2.y; }
        u32x2 w; w.x = cvt4_fp8(v[0], v[1], v[2], v[3]); w.y = cvt4_fp8(v[4], v[5], v[6], v[7]);
        *(u32x2*)(ws + WS_ACT + (unsigned)(grow * DFF + u.pn * 128 + cit)) = w;
    }
};
struct EpiDown {
    unsigned char* ws; unsigned zstride; float sc;
    __device__ __forceinline__ void row(const pg8::Unit& u, int rit, int cit, const f32x4 (&a)[2][2]) const {
        const int grow = u.pm * 256 + rit;
#pragma unroll
        for (int bj = 0; bj < 2; ++bj) {
            float v[8] = {a[bj][0][0] * sc, a[bj][0][1] * sc, a[bj][0][2] * sc, a[bj][0][3] * sc, a[bj][1][0] * sc, a[bj][1][1] * sc, a[bj][1][2] * sc, a[bj][1][3] * sc};
            *(u32x4*)((char*)(ws + WS_Y2) + ((unsigned)u.z * zstride + (unsigned)(grow * DM + u.pn * 256 + bj * 128 + cit)) * 2u) = pack8(v);
        }
    }
};

struct SchedDense {
    pg8::GridOrder o; const char* A; const char* B; size_t lda2, ldb2;
    bool lat_only = false;
    __device__ __forceinline__ bool next(int i, pg8::Unit& u) const { u.z = 0; if (!o.next2(i, u.pm, u.pn)) return false; if (lat_only) u.pm += 1 + (u.pm >= 16 ? 1 : 0); return true; }
    __device__ __forceinline__ void ptrs(const pg8::Unit& u, const char*& a, const char*& b) const { a = A + (size_t)u.pm * 256 * lda2; b = B + (size_t)u.pn * 256 * ldb2; }
};
struct SchedG1Last {
    pg8::GridOrder o; const char* A; const char* B; int es = 2;
    __device__ __forceinline__ bool next(int i, pg8::Unit& u) const { u.z = 0;
        if (o.next2(i, u.pm, u.pn)) { u.pm += 1 + (u.pm >= 16 ? 1 : 0); return true; }
        const int k = i * o.G + o.c - o.nwg; if (k < 0 || k >= 6) return false;
        u.pm = (k / 3) * 17; u.pn = (k % 3) == 2 ? 24 : 2 + (k % 3); return true; }
    __device__ __forceinline__ void ptrs(const pg8::Unit& u, const char*& a, const char*& b) const { a = A + (size_t)u.pm * 256 * DM * es; b = B + (size_t)u.pn * 256 * DM * es; }
};
struct SchedPool {
    pg8::GridOrder o; const char* A; const char* B; bool lat_only = false;
    __device__ __forceinline__ bool next(int i, pg8::Unit& u) const { u.z = 0; if (!o.next2(i, u.pm, u.pn)) return false; if (lat_only) u.pm += 1 + (u.pm >= 16 ? 1 : 0); return true; }
    __device__ __forceinline__ void ptrs(const pg8::Unit& u, const char*& a, const char*& b) const { a = A + ((size_t)u.pm * 256 * POOLW + (size_t)(u.pn >> 1) * 256) * 2; b = B + (size_t)u.pn * 256 * 256 * 2; }
};
struct SchedSplitK {
    pg8::GridOrder o; const char* A; const char* B; int nN;
    __device__ __forceinline__ bool next(int i, pg8::Unit& u) const { int pn2; if (!o.next2(i, u.pm, pn2)) return false; u.pn = pn2 % nN; u.z = pn2 / nN; return true; }
    __device__ __forceinline__ void ptrs(const pg8::Unit& u, const char*& a, const char*& b) const { a = A + ((size_t)u.pm * 256 * DFF + (size_t)u.z * KSPL) * 2; b = B + ((size_t)u.pn * 256 * DFF + (size_t)u.z * KSPL) * 2; }
};
struct SchedCtxSplit {
    pg8::GridOrder o; const char* A; const char* B; size_t lda2, ldb2; int nN; unsigned ksb;
    __device__ __forceinline__ bool next(int i, pg8::Unit& u) const { int c, pn2; if (!o.next2(i, c, pn2)) return false; u.pm = c * 17; u.pn = pn2 % nN; u.z = pn2 / nN; return true; }
    __device__ __forceinline__ void ptrs(const pg8::Unit& u, const char*& a, const char*& b) const { a = A + (size_t)u.pm * 256 * lda2 + (size_t)u.z * ksb; b = B + (size_t)u.pn * 256 * ldb2 + (size_t)u.z * ksb; }
};
struct EpiCtxPart {
    unsigned char* ws;
    __device__ __forceinline__ void row(const pg8::Unit& u, int rit, int cit, const f32x4 (&a)[2][2]) const {
        const int crow = (u.pm ? CTXL : 0) + rit;
#pragma unroll
        for (int bj = 0; bj < 2; ++bj) {
            bf16_t* dst = (bf16_t*)(ws + WS_YC + ((unsigned)(u.z * (NB * CTXL) + crow) * DM + (unsigned)(u.pn * 256 + bj * 128 + cit)) * 2u);
            const float v[8] = {a[bj][0][0], a[bj][0][1], a[bj][0][2], a[bj][0][3], a[bj][1][0], a[bj][1][1], a[bj][1][2], a[bj][1][3]};
            *(u32x4*)dst = pack8(v);
        }
    }
};
struct MoeTiles { const volatile LAS int* tb; int total;
    __device__ __forceinline__ int get(int k) const { return __builtin_amdgcn_readfirstlane(tb[k]); } };
__device__ __forceinline__ int moe_expert_of(const MoeTiles& mt, int pm) { int e = 0;
#pragma unroll
    for (int k = 1; k < NE; ++k) e += (pm >= mt.get(k)) ? 1 : 0;
    return e; }
constexpr int MOE_ES = MOE_FP8 ? 1 : 2;
struct SchedMoeUp {
    pg8::GridOrder o; MoeTiles mt; const char* A; const char* B;
    __device__ __forceinline__ bool next(int i, pg8::Unit& u) const { u.z = 0; return o.next2(i, u.pm, u.pn); }
    __device__ __forceinline__ void ptrs(const pg8::Unit& u, const char*& a, const char*& b) const { const int e = moe_expert_of(mt, u.pm);
#if MOE_DIRECT
        a = A + ((size_t)e * NLAT + (size_t)(u.pm - mt.get(e)) * 256) * DM;
#else
        a = A + (size_t)u.pm * 256 * DM * MOE_ES;
#endif
        b = B + (size_t)e * SZ_WGU + (size_t)u.pn * 256 * DM * MOE_ES; }
};
struct SchedMoeDown {
    pg8::GridOrder o; MoeTiles mt; const char* A; const char* B; int nN;
    __device__ __forceinline__ bool next(int i, pg8::Unit& u) const { int pn2; if (!o.next2(i, u.pm, pn2)) return false; u.pn = pn2 % nN; u.z = pn2 / nN; return true; }
    __device__ __forceinline__ void ptrs(const pg8::Unit& u, const char*& a, const char*& b) const { const int e = moe_expert_of(mt, u.pm);
        a = A + ((size_t)u.pm * 256 * DFF + (size_t)u.z * KSPL) * MOE_ES; b = B + (size_t)e * SZ_WD + ((size_t)u.pn * 256 * DFF + (size_t)u.z * KSPL) * MOE_ES; }
};

namespace att {
constexpr int NW = 8, QBLK = 32, KVBLK = 64;
constexpr int LDQ = 3072, LDKN = 2048, LDKR = INWP, LDV = 2048;
constexpr int SHM_V = 16384, SHM_KN = 16384, SHM_KR = 8192;
constexpr int OFF_V = 0, OFF_KN = 2 * SHM_V, OFF_KR = OFF_KN + 2 * SHM_KN, OFF_WS = OFF_KR + 2 * SHM_KR, OFF_QR = OFF_WS + NW * 64 * 4, ATT_LDS = OFF_QR + NW * 4096;
constexpr float THR = 8.f;
struct Out { unsigned char* ws;
    __device__ __forceinline__ void put(int grow, int hcol, float val) const {
        const bf16_t* P = (const bf16_t*)(ws + WS_P); const bf16_t* POOLM = (const bf16_t*)(ws + WS_POOLM); bf16_t* MB = (bf16_t*)(ws + WS_MB);
        const unsigned op = ((unsigned)grow * INWP + CGATE + hcol) * 2u, om = ((unsigned)grow * 2048u + hcol) * 2u;
        const float ga = bf2f(*(const bf16_t*)((const char*)P + op)), pm = bf2f(*(const bf16_t*)((const char*)POOLM + om));
        *(bf16_t*)((char*)MB + om) = (bf16_t)f2bf(ga * val + pm);
    }
};
#if !NAIVE_ATTN
#define KSWZ(row, colB) ((row) * 256 + ((colB) ^ (((row) & 15) << 4)))
#define KRSWZ(row, ch) ((row) * 128 + ((((ch) ^ (((row) >> 1) & 7))) << 4))
#define SBAR() __builtin_amdgcn_sched_barrier(0)
__device__ __forceinline__ int crow(int r, int hi) { return (r & 3) + 8 * (r >> 2) + 4 * hi; }
__device__ __forceinline__ void partialSM(f32x16& p0, f32x16& p1, float& m_reg, float& mn, float& alpha) {
    constexpr float C = ATTN_SCALE * 1.4426950408889634f;
    float pmax = p0[0];
#pragma unroll
    for (int r = 1; r < 16; ++r) pmax = fmaxf(pmax, p0[r]);
#pragma unroll
    for (int r = 0; r < 16; ++r) pmax = fmaxf(pmax, p1[r]);
    { auto rr = __builtin_amdgcn_permlane32_swap(__float_as_uint(pmax), __float_as_uint(pmax), false, false);
      pmax = fmaxf(__uint_as_float(rr[0]), __uint_as_float(rr[1])); }
    if (__builtin_expect(__all(pmax - m_reg <= THR / ATTN_SCALE), 1)) { mn = m_reg; alpha = 1.f; }
    else { mn = fmaxf(m_reg, pmax); alpha = __builtin_amdgcn_exp2f((m_reg - mn) * C); m_reg = mn; }
    const float mnC = -mn * C;
#pragma unroll
    for (int r = 0; r < 16; ++r) p0[r] = fmaf(p0[r], C, mnC);
#pragma unroll
    for (int r = 0; r < 16; ++r) p1[r] = fmaf(p1[r], C, mnC);
#pragma unroll
    for (int r = 0; r < 16; ++r) p0[r] = __builtin_amdgcn_exp2f(p0[r]);
}
__device__ __forceinline__ void finishSM(f32x16& p0, f32x16& p1, float alpha, float& l_reg, bf16x8& pa0, bf16x8& pa1, bf16x8& pa2, bf16x8& pa3) {
#pragma unroll
    for (int r = 0; r < 16; ++r) p1[r] = __builtin_amdgcn_exp2f(p1[r]);
    float ps = 0;
#pragma unroll
    for (int r = 0; r < 16; ++r) ps += p0[r];
#pragma unroll
    for (int r = 0; r < 16; ++r) ps += p1[r];
    { auto rr = __builtin_amdgcn_permlane32_swap(__float_as_uint(ps), __float_as_uint(ps), false, false);
      ps = __uint_as_float(rr[0]) + __uint_as_float(rr[1]); }
    l_reg = l_reg * alpha + ps;
#define PK4(P_, BASE, OUT) do { unsigned a0 = cvt_pk_bf16(P_[BASE + 0], P_[BASE + 1]), a1 = cvt_pk_bf16(P_[BASE + 2], P_[BASE + 3]);   \
    unsigned b0 = cvt_pk_bf16(P_[BASE + 4], P_[BASE + 5]), b1 = cvt_pk_bf16(P_[BASE + 6], P_[BASE + 7]);                              \
    auto r0 = __builtin_amdgcn_permlane32_swap(a0, b0, false, false); auto r1 = __builtin_amdgcn_permlane32_swap(a1, b1, false, false); \
    u32x4 w = {r0[0], r1[0], r0[1], r1[1]}; OUT = *reinterpret_cast<bf16x8*>(&w); } while (0)
    PK4(p0, 0, pa0); PK4(p0, 8, pa1); PK4(p1, 0, pa2); PK4(p1, 8, pa3);
#undef PK4
}
__device__ __forceinline__ void kfrag(const char* Kn, const char* Kr, int d0, int r32, int hi, bf16x8& b0, bf16x8& b1) {
    if (d0 < 8) { const int cb = (d0 * 16 + hi * 8) * 2; b0 = *reinterpret_cast<const bf16x8*>(Kn + KSWZ(r32, cb)); b1 = *reinterpret_cast<const bf16x8*>(Kn + KSWZ(32 + r32, cb)); }
    else { const int ch = (d0 - 8) * 2 + hi; b0 = *reinterpret_cast<const bf16x8*>(Kr + KRSWZ(r32, ch)); b1 = *reinterpret_cast<const bf16x8*>(Kr + KRSWZ(32 + r32, ch)); }
}
struct NoPiece { __device__ __forceinline__ void operator()(int) const {} };
template <class PF>
__device__ __forceinline__ void qkt(f32x16& p0, f32x16& p1, const char* Kn, const char* Kr, const bf16x8* qr, int r32, int hi, const PF& piece) {
    p0 = f32x16{}; p1 = f32x16{};
    bf16x8 a0, a1, c0, c1, n0, n1;
    kfrag(Kn, Kr, 0, r32, hi, a0, a1); kfrag(Kn, Kr, 1, r32, hi, c0, c1);
#pragma unroll
    for (int d0 = 0; d0 < 12; ++d0) {
        if (d0 + 2 < 12) kfrag(Kn, Kr, d0 + 2, r32, hi, n0, n1);
        __builtin_amdgcn_sched_barrier(0);
        p0 = __builtin_amdgcn_mfma_f32_32x32x16_bf16(a0, qr[d0], p0, 0, 0, 0);
        p1 = __builtin_amdgcn_mfma_f32_32x32x16_bf16(a1, qr[d0], p1, 0, 0, 0);
        __builtin_amdgcn_sched_barrier(0);
        piece(d0);
        __builtin_amdgcn_sched_barrier(0);
        a0 = c0; a1 = c1; c0 = n0; c1 = n1;
    }
}
__device__ __forceinline__ int v_st(int k, int c) { const int kk = (k & ~0xC) | ((k & 4) << 1) | ((k & 8) >> 1); return ((kk >> 3) * 4 + (c >> 5)) * 512 + ((kk & 7) * 32 + (c & 31)) * 2; }
__device__ __forceinline__ int v_rd_base(int lane) { return ((lane & 3) << 3) | (((lane >> 2) & 3) << 6) | (((lane >> 4) & 1) << 5) | (((lane >> 5) & 1) << 8); }
constexpr int v_rd_off(int d0, int ks, int half) { return d0 * 512 + ks * 4096 + half * 2048; }
template <int OFF> __device__ __forceinline__ s16x4 tr_read(int vb) {
    s16x4 r; asm volatile("ds_read_b64_tr_b16 %0, %1 offset:%2" : "=&v"(r) : "v"(vb), "i"(OFF) : "memory"); return r;
}
template <int D0> __device__ __forceinline__ void pv_one(f32x16& od, int vb, bf16x8 pa0, bf16x8 pa1, bf16x8 pa2, bf16x8 pa3) {
    const s16x4 l0 = tr_read<v_rd_off(D0, 0, 0)>(vb), h0 = tr_read<v_rd_off(D0, 0, 1)>(vb), l1 = tr_read<v_rd_off(D0, 1, 0)>(vb), h1 = tr_read<v_rd_off(D0, 1, 1)>(vb);
    const s16x4 l2 = tr_read<v_rd_off(D0, 2, 0)>(vb), h2 = tr_read<v_rd_off(D0, 2, 1)>(vb), l3 = tr_read<v_rd_off(D0, 3, 0)>(vb), h3 = tr_read<v_rd_off(D0, 3, 1)>(vb);
    asm volatile("s_waitcnt lgkmcnt(0)" ::: "memory"); SBAR();
#define PK(L, H) (bf16x8){L[0], L[1], L[2], L[3], H[0], H[1], H[2], H[3]}
    od = __builtin_amdgcn_mfma_f32_32x32x16_bf16(pa0, PK(l0, h0), od, 0, 0, 0);
    od = __builtin_amdgcn_mfma_f32_32x32x16_bf16(pa1, PK(l1, h1), od, 0, 0, 0);
    od = __builtin_amdgcn_mfma_f32_32x32x16_bf16(pa2, PK(l2, h2), od, 0, 0, 0);
    od = __builtin_amdgcn_mfma_f32_32x32x16_bf16(pa3, PK(l3, h3), od, 0, 0, 0);
#undef PK
}
template <class PF>
__device__ __forceinline__ void pv_d0(f32x16* o, int vb, bf16x8 pa0, bf16x8 pa1, bf16x8 pa2, bf16x8 pa3, const PF& piece) {
    pv_one<0>(o[0], vb, pa0, pa1, pa2, pa3); SBAR(); piece(0); SBAR(); pv_one<1>(o[1], vb, pa0, pa1, pa2, pa3); SBAR(); piece(1); SBAR();
    pv_one<2>(o[2], vb, pa0, pa1, pa2, pa3); SBAR(); piece(2); SBAR(); pv_one<3>(o[3], vb, pa0, pa1, pa2, pa3); SBAR(); piece(3); SBAR();
}
constexpr int SLOTB = 40960, SL_V = 0, SL_KN = 16384, SL_KR = 32768, OFF_WS3 = 3 * SLOTB, ATT_LDS3 = OFF_WS3 + NW * 64 * 4;
constexpr int AC_JOBS = 18, AC_STRIPS_PER_JOB = (DM / 32) * (DFF / 32) / (8 * 32), AC_STRIPS = AC_JOBS * AC_STRIPS_PER_JOB, AC_STEPS = 32;
static_assert(AC_STRIPS_PER_JOB == 56 && AC_STRIPS <= 4 * 256 && 2 * AC_STEPS + 2 <= TPB / KVBLK - 2, "conversion strips fit the attention units' tile steps (one item per two steps)");
constexpr int AC_STG_HI = MISC_OFF + 1024;
static_assert(ATT_LDS3 + 4096 <= LDSCTL_OFF && AC_STG_HI + 7 * 4096 <= LDS_BYTES && AC_STG_HI % 16 == 0, "conversion staging blocks");
__device__ __forceinline__ void attn_unit(int qrow0, int krow0, int nkeys, int h, char* lds, LAS unsigned char* lds3, const Out& O, int wv, int ac_slot) {
    const bf16_t* __restrict__ Qg = (const bf16_t*)(O.ws + WS_Q);
    const int tid = fresh_tid(wv), wid = __builtin_amdgcn_readfirstlane(tid >> 6), lane = tid & 63, r32 = lane & 31, hi = lane >> 5;
    float* ws = (float*)(lds + OFF_WS3) + wid * 64; float* li_l = ws; float* al_l = ws + 32;
    float m_reg = -1e30f, l_reg = 0; f32x16 o[4] = {}; bf16x8 qr[12];
    { const char* Qb = (const char*)(Qg + (size_t)(qrow0 + wid * QBLK) * LDQ + h * DQK); const unsigned qo = (unsigned)(r32 * LDQ + hi * 8) * 2u;
#pragma unroll
      for (int d0 = 0; d0 < 12; ++d0) qr[d0] = *reinterpret_cast<const bf16x8*>(Qb + qo + d0 * 32); }
    unsigned vofV[1], vofK[1], vofR;
#pragma unroll
    for (int i = 0; i < 1; ++i) { const int p = (i * 8 + wid) * 1024 + lane * 16;
        { const int sub = p >> 9, kkh = sub >> 2, ch = sub & 3, within = p & 511, kkl = within >> 6, cl = (within & 63) >> 1, kk = kkh * 8 + kkl;
          const int k = (kk & ~0xC) | ((kk & 4) << 1) | ((kk & 8) >> 1), c = ch * 32 + cl; vofV[i] = (unsigned)(k * LDV + c) * 2u; }
        { const int row = p >> 8, cs = (p & 255) >> 4, c16 = cs ^ (row & 15); vofK[i] = (unsigned)(row * LDKN + c16 * 8) * 2u; } }
    { const int p = wid * 1024 + lane * 16, row = p >> 7, cs = (p & 127) >> 4, chh = cs ^ ((row >> 1) & 7); vofR = (unsigned)(row * LDKR + chh * 8) * 2u; }
    const __amdgpu_buffer_rsrc_t rs = __builtin_amdgcn_make_buffer_rsrc((void*)O.ws, 0, 0xffffffff, 0x00020000);
    const unsigned sV0 = (unsigned)(WS_V + ((size_t)krow0 * LDV + h * DV) * 2), sK0 = (unsigned)(WS_KN + ((size_t)krow0 * LDKN + h * DN) * 2), sR0 = (unsigned)(WS_P + ((size_t)krow0 * LDKR + CKR) * 2);
#define DMA(t, slot) do { const unsigned tv_ = sV0 + (unsigned)(t) * (KVBLK * LDV * 2), tk_ = sK0 + (unsigned)(t) * (KVBLK * LDKN * 2), tr_ = sR0 + (unsigned)(t) * (KVBLK * LDKR * 2); \
    _Pragma("unroll") for (int i_ = 0; i_ < 2; ++i_) __builtin_amdgcn_raw_ptr_buffer_load_lds(rs, (LAS void*)(lds3 + (slot) + SL_V + (i_ * 8 + wid) * 1024), 16, (int)vofV[0], (int)(tv_ + (unsigned)i_ * (32u * LDV * 2u)), 0, 0); \
    _Pragma("unroll") for (int i_ = 0; i_ < 2; ++i_) __builtin_amdgcn_raw_ptr_buffer_load_lds(rs, (LAS void*)(lds3 + (slot) + SL_KN + (i_ * 8 + wid) * 1024), 16, (int)vofK[0], (int)(tk_ + (unsigned)i_ * (32u * LDKN * 2u)), 0, 0); \
    __builtin_amdgcn_raw_ptr_buffer_load_lds(rs, (LAS void*)(lds3 + (slot) + SL_KR + wid * 1024), 16, (int)vofR, (int)tr_, 0, 0); } while (0)
#define LANDED() do { asm volatile("s_waitcnt vmcnt(0)" ::: "memory"); __syncthreads(); } while (0)
#define RESC(a) do { if (__any((a) < 1.f)) { if (hi == 0) al_l[r32] = (a); asm volatile("s_waitcnt lgkmcnt(0)" ::: "memory"); \
    _Pragma("unroll") for (int d = 0; d < 4; ++d) _Pragma("unroll") for (int r = 0; r < 16; ++r) o[d][r] *= al_l[crow(r, hi)]; } } while (0)
#define ROT3() do { const int t_ = s_prev; s_prev = s_cur; s_cur = s_next; s_next = t_; } while (0)
    const int vbl = (int)(uintptr_t)lds + SL_V + v_rd_base(lane);
    f32x16 pA0, pA1, pB0, pB1; float mnA, mnB, alA, alB; bf16x8 pa0, pa1, pa2, pa3; const int NT = nkeys / KVBLK;
    int s_prev = 0, s_cur = SLOTB, s_next = 2 * SLOTB;
    int ac_left = 0, ac_pend = 0, ac_N = DFF, ac_K = DM, ac_t = 0; unsigned ac_src = 0, ac_dst = 0;
    { const int sl = __builtin_amdgcn_readfirstlane(ac_slot);
      if (sl >= 0 && sl < AC_STRIPS) { const int jb = sl / AC_STRIPS_PER_JOB, r = sl - jb * AC_STRIPS_PER_JOB, e = jb / 3; ac_t = jb - e * 3;
          if (ac_t < 2) { const int kh = r / (DFF / 256), ns = r - kh * (DFF / 256), n0 = (ns * 8 + wid) * 32, k0 = kh * (AC_STEPS * 32);
              ac_src = (unsigned)e * (unsigned)(DM * DFF * 4) + ((unsigned)k0 * (unsigned)DFF + (unsigned)n0) * 4u;
              ac_dst = (unsigned)(WS_WEGU + (size_t)e * SZ_WGU) + (unsigned)((n0 >> 7) * 256 + ac_t * 128 + (n0 & 127)) * (unsigned)DM + (unsigned)k0; }
          else { const int part = r >> 3, ns = r & 7, n0 = (ns * 8 + wid) * 32, k0 = part * (AC_STEPS * 32); ac_N = DM; ac_K = DFF;
              ac_src = (unsigned)e * (unsigned)(DM * DFF * 4) + ((unsigned)k0 * (unsigned)DM + (unsigned)n0) * 4u;
              ac_dst = (unsigned)(WS_WED + (size_t)e * SZ_WD) + (unsigned)n0 * (unsigned)DFF + (unsigned)k0; }
          ac_left = AC_STEPS; } }
    const __amdgpu_buffer_rsrc_t ac_rs = __builtin_amdgcn_make_buffer_rsrc((void*)in_ptr(24 + ac_t), 0, 0xffffffff, 0x00020000);
    const int ac_stg = wid == 0 ? ATT_LDS3 : AC_STG_HI + (wid - 1) * 4096;
#define AC_PROC() do { \
        if (ac_pend) { const unsigned a0_ = (unsigned)(uintptr_t)(lds3 + ac_stg) + (unsigned)((16 * hi) * 32 + r32) * 4u, a1_ = a0_ + 1024u; f32x2 q0_, q1_, q2_, q3_, q4_, q5_, q6_, q7_; \
            asm volatile("ds_read2_b32 %0, %8 offset1:32\n\tds_read2_b32 %1, %8 offset0:64 offset1:96\n\tds_read2_b32 %2, %8 offset0:128 offset1:160\n\tds_read2_b32 %3, %8 offset0:192 offset1:224\n\t" \
                         "ds_read2_b32 %4, %9 offset1:32\n\tds_read2_b32 %5, %9 offset0:64 offset1:96\n\tds_read2_b32 %6, %9 offset0:128 offset1:160\n\tds_read2_b32 %7, %9 offset0:192 offset1:224\n\ts_waitcnt lgkmcnt(0)" \
                         : "=&v"(q0_), "=&v"(q1_), "=&v"(q2_), "=&v"(q3_), "=&v"(q4_), "=&v"(q5_), "=&v"(q6_), "=&v"(q7_) : "v"(a0_), "v"(a1_) : "memory"); \
            const float sc_ = (float)(1 << pg8::FP8_WSHIFT); q0_ *= sc_; q1_ *= sc_; q2_ *= sc_; q3_ *= sc_; q4_ *= sc_; q5_ *= sc_; q6_ *= sc_; q7_ *= sc_; \
            u32x4 w_; w_.x = cvt4_fp8(q0_.x, q0_.y, q1_.x, q1_.y); w_.y = cvt4_fp8(q2_.x, q2_.y, q3_.x, q3_.y); w_.z = cvt4_fp8(q4_.x, q4_.y, q5_.x, q5_.y); w_.w = cvt4_fp8(q6_.x, q6_.y, q7_.x, q7_.y); \
            *(u32x4*)(O.ws + (ac_dst - 32u + (unsigned)(r32 * ac_K + 16 * hi))) = w_; } \
        if (ac_pend) asm volatile("s_waitcnt lgkmcnt(0)" ::: "memory"); \
        ac_pend = 0; } while (0)
#define AC_PIECE(i_) do { const unsigned vo_ = (unsigned)((lane >> 3) * ac_N + (lane & 7) * 4) * 4u; \
        __builtin_amdgcn_raw_ptr_buffer_load_lds(ac_rs, (LAS void*)(lds3 + ac_stg + (i_) * 1024), 16, (int)vo_, (int)(ac_src + (unsigned)((i_) * 8 * 4) * (unsigned)ac_N), 0, 2); } while (0)
#define AC_ADV() do { ac_src += (unsigned)(32 * 4) * (unsigned)ac_N; ac_dst += 32u; ac_pend = 1; --ac_left; } while (0)
#define AC_STEP() do { AC_PROC(); if (ac_left) { AC_PIECE(0); AC_PIECE(1); AC_PIECE(2); AC_PIECE(3); AC_ADV(); } } while (0)
#define KVPIECE(pi_, tv_, tk_, tr_, slot_) do { \
        if ((pi_) < 2) __builtin_amdgcn_raw_ptr_buffer_load_lds(rs, (LAS void*)(lds3 + (slot_) + SL_V + ((pi_) * 8 + wid) * 1024), 16, (int)vofV[0], (int)((tv_) + (unsigned)((pi_) & 1) * (32u * LDV * 2u)), 0, 0); \
        else if ((pi_) < 4) __builtin_amdgcn_raw_ptr_buffer_load_lds(rs, (LAS void*)(lds3 + (slot_) + SL_KN + (((pi_) - 2) * 8 + wid) * 1024), 16, (int)vofK[0], (int)((tk_) + (unsigned)((pi_) & 1) * (32u * LDKN * 2u)), 0, 0); \
        else __builtin_amdgcn_raw_ptr_buffer_load_lds(rs, (LAS void*)(lds3 + (slot_) + SL_KR + wid * 1024), 16, (int)vofR, (int)(tr_), 0, 0); } while (0)
#define KVSPREAD(d0_, tq_, tv_, tk_, tr_, sn_) do { if ((tq_) >= 0) { if ((d0_) == 0) KVPIECE(0, tv_, tk_, tr_, sn_); else if ((d0_) == 3) KVPIECE(1, tv_, tk_, tr_, sn_); else if ((d0_) == 6) KVPIECE(2, tv_, tk_, tr_, sn_); \
        else if ((d0_) == 9) KVPIECE(3, tv_, tk_, tr_, sn_); else if ((d0_) == 11) KVPIECE(4, tv_, tk_, tr_, sn_); } } while (0)
    DMA(0, 0); DMA(1, SLOTB);
    LANDED();
    if (2 < NT) DMA(2, 2 * SLOTB);
    qkt(pA0, pA1, lds + SL_KN, lds + SL_KR, qr, r32, hi, NoPiece{}); partialSM(pA0, pA1, m_reg, mnA, alA);
    int pend_t = -1;
    for (int j = 1; j + 1 < NT; j += 2) {
        { const int tq = pend_t, tc = tq < 0 ? 0 : tq, sn = s_next; const unsigned tv_ = sV0 + (unsigned)tc * (KVBLK * LDV * 2), tk_ = sK0 + (unsigned)tc * (KVBLK * LDKN * 2), tr_ = sR0 + (unsigned)tc * (KVBLK * LDKR * 2);
          SBAR(); qkt(pB0, pB1, lds + s_cur + SL_KN, lds + s_cur + SL_KR, qr, r32, hi, [&](int d0) { KVSPREAD(d0, tq, tv_, tk_, tr_, sn); }); }
        finishSM(pA0, pA1, alA, l_reg, pa0, pa1, pa2, pa3); SBAR();
        pv_d0(o, vbl + s_prev, pa0, pa1, pa2, pa3, NoPiece{}); partialSM(pB0, pB1, m_reg, mnB, alB);
        RESC(alB);
        LANDED();
        AC_PROC();
        ROT3();
        { const int tq = j + 2 < NT ? j + 2 : -1, tc = tq < 0 ? 0 : tq, sn = s_next; const unsigned tv_ = sV0 + (unsigned)tc * (KVBLK * LDV * 2), tk_ = sK0 + (unsigned)tc * (KVBLK * LDKN * 2), tr_ = sR0 + (unsigned)tc * (KVBLK * LDKR * 2);
          SBAR(); qkt(pA0, pA1, lds + s_cur + SL_KN, lds + s_cur + SL_KR, qr, r32, hi, [&](int d0) { KVSPREAD(d0, tq, tv_, tk_, tr_, sn); }); }
        finishSM(pB0, pB1, alB, l_reg, pa0, pa1, pa2, pa3); SBAR();
        pv_d0(o, vbl + s_prev, pa0, pa1, pa2, pa3, NoPiece{});
        partialSM(pA0, pA1, m_reg, mnA, alA);
        RESC(alA);
        if (ac_left) { AC_PIECE(0); AC_PIECE(1); AC_PIECE(2); AC_PIECE(3); AC_ADV(); }
        if (ac_pend) asm volatile("s_waitcnt vmcnt(4)\n\ts_waitcnt lgkmcnt(0)" ::: "memory"); else asm volatile("s_waitcnt vmcnt(0)\n\ts_waitcnt lgkmcnt(0)" ::: "memory");
        __builtin_amdgcn_s_barrier(); asm volatile("" ::: "memory");
        ROT3();
        pend_t = j + 3 < NT ? j + 3 : -1;
    }
    SBAR(); qkt(pB0, pB1, lds + s_cur + SL_KN, lds + s_cur + SL_KR, qr, r32, hi, NoPiece{});
    finishSM(pA0, pA1, alA, l_reg, pa0, pa1, pa2, pa3); SBAR();
    pv_d0(o, vbl + s_prev, pa0, pa1, pa2, pa3, NoPiece{}); partialSM(pB0, pB1, m_reg, mnB, alB);
    RESC(alB);
    finishSM(pB0, pB1, alB, l_reg, pa0, pa1, pa2, pa3); SBAR();
    pv_d0(o, vbl + s_cur, pa0, pa1, pa2, pa3, NoPiece{});
    while (ac_pend) { asm volatile("s_waitcnt vmcnt(0)" ::: "memory"); AC_STEP(); }
    if (hi == 0) li_l[r32] = l_reg; asm volatile("s_waitcnt lgkmcnt(0)" ::: "memory");
    float rli[16];
#pragma unroll
    for (int r = 0; r < 16; ++r) rli[r] = __builtin_amdgcn_rcpf(li_l[crow(r, hi)]);
    __syncthreads();
    { LAS float* so = (LAS float*)lds3 + wid * 4096;
#pragma unroll
      for (int r = 0; r < 16; ++r)
#pragma unroll
          for (int d0 = 0; d0 < 4; ++d0) so[crow(r, hi) * 128 + d0 * 32 + r32] = o[d0][r] * rli[r];
      asm volatile("s_waitcnt lgkmcnt(0)" ::: "memory");
      int ln_; asm volatile("v_mbcnt_lo_u32_b32 %0, -1, 0\n\tv_mbcnt_hi_u32_b32 %0, -1, %0" : "=v"(ln_));
      const int rr = ln_ >> 4, c8 = (ln_ & 15) * 8;
      const unsigned og = ((unsigned)(qrow0 + wid * QBLK + rr) * INWP + CGATE + h * DV + c8) * 2u, om = ((unsigned)(qrow0 + wid * QBLK + rr) * 2048u + h * DV + c8) * 2u;
      const char* Pb = (const char*)(O.ws + WS_P); const char* PMb = (const char*)(O.ws + WS_POOLM); char* MBb = (char*)(O.ws + WS_MB);
#pragma unroll
      for (int hb = 0; hb < 8; hb += 4) {
      u32x4 g[4], pm[4];
#pragma unroll
      for (int q = 0; q < 4; ++q) { const int it = hb + q; g[q] = *(const u32x4*)(Pb + og + (unsigned)it * (4u * INWP * 2u)); pm[q] = *(const u32x4*)(PMb + om + (unsigned)it * (4u * 2048u * 2u)); }
      asm volatile("" ::: "memory");
#pragma unroll
      for (int q = 0; q < 4; ++q) { const int it = hb + q; const LAS float* sp = so + (it * 4 + rr) * 128 + c8; const f32x4 v0 = *(const LAS f32x4*)sp, v1 = *(const LAS f32x4*)(sp + 4);
          float gf[8], pf[8], ov[8]; unpack8(g[q], gf); unpack8(pm[q], pf);
          ov[0] = gf[0] * v0[0] + pf[0]; ov[1] = gf[1] * v0[1] + pf[1]; ov[2] = gf[2] * v0[2] + pf[2]; ov[3] = gf[3] * v0[3] + pf[3];
          ov[4] = gf[4] * v1[0] + pf[4]; ov[5] = gf[5] * v1[1] + pf[5]; ov[6] = gf[6] * v1[2] + pf[6]; ov[7] = gf[7] * v1[3] + pf[7];
          *(u32x4*)(MBb + om + (unsigned)it * (4u * 2048u * 2u)) = pack8(ov); }
      asm volatile("" ::: "memory"); } }
    __syncthreads();
#undef DMA
#undef LANDED
#undef RESC
#undef ROT3
#undef AC_STEP
#undef AC_PROC
#undef AC_PIECE
#undef AC_ADV
#undef KVPIECE
#undef KVSPREAD
}
#undef SBAR
#else
__device__ __forceinline__ void attn_naive_item(const bf16_t* Qg, const bf16_t* KNg, const bf16_t* Pg, const bf16_t* Vg, int grow, int krow0, int nkeys, int h,
                                                LAS float* sc, LAS float* qs, int lane, const Out& O) {
#pragma unroll
    for (int i = 0; i < 3; ++i) qs[lane + 64 * i] = bf2f(Qg[(size_t)grow * LDQ + h * DQK + lane + 64 * i]);
    asm volatile("s_waitcnt lgkmcnt(0)" ::: "memory");
    float mx = -1e30f;
    for (int k = lane; k < nkeys; k += 64) {
        const bf16_t* kn = KNg + (size_t)(krow0 + k) * LDKN + h * DN; const bf16_t* kr = Pg + (size_t)(krow0 + k) * LDKR + CKR;
        float s = 0.f;
        for (int c = 0; c < 16; ++c) { float kv[8]; unpack8(*(const u32x4*)(kn + c * 8), kv);
#pragma unroll
            for (int j = 0; j < 8; ++j) s += kv[j] * qs[c * 8 + j]; }
        for (int c = 0; c < 8; ++c) { float kv[8]; unpack8(*(const u32x4*)(kr + c * 8), kv);
#pragma unroll
            for (int j = 0; j < 8; ++j) s += kv[j] * qs[128 + c * 8 + j]; }
        s *= ATTN_SCALE; sc[k] = s; mx = fmaxf(mx, s);
    }
    mx = wave_max(mx);
    float sum = 0.f;
    for (int k = lane; k < nkeys; k += 64) { const float p = fast_exp(sc[k] - mx); sc[k] = p; sum += p; }
    sum = wave_sum(sum);
    asm volatile("s_waitcnt lgkmcnt(0)" ::: "memory");
    float o0 = 0.f, o1 = 0.f;
    for (int k = 0; k < nkeys; ++k) { const float p = sc[k]; const bf16_t* v = Vg + (size_t)(krow0 + k) * LDV + h * DV;
        o0 += p * bf2f(v[lane]); o1 += p * bf2f(v[lane + 64]); }
    const float inv = 1.f / sum;
    O.put(grow, h * DV + lane, o0 * inv); O.put(grow, h * DV + lane + 64, o1 * inv);
    asm volatile("s_waitcnt lgkmcnt(0)" ::: "memory");
}
#endif
}

__device__ __forceinline__ void ld_row_f32(const float* p, f32x4 (&v)[8], int lane) {
#pragma unroll
    for (int j = 0; j < 8; ++j) v[j] = *(const f32x4*)(p + 4 * lane + 256 * j);
}
__device__ __forceinline__ void st_row_f32(float* p, const f32x4 (&v)[8], int lane) {
#pragma unroll
    for (int j = 0; j < 8; ++j) *(f32x4*)(p + 4 * lane + 256 * j) = v[j];
}
__device__ __forceinline__ void ld_row_bf16(const bf16_t* p, f32x4 (&v)[8], int lane) {
#pragma unroll
    for (int j = 0; j < 8; ++j) { const u32x2 w = *(const u32x2*)(p + 4 * lane + 256 * j);
        v[j] = (f32x4){__uint_as_float(w.x << 16), __uint_as_float(w.x & 0xffff0000u), __uint_as_float(w.y << 16), __uint_as_float(w.y & 0xffff0000u)}; }
}
__device__ __forceinline__ void st_row_bf16(bf16_t* p, const f32x4 (&v)[8], int lane) {
#pragma unroll
    for (int j = 0; j < 8; ++j) { u32x2 w; w.x = cvt_pk_bf16(v[j][0], v[j][1]); w.y = cvt_pk_bf16(v[j][2], v[j][3]); *(u32x2*)(p + 4 * lane + 256 * j) = w; }
}
__device__ __forceinline__ float row_rstd(const f32x4 (&v)[8]) {
    float s = 0.f;
#pragma unroll
    for (int j = 0; j < 8; ++j) s += (v[j][0] * v[j][0] + v[j][1] * v[j][1]) + (v[j][2] * v[j][2] + v[j][3] * v[j][3]);
    s = wave_sum(s);
    return 1.0f / sqrtf(s * (1.0f / DM) + EPS);
}
__device__ __forceinline__ void norm_mod(const f32x4 (&x)[8], f32x4 (&o)[8], const float* gain, const float* shift, const float* scale, int lane) {
    const float rs = row_rstd(x);
#pragma unroll
    for (int j = 0; j < 8; ++j) { const int c = 4 * lane + 256 * j; const f32x4 g = *(const f32x4*)(gain + c), sh = *(const f32x4*)(shift + c), sc = *(const f32x4*)(scale + c);
        o[j] = x[j] * rs * g * (sc + 1.0f) + sh; }
}

#define LV_A(F) ((LAS float*)(F).lds)
#define LV_B(F) ((LAS float*)(F).lds + 3 * DM)
#define LV_C(F) ((LAS float*)(F).lds + 6 * DM)
#define LV_G1(F) ((LAS float*)(F).lds + 9 * DM)
#define LV_G2(F) ((LAS float*)(F).lds + 10 * DM)
__device__ __forceinline__ void stage3(LAS float* dst, const float* src, int tid) {
#pragma unroll
    for (int mi = 0; mi < 3; ++mi) *(LAS f32x4*)(dst + mi * DM + 4 * tid) = *(const f32x4*)(src + (size_t)mi * 6 * DM + 4 * tid);
}
__device__ __forceinline__ void stage1(LAS float* dst, const float* src, int tid) { *(LAS f32x4*)(dst + 4 * tid) = *(const f32x4*)(src + 4 * tid); }
__device__ __forceinline__ void norm_mod_l(const f32x4 (&x)[8], f32x4 (&o)[8], const LAS float* gain, const LAS float* shift, const LAS float* scale, int lane) {
    const float rs = row_rstd(x);
#pragma unroll
    for (int j = 0; j < 8; ++j) { const int c = 4 * lane + 256 * j; const f32x4 g = *(const LAS f32x4*)(gain + c), sh = *(const LAS f32x4*)(shift + c), sc = *(const LAS f32x4*)(scale + c);
        o[j] = x[j] * rs * g * (sc + 1.0f) + sh; }
}
__device__ __forceinline__ void st_row_i8(const Frame& F, int row, const f32x4 (&o)[8], int lane) {
    float mx = 0.f;
#pragma unroll
    for (int j = 0; j < 8; ++j) mx = fmaxf(fmaxf(mx, fmaxf(fabsf(o[j][0]), fabsf(o[j][1]))), fmaxf(fabsf(o[j][2]), fabsf(o[j][3])));
    mx = fmaxf(wave_max(mx), 1e-20f); const float inv = 127.0f / mx;
    unsigned char* h8 = F.ws + WS_H + (size_t)row * DM;
#pragma unroll
    for (int j = 0; j < 8; ++j) { const int q0 = (int)rintf(o[j][0] * inv), q1 = (int)rintf(o[j][1] * inv), q2 = (int)rintf(o[j][2] * inv), q3 = (int)rintf(o[j][3] * inv);
        *(unsigned*)(h8 + 4 * lane + 256 * j) = (unsigned)(q0 & 255) | ((unsigned)(q1 & 255) << 8) | ((unsigned)(q2 & 255) << 16) | ((unsigned)(q3 & 255) << 24); }
    if (lane == 0) ((float*)(F.ws + WS_HSC))[row] = mx * (1.0f / 127.0f);
}
__device__ __forceinline__ void phase_norm1_l0(const Frame& F) {
    PHASE_IDS(); const int gw = F.vcu * 8 + wave, NGW = F.G * 8;
    float* XRES = (float*)(F.ws + WS_XRES); bf16_t* H = (bf16_t*)(F.ws + WS_H);
    __syncthreads();
    stage3(LV_B(F), modp(F, 0, 0, 0), tid); stage3(LV_C(F), modp(F, 0, 0, 1), tid); stage1(LV_G1(F), in_ptr(6), tid);
    __syncthreads();
    for (int row = gw; row < R; row += NGW) {
        const int b = row / TPB, t = row % TPB;
        const float* src = t < CTXL ? in_ptr(2) + ((size_t)b * CTXL + t) * DM : in_ptr(0) + ((size_t)b * SEQ + (t - CTXL)) * DM;
        f32x4 x[8], o[8]; ld_row_f32(src, x, lane);
        const int mi = t < CTXL ? 2 : b;
        norm_mod_l(x, o, LV_G1(F), LV_B(F) + mi * DM, LV_C(F) + mi * DM, lane);
#if WIN_I8
        st_row_i8(F, row, o, lane);
#else
        st_row_bf16(H + (size_t)row * DM, o, lane);
#endif
    }
}
struct T2Row { u32x4 qv, kvv, wv[15], sv[4]; };
__device__ __forceinline__ void t2_load(const bf16_t* P, int row, int lane, T2Row& d) {
    const bf16_t* pr = P + (size_t)row * INWP; const int hv = lane >> 5, l32 = lane & 31;
    const int b = row / TPB, t = row % TPB, segrow0 = t < CTXL ? b * TPB : b * TPB + CTXL, L = t < CTXL ? CTXL : SEQ, tt = t < CTXL ? t : t - CTXL;
    d.qv = *(const u32x4*)(pr + CQ + 8 * lane); d.kvv = *(const u32x4*)(pr + CKV + 8 * lane);
#pragma unroll
    for (int gi = 0; gi < 4; ++gi) { const int w = 2 << gi, col = CPOOL + gi * 256 + 8 * l32;
#pragma unroll
        for (int q = 0; q < w / 2; ++q) { const int rr = tt - w / 2 + 2 * q + hv; const int rc = rr < 0 ? 0 : (rr >= L ? L - 1 : rr);
            d.wv[(w / 2 - 1) + q] = *(const u32x4*)(P + (size_t)(segrow0 + rc) * INWP + col); }
        d.sv[gi] = *(const u32x4*)(pr + col); }
}
__device__ __forceinline__ void t2_compute(const Frame& F, int row, int lane, const T2Row& d, const LAS float* GQ, const LAS float* GKV) {
    bf16_t* QLN = (bf16_t*)(F.ws + WS_QLN); bf16_t* KVLN = (bf16_t*)(F.ws + WS_KVLN); bf16_t* PL = (bf16_t*)(F.ws + WS_PL);
    const int hv = lane >> 5, l32 = lane & 31;
    const int t = row % TPB, L = t < CTXL ? CTXL : SEQ, tt = t < CTXL ? t : t - CTXL;
#pragma unroll
    for (int w = 0; w < 2; ++w) {
        float v[8]; unpack8(w == 0 ? d.qv : d.kvv, v);
        float s = 0.f;
#pragma unroll
        for (int j = 0; j < 8; ++j) s += v[j] * v[j];
        s = wave_sum(s); const float rs = 1.0f / sqrtf(s * (1.0f / 512.f) + EPS);
        const LAS float* g = (w == 0 ? GQ : GKV) + 8 * lane; const f32x4 g0 = *(const LAS f32x4*)g, g1 = *(const LAS f32x4*)(g + 4);
        v[0] *= rs * g0[0]; v[1] *= rs * g0[1]; v[2] *= rs * g0[2]; v[3] *= rs * g0[3]; v[4] *= rs * g1[0]; v[5] *= rs * g1[1]; v[6] *= rs * g1[2]; v[7] *= rs * g1[3];
        *(u32x4*)((w == 0 ? QLN : KVLN) + (size_t)row * 512 + 8 * lane) = pack8(v);
    }
#pragma unroll
    for (int gi = 0; gi < 4; ++gi) {
        const int w = 2 << gi; int lo = tt - w / 2, hi = tt - w / 2 + w; lo = lo < 0 ? 0 : lo; hi = hi > L ? L : hi;
        float a[8];
#pragma unroll
        for (int i = 0; i < 8; ++i) a[i] = 0.f;
#pragma unroll
        for (int q = 0; q < w / 2; ++q) { const int rr = tt - w / 2 + 2 * q + hv; const bool ok = rr >= 0 && rr < L;
            float v[8]; unpack8(d.wv[(w / 2 - 1) + q], v); const float m = ok ? 1.f : 0.f;
#pragma unroll
            for (int i = 0; i < 8; ++i) a[i] += m * v[i]; }
#pragma unroll
        for (int i = 0; i < 8; ++i) { auto sw = __builtin_amdgcn_permlane32_swap(__float_as_uint(a[i]), __float_as_uint(a[i]), false, false); a[i] = __uint_as_float(sw[0]) + __uint_as_float(sw[1]); }
        const float ic = 1.0f / (float)(hi - lo);
        float s8[8]; unpack8(d.sv[gi], s8);
#pragma unroll
        for (int i = 0; i < 8; ++i) a[i] = a[i] * ic - s8[i];
        if (hv == 0) *(u32x4*)(PL + (size_t)row * POOLW + gi * 256 + 8 * l32) = pack8(a);
    }
}
__device__ __forceinline__ void phase_thin2(const Frame& F, int l) {
    PHASE_IDS(); const int gw = F.vcu * 8 + wave, NGW = F.G * 8;
    const bf16_t* P = (const bf16_t*)(F.ws + WS_P);
    LAS float* const GQ = (LAS float*)F.lds; LAS float* const GKV = GQ + QL;
    if (tid < 128) *(LAS f32x4*)(GQ + 4 * tid) = *(const f32x4*)(in_ptr(12) + l * QL + 4 * tid); else if (tid < 256) *(LAS f32x4*)(GKV + 4 * (tid - 128)) = *(const f32x4*)(in_ptr(13) + l * KVL + 4 * (tid - 128));
    __syncthreads();
    for (int row = gw; row < R; row += 2 * NGW) { const int r2 = row + NGW; const bool h2 = r2 < R;
        T2Row A, B; t2_load(P, row, lane, A); t2_load(P, h2 ? r2 : row, lane, B);
        asm volatile("" ::: "memory");
        t2_compute(F, row, lane, A, GQ, GKV);
        if (h2) t2_compute(F, r2, lane, B, GQ, GKV);
    }
}
#ifndef MOD_DEFER
#define MOD_DEFER 1
#endif
__device__ __forceinline__ void mod_partial_item(const Frame& F, int it, int lane) {
    float* MODP = (float*)(F.ws + WS_MODP); const float* cvec = in_ptr(1); const float* cctx = in_ptr(3);
    const int l = it / (16 * 48), kc = (it / 48) % 16, cb = it % 48, n0 = cb * 256 + 4 * lane;
    const GAS float* W = (const GAS float*)in_ptr(4) + (size_t)l * DM * 12288 + (size_t)(kc * 128) * 12288 + n0;
    f32x4 a0 = {0.f, 0.f, 0.f, 0.f}, a1 = a0, a2 = a0;
#pragma unroll 16
    for (int k = 0; k < 128; ++k) { const int kk = kc * 128 + k; const f32x4 w = *(const GAS f32x4*)(W + (size_t)k * 12288);
        const float c0 = cvec[kk], c1 = cvec[DM + kk], c2 = cctx[kk];
        a0 += w * (c0 * sigmoidf_(c0)); a1 += w * (c1 * sigmoidf_(c1)); a2 += w * (c2 * sigmoidf_(c2)); }
    float* o = MODP + (((size_t)kc * 2 + l) * 3) * 12288 + n0;
    *(f32x4*)(o) = a0; *(f32x4*)(o + 12288) = a1; *(f32x4*)(o + 2 * 12288) = a2;
}
__device__ __forceinline__ void mod_reduce_layer(const Frame& F, int l, int tid) {
    const float* MODP = (const float*)(F.ws + WS_MODP); float* MOD = (float*)(F.ws + WS_MOD); const float* bmod = in_ptr(5);
    for (int j = F.vcu * 512 + tid; j < 3 * 12288; j += F.G * 512) { const int i = l * 3 * 12288 + j, n = j % 12288;
        float s = bmod[l * 12288 + n];
        for (int kc = 0; kc < 16; ++kc) s += MODP[(size_t)kc * (2 * 3 * 12288) + i];
        MOD[i] = s; }
}
__device__ __forceinline__ void phase_thin3_dense(const Frame& F, int l) {
    PHASE_IDS();
    const int gw = F.vcu * 8 + wave, NGW = F.G * 8;
    if (MOD_DEFER && F.G == 256) mod_reduce_layer(F, 1, tid);
    float* XRES = (float*)(F.ws + WS_XRES); bf16_t* H = (bf16_t*)(F.ws + WS_H); const bf16_t* Y = (const bf16_t*)(F.ws + WS_Y);
    stage3(LV_A(F), modp(F, l, 0, 2), tid); stage3(LV_B(F), modp(F, l, 0, 3), tid); stage3(LV_C(F), modp(F, l, 0, 4), tid); stage1(LV_G1(F), in_ptr(7) + l * DM, tid); stage1(LV_G2(F), in_ptr(8) + l * DM, tid);
    __syncthreads();
    const int nlr = (NLAT + NGW - 1) / NGW;
    for (int it = 0; ; ++it) { int row;
        if (it < nlr) { const int lat = it * NGW + gw; if (lat >= NLAT) continue; row = (lat / SEQ) * TPB + CTXL + lat % SEQ; }
        else { const int c = (it - nlr) * NGW + wave * F.G + F.vcu; if (c >= NB * CTXL) break; row = (c / CTXL) * TPB + c % CTXL; }
        const int mi = row_modidx(row);
        f32x4 y[8], x[8], o[8];
        if (row % TPB < CTXL) { const bf16_t* yc = (const bf16_t*)(F.ws + WS_YC) + (size_t)((row / TPB) * CTXL + row % TPB) * DM;
            ld_row_bf16(yc, y, lane);
            for (int z = 1; z < ZS_G3; ++z) { f32x4 t[8]; ld_row_bf16(yc + (size_t)z * (NB * CTXL) * DM, t, lane);
#pragma unroll
                for (int j = 0; j < 8; ++j) y[j] = y[j] + t[j]; } }
        else ld_row_bf16(Y + (size_t)row * DM, y, lane);
        { const int b_ = row / TPB, t_ = row % TPB;
          const float* src = t_ < CTXL ? in_ptr(2) + ((size_t)b_ * CTXL + t_) * DM : in_ptr(0) + ((size_t)b_ * SEQ + (t_ - CTXL)) * DM;
          ld_row_f32(src, x, lane); }
        const float rs = row_rstd(y); const LAS float* gp = LV_G1(F); const LAS float* g1 = LV_A(F) + mi * DM;
#pragma unroll
        for (int j = 0; j < 8; ++j) { const int c = 4 * lane + 256 * j; x[j] = x[j] + *(const LAS f32x4*)(g1 + c) * (y[j] * rs * *(const LAS f32x4*)(gp + c)); }
        st_row_f32(XRES + (size_t)row * DM, x, lane);
        norm_mod_l(x, o, LV_G2(F), LV_B(F) + mi * DM, LV_C(F) + mi * DM, lane);
#if DENSE_I8
        st_row_i8(F, row, o, lane);
#else
        st_row_bf16(H + (size_t)row * DM, o, lane);
#endif
    }
}
__device__ __forceinline__ void phase_thin3_moe(const Frame& F, int l) {
    PHASE_IDS(); const int gw = F.vcu * 8 + wave, NGW = F.G * 8;
    float* XRES = (float*)(F.ws + WS_XRES); const bf16_t* Y = (const bf16_t*)(F.ws + WS_Y);
    unsigned* TOK = (unsigned*)(F.ws + WS_TOK);
    const float* wr = in_ptr(22); const float* br = in_ptr(23);
    __syncthreads();
    LAS float* const VA = (LAS float*)F.lds; LAS float* const VB = VA + 2 * DM; LAS float* const VC = VA + 4 * DM; LAS float* const VG1 = VA + 6 * DM; LAS float* const VG2 = VA + 7 * DM; LAS float* const WE = VA + 8 * DM;
#pragma unroll
    for (int m2 = 0; m2 < 2; ++m2) { stage1(VA + m2 * DM, modp(F, l, m2, 2), tid); stage1(VB + m2 * DM, modp(F, l, m2, 3), tid); stage1(VC + m2 * DM, modp(F, l, m2, 4), tid); }
    stage1(VG1, in_ptr(7) + l * DM, tid); stage1(VG2, in_ptr(8) + l * DM, tid);
#pragma unroll
    for (int i = 0; i < 8; ++i) { const int c = i * 512 + tid, k = c >> 1, e0 = (c & 1) * 4; const f32x4 v = *(const f32x4*)(wr + (size_t)c * 4);
        WE[(e0 + 0) * DM + k] = v[0]; WE[(e0 + 1) * DM + k] = v[1]; WE[(e0 + 2) * DM + k] = v[2]; WE[(e0 + 3) * DM + k] = v[3]; }
    __syncthreads();
    for (int tok = gw; tok < NLAT; tok += NGW) {
        const int b = tok / SEQ, s = tok % SEQ, row = b * TPB + CTXL + s, mi = b;
        f32x4 y[8], x[8], o[8]; ld_row_bf16(Y + (size_t)row * DM, y, lane); ld_row_f32(XRES + (size_t)row * DM, x, lane);
        const float rs = row_rstd(y); const LAS float* gp = VG1; const LAS float* g1 = VA + mi * DM;
#pragma unroll
        for (int j = 0; j < 8; ++j) { const int c = 4 * lane + 256 * j; x[j] = x[j] + *(const LAS f32x4*)(g1 + c) * (y[j] * rs * *(const LAS f32x4*)(gp + c)); }
        st_row_f32(XRES + (size_t)row * DM, x, lane);
        norm_mod_l(x, o, VG2, VB + mi * DM, VC + mi * DM, lane);
        float lg[8];
#pragma unroll
        for (int e = 0; e < 8; ++e) lg[e] = 0.f;
#pragma unroll
        for (int j = 0; j < 8; ++j) {
#pragma unroll
            for (int e = 0; e < 8; ++e) { const f32x4 w = *(const LAS f32x4*)(WE + e * DM + 4 * lane + 256 * j);
                lg[e] += (o[j][0] * w[0] + o[j][1] * w[1]) + (o[j][2] * w[2] + o[j][3] * w[3]); }
            asm volatile("" ::: "memory"); }
#pragma unroll
        for (int e = 0; e < 8; ++e) lg[e] = wave_sum(lg[e]) + br[e];
        int e1 = 0; float m1 = lg[0];
#pragma unroll
        for (int e = 1; e < 8; ++e) if (lg[e] > m1) { m1 = lg[e]; e1 = e; }
        int e2 = -1; float m2 = -3.0e38f;
#pragma unroll
        for (int e = 0; e < 8; ++e) if (e != e1 && lg[e] > m2) { m2 = lg[e]; e2 = e; }
        const float p2 = fast_exp(m2 - m1), w1n = 1.0f / (1.0f + p2), w2n = p2 / (1.0f + p2);
        unsigned r1 = 0u, r2 = 0u;
        if (lane == 0) {
            r1 = __hip_atomic_fetch_add(F.ctl + CW_CNT + 64 * e1, 1u, RLX_AGENT);
            r2 = __hip_atomic_fetch_add(F.ctl + CW_CNT + 64 * e2, 1u, RLX_AGENT);
            u32x4 a; a.x = (unsigned)e1; a.y = r1; a.z = __float_as_uint(w1n); a.w = (unsigned)e2; u32x4 c2; c2.x = r2; c2.y = __float_as_uint(w2n); c2.z = 0u; c2.w = 0u;
            *(u32x4*)(TOK + (size_t)tok * 8) = a; *(u32x4*)(TOK + (size_t)tok * 8 + 4) = c2;
        }
#if MOE_DIRECT
        { r1 = (unsigned)__builtin_amdgcn_readfirstlane((int)r1); r2 = (unsigned)__builtin_amdgcn_readfirstlane((int)r2);
          const int e1u = __builtin_amdgcn_readfirstlane(e1), e2u = __builtin_amdgcn_readfirstlane(e2);
          unsigned char* h1 = F.ws + WS_HS2 + ((size_t)e1u * NLAT + r1) * DM; unsigned char* h2 = F.ws + WS_HS2 + ((size_t)e2u * NLAT + r2) * DM;
#pragma unroll
          for (int j = 0; j < 8; ++j) { const unsigned w = cvt4_fp8(o[j][0], o[j][1], o[j][2], o[j][3]); *(unsigned*)(h1 + 4 * lane + 256 * j) = w; *(unsigned*)(h2 + 4 * lane + 256 * j) = w; } }
#endif
    }
}
__device__ __forceinline__ MoeTiles moe_tiles(const Frame& F) {
    volatile LAS int* tbl = (volatile LAS int*)(F.lds + MISC_OFF + 64);
    __syncthreads();
    if (threadIdx.x == 0) { int acc = 0;
        for (int e = 0; e < NE; ++e) { tbl[e] = acc; const unsigned c = __hip_atomic_load(F.ctl + CW_CNT + 64 * e, RLX_AGENT); acc += (int)((c + 255u) >> 8); }
        tbl[NE] = acc; }
    __syncthreads();
    MoeTiles mt; mt.tb = tbl; mt.total = __builtin_amdgcn_readfirstlane(tbl[NE]); return mt;
}
__device__ __forceinline__ void phase_moe_scatter(const Frame& F, int l, const MoeTiles& mt) {
    PHASE_IDS(); const int gw = F.vcu * 8 + wave, NGW = F.G * 8;
    const float* XRES = (const float*)(F.ws + WS_XRES); bf16_t* HS = (bf16_t*)(F.ws + WS_HS);
    const unsigned* TOK = (const unsigned*)(F.ws + WS_TOK);
    for (int tok = gw; tok < NLAT; tok += NGW) {
        const int b = tok / SEQ, s = tok % SEQ, row = b * TPB + CTXL + s, mi = b;
        f32x4 x[8], o[8]; ld_row_f32(XRES + (size_t)row * DM, x, lane);
        norm_mod(x, o, in_ptr(8) + l * DM, modp(F, l, mi, 3), modp(F, l, mi, 4), lane);
        const u32x4 a = *(const u32x4*)(TOK + (size_t)tok * 8); const u32x4 c2 = *(const u32x4*)(TOK + (size_t)tok * 8 + 4);
        int base1 = 0, base2 = 0;
        base1 = mt.tb[(int)a.x]; base2 = mt.tb[(int)a.w];
        const int s1 = base1 * 256 + (int)a.y, s2 = base2 * 256 + (int)c2.x;
#if MOE_FP8
        { unsigned char* h1 = (unsigned char*)HS + (size_t)s1 * DM; unsigned char* h2 = (unsigned char*)HS + (size_t)s2 * DM;
#pragma unroll
          for (int j = 0; j < 8; ++j) { const unsigned w = cvt4_fp8(o[j][0], o[j][1], o[j][2], o[j][3]); *(unsigned*)(h1 + 4 * lane + 256 * j) = w; *(unsigned*)(h2 + 4 * lane + 256 * j) = w; } }
#else
        st_row_bf16(HS + (size_t)s1 * DM, o, lane); st_row_bf16(HS + (size_t)s2 * DM, o, lane);
#endif
    }
}
__device__ __forceinline__ void phase_thin4_dense(const Frame& F, int l) {
    PHASE_IDS(); const int gw = F.vcu * 8 + wave, NGW = F.G * 8;
    float* XRES = (float*)(F.ws + WS_XRES); bf16_t* H = (bf16_t*)(F.ws + WS_H); const float* Y2 = (const float*)(F.ws + WS_Y2);
    stage3(LV_A(F), modp(F, l, 0, 5), tid); stage3(LV_B(F), modp(F, l + 1, 0, 0), tid); stage3(LV_C(F), modp(F, l + 1, 0, 1), tid); stage1(LV_G1(F), in_ptr(9) + l * DM, tid); stage1(LV_G2(F), in_ptr(6) + (l + 1) * DM, tid);
    __syncthreads();
    const int nlr = (NLAT + NGW - 1) / NGW;
    for (int it = 0; ; ++it) { int row;
        if (it < nlr) { const int lat = it * NGW + gw; if (lat >= NLAT) continue; row = (lat / SEQ) * TPB + CTXL + lat % SEQ; }
        else { const int c = (it - nlr) * NGW + wave * F.G + F.vcu; if (c >= NB * CTXL) break; row = (c / CTXL) * TPB + c % CTXL; }
        const int mi = row_modidx(row);
        f32x4 y[8], x[8], o[8];
        if (row % TPB < CTXL) { const bf16_t* yc = (const bf16_t*)(F.ws + WS_YC) + (size_t)((row / TPB) * CTXL + row % TPB) * DM;
            ld_row_bf16(yc, y, lane);
            for (int z = 1; z < ZS_G5; ++z) { f32x4 t[8]; ld_row_bf16(yc + (size_t)z * (NB * CTXL) * DM, t, lane);
#pragma unroll
                for (int j = 0; j < 8; ++j) y[j] = y[j] + t[j]; } }
        else ld_row_bf16((const bf16_t*)Y2 + (size_t)row * DM, y, lane);
        ld_row_f32(XRES + (size_t)row * DM, x, lane);
        const float rs = row_rstd(y); const LAS float* gp = LV_G1(F); const LAS float* g2 = LV_A(F) + mi * DM;
#pragma unroll
        for (int j = 0; j < 8; ++j) { const int c = 4 * lane + 256 * j; x[j] = x[j] + *(const LAS f32x4*)(g2 + c) * (y[j] * rs * *(const LAS f32x4*)(gp + c)); }
        st_row_f32(XRES + (size_t)row * DM, x, lane);
        norm_mod_l(x, o, LV_G2(F), LV_B(F) + mi * DM, LV_C(F) + mi * DM, lane);
#if WIN_I8
        st_row_i8(F, row, o, lane);
#else
        st_row_bf16(H + (size_t)row * DM, o, lane);
#endif
    }
}
__device__ __forceinline__ void phase_final_moe(const Frame& F, int l, const MoeTiles& mt) {
    PHASE_IDS(); const int gw = F.vcu * 8 + wave, NGW = F.G * 8;
    const float* XRES = (const float*)(F.ws + WS_XRES); const float* Y2 = (const float*)(F.ws + WS_Y2);
    const unsigned* TOK = (const unsigned*)(F.ws + WS_TOK);
    for (int tok = gw; tok < NLAT; tok += NGW) {
        const int b = tok / SEQ, s = tok % SEQ, row = b * TPB + CTXL + s, mi = b;
        const u32x4 a = *(const u32x4*)(TOK + (size_t)tok * 8); const u32x4 c2 = *(const u32x4*)(TOK + (size_t)tok * 8 + 4);
        int base1 = 0, base2 = 0;
        base1 = mt.tb[(int)a.x]; base2 = mt.tb[(int)a.w];
        const int s1 = base1 * 256 + (int)a.y, s2 = base2 * 256 + (int)c2.x;
        const float w1 = __uint_as_float(a.z), w2 = __uint_as_float(c2.y);
        f32x4 y[8], t0[8], x[8];
        ld_row_bf16((const bf16_t*)Y2 + (size_t)s1 * DM, y, lane); ld_row_bf16((const bf16_t*)Y2 + (size_t)MOE_ROWS * DM + (size_t)s1 * DM, t0, lane);
#pragma unroll
        for (int j = 0; j < 8; ++j) y[j] = (y[j] + t0[j]) * w1;
        ld_row_bf16((const bf16_t*)Y2 + (size_t)s2 * DM, t0, lane);
#pragma unroll
        for (int j = 0; j < 8; ++j) y[j] = y[j] + t0[j] * w2;
        ld_row_bf16((const bf16_t*)Y2 + (size_t)MOE_ROWS * DM + (size_t)s2 * DM, t0, lane);
#pragma unroll
        for (int j = 0; j < 8; ++j) y[j] = y[j] + t0[j] * w2;
        ld_row_f32(XRES + (size_t)row * DM, x, lane);
        const float rs = row_rstd(y); const float* gp = in_ptr(9) + l * DM; const float* g2 = modp(F, l, mi, 5);
#pragma unroll
        for (int j = 0; j < 8; ++j) { const int c = 4 * lane + 256 * j; x[j] = x[j] + *(const f32x4*)(g2 + c) * (y[j] * rs * *(const f32x4*)(gp + c)); }
        st_row_f32(F.out + (size_t)tok * DM, x, lane);
    }
}

enum { MAP_ID = 0, MAP_WIN = 1, MAP_QUP = 2, MAP_GATE = 3, MAP_UP = 4 };
__device__ __forceinline__ int dst_row(int kind, int n) {
    if (kind == MAP_WIN) {
        if (n < 1024) return n;
        if (n < 1088) { const int i = n - 1024; return i < 32 ? CKR + 2 * i : CKR + 2 * (i - 32) + 1; }
        if (n < 2112) return CPOOL + (n - 1088);
        return CGATE + (n - 2112);
    }
    if (kind == MAP_QUP) { const int h = n / DQK, d = n % DQK; if (d < DN) return n; const int i = d - DN; return h * DQK + DN + (i < 32 ? 2 * i : 2 * (i - 32) + 1); }
    if (kind == MAP_GATE) return (n >> 7) * 256 + (n & 127);
    if (kind == MAP_UP) return (n >> 7) * 256 + 128 + (n & 127);
    return n;
}
__device__ __forceinline__ void titem_load(const float* W, int N, int item, int lane, float (&v)[32]) {
    const int nblk = N / 32, kb = item / nblk, nb = item % nblk;
    const float* p = W + (size_t)(64 * kb + (lane >> 5)) * N + 32 * nb + (lane & 31);
#pragma unroll
    for (int i = 0; i < 32; ++i) v[i] = __builtin_nontemporal_load(p + (size_t)(2 * i) * N);
}
__device__ __forceinline__ void titem_store(const float (&v)[32], int K, int N, bf16_t* WT, int kind, LAS float* scr, int item, int lane) {
    const int nblk = N / 32, kb = item / nblk, nb = item % nblk, k0 = 64 * kb, n0 = 32 * nb;
#pragma unroll
    for (int i = 0; i < 32; ++i) scr[(2 * i + (lane >> 5)) * 33 + (lane & 31)] = v[i];
    asm volatile("s_waitcnt lgkmcnt(0)" ::: "memory");
    const int c = lane & 7;
#pragma unroll
    for (int j = 0; j < 4; ++j) { const int n = (lane >> 3) + 8 * j; const LAS float* s = scr + (8 * c) * 33 + n;
        u32x4 o; o.x = cvt_pk_bf16(s[0 * 33], s[1 * 33]); o.y = cvt_pk_bf16(s[2 * 33], s[3 * 33]); o.z = cvt_pk_bf16(s[4 * 33], s[5 * 33]); o.w = cvt_pk_bf16(s[6 * 33], s[7 * 33]);
        *(u32x4*)(WT + (size_t)dst_row(kind, n0 + n) * K + k0 + 8 * c) = o; }
    asm volatile("s_waitcnt lgkmcnt(0)" ::: "memory");
}
__device__ __forceinline__ void titem_store8(const float (&v)[32], int K, int N, unsigned char* WT, int kind, LAS float* scr, int item, int lane) {
    const int nblk = N / 32, kb = item / nblk, nb = item % nblk, k0 = 64 * kb, n0 = 32 * nb;
#pragma unroll
    for (int i = 0; i < 32; ++i) scr[(2 * i + (lane >> 5)) * 33 + (lane & 31)] = v[i] * (float)(1 << pg8::FP8_WSHIFT);
    asm volatile("s_waitcnt lgkmcnt(0)" ::: "memory");
    const int c = lane & 3;
#pragma unroll
    for (int j = 0; j < 2; ++j) { const int n = (lane >> 2) + 16 * j; const LAS float* s = scr + (16 * c) * 33 + n;
        u32x4 o; o.x = cvt4_fp8(s[0 * 33], s[1 * 33], s[2 * 33], s[3 * 33]); o.y = cvt4_fp8(s[4 * 33], s[5 * 33], s[6 * 33], s[7 * 33]);
        o.z = cvt4_fp8(s[8 * 33], s[9 * 33], s[10 * 33], s[11 * 33]); o.w = cvt4_fp8(s[12 * 33], s[13 * 33], s[14 * 33], s[15 * 33]);
        *(u32x4*)(WT + (size_t)dst_row(kind, n0 + n) * K + k0 + 16 * c) = o; }
    asm volatile("s_waitcnt lgkmcnt(0)" ::: "memory");
}
__device__ __forceinline__ void titem_store_i8(const float (&v)[32], int K, int N, unsigned char* WT, int kind, const float* inv_scale, LAS float* scr, int item, int lane) {
    const int nblk = N / 32, kb = item / nblk, nb = item % nblk, k0 = 64 * kb, n0 = 32 * nb;
    const float isc = inv_scale[n0 + (lane & 31)];
#pragma unroll
    for (int i = 0; i < 32; ++i) scr[(2 * i + (lane >> 5)) * 33 + (lane & 31)] = fminf(fmaxf(rintf(v[i] * isc), -127.0f), 127.0f);
    asm volatile("s_waitcnt lgkmcnt(0)" ::: "memory");
    const int c = lane & 3;
#pragma unroll
    for (int j = 0; j < 2; ++j) { const int n = (lane >> 2) + 16 * j; const LAS float* s = scr + (16 * c) * 33 + n;
        unsigned w[4];
#pragma unroll
        for (int q = 0; q < 4; ++q) w[q] = (unsigned)((int)s[(4 * q) * 33] & 255) | ((unsigned)((int)s[(4 * q + 1) * 33] & 255) << 8) | ((unsigned)((int)s[(4 * q + 2) * 33] & 255) << 16) | ((unsigned)((int)s[(4 * q + 3) * 33] & 255) << 24);
        *(u32x4*)(WT + (size_t)dst_row(kind, n0 + n) * K + k0 + 16 * c) = (u32x4){w[0], w[1], w[2], w[3]}; }
    asm volatile("s_waitcnt lgkmcnt(0)" ::: "memory");
}
struct Job { const float* src; bf16_t* dst; int K, N, kind, items; const float* isc; };
__device__ __forceinline__ Job make_job(const float* src, bf16_t* dst, int K, int N, int kind) { Job j; j.src = src; j.dst = dst; j.K = K; j.N = N; j.kind = kind; j.items = (K / 64) * (N / 32); j.isc = nullptr; return j; }
constexpr int NJOBS = 43;
#ifndef AC_CONVERT
#define AC_CONVERT 1
#endif
#ifndef BG_CONVERT
#define BG_CONVERT 1
#endif
constexpr int NJOBS_FG = BG_CONVERT ? 19 : NJOBS;
constexpr int EXP_ITEMS_PER_JOB = (DM / 64) * (DFF / 32), EXP_ITEMS = 24 * EXP_ITEMS_PER_JOB;
static_assert((DFF / 64) * (DM / 32) == EXP_ITEMS_PER_JOB && EXP_ITEMS_PER_JOB % 32 == 0, "expert jobs have equal item counts, whole 32-item rounds");
__device__ __forceinline__ Job get_job(const Frame& F, int jid) {
    unsigned char* ws = F.ws;
    if (jid < 16) { const int l = jid >> 3, k = jid & 7;
        if (k == 0) { Job j = make_job(in_ptr(10) + (size_t)l * DM * INW, (bf16_t*)(ws + WS_WIN + l * SZ_WIN), DM, INW, MAP_WIN + (WIN_I8 ? 64 : 0)); j.isc = (const float*)(ws + WS_WSC2) + 2 * INWP + l * INW; return j; }
        if (k == 1) return make_job(in_ptr(14) + (size_t)l * QL * 3072, (bf16_t*)(ws + WS_WQUP + l * SZ_WQUP), QL, 3072, MAP_QUP);
        if (k == 2) return make_job(in_ptr(15) + (size_t)l * KVL * 4096, (bf16_t*)(ws + WS_WKVUP + l * SZ_WKVUP), KVL, 4096, MAP_ID);
        if (k == 3) return make_job(in_ptr(18) + (size_t)l * DM * DM, (bf16_t*)(ws + WS_WOUT + l * SZ_WOUT), DM, DM, MAP_ID);
        const int g = k - 4; return make_job(in_ptr(16) + ((size_t)l * 4 + g) * 256 * 512, (bf16_t*)(ws + WS_WPOOL + l * SZ_WPOOL) + (size_t)g * 512 * 256, 256, 512, MAP_ID);
    }
    if (jid == 16) { Job j = make_job(in_ptr(19), (bf16_t*)(ws + WS_WFFGU), DM, DFF, MAP_GATE + (DENSE_I8 ? 64 : 0)); j.isc = (const float*)(ws + WS_WSC) + 2 * DFF; return j; }
    if (jid == 17) { Job j = make_job(in_ptr(20), (bf16_t*)(ws + WS_WFFGU), DM, DFF, MAP_UP + (DENSE_I8 ? 64 : 0)); j.isc = (const float*)(ws + WS_WSC) + 3 * DFF; return j; }
    if (jid == 18) return make_job(in_ptr(21), (bf16_t*)(ws + WS_WFFD), DFF, DM, MAP_ID);
    const int e = (jid - 19) / 3, k = (jid - 19) % 3;
    constexpr int FK = MOE_FP8 ? 16 : 0;
    if (k == 0) return make_job(in_ptr(24) + (size_t)e * DM * DFF, (bf16_t*)(ws + WS_WEGU + e * SZ_WGU), DM, DFF, MAP_GATE + FK);
    if (k == 1) return make_job(in_ptr(25) + (size_t)e * DM * DFF, (bf16_t*)(ws + WS_WEGU + e * SZ_WGU), DM, DFF, MAP_UP + FK);
    return make_job(in_ptr(26) + (size_t)e * DFF * DM, (bf16_t*)(ws + WS_WED + e * SZ_WD), DFF, DM, MAP_ID + FK);
}
template <int PART>
__device__ __forceinline__ void phase_prologue(const Frame& F) {
    PHASE_IDS(); const int gw = F.vcu * 8 + wave, NGW = F.G * 8;
    LAS float* scr = (LAS float*)(F.lds + wave * 16384); (void)scr;
    if constexpr (PART == 1) {
    { int total = 0;
      for (int jid = 0; jid < NJOBS_FG; ++jid) total += get_job(F, jid).items;
      int jid = 0, jbase = 0; Job J = get_job(F, 0);
      float cur[32], nxt[32];
      int g = gw;
      Job Jc = J; int itc = 0;
      if (g < total) { while (g >= jbase + J.items) { jbase += J.items; ++jid; J = get_job(F, jid); } Jc = J; itc = g - jbase; titem_load(Jc.src, Jc.N, itc, lane, cur); }
      while (g < total) {
          const int gn = g + NGW; Job Jn = J; int itn = 0; const bool hn = gn < total;
          if (hn) { while (gn >= jbase + J.items) { jbase += J.items; ++jid; J = get_job(F, jid); } Jn = J; itn = gn - jbase; titem_load(Jn.src, Jn.N, itn, lane, nxt); }
          if (Jc.kind >= 64) titem_store_i8(cur, Jc.K, Jc.N, (unsigned char*)Jc.dst, Jc.kind - 64, Jc.isc, scr, itc, lane);
          else if (MOE_FP8 && Jc.kind >= 16) titem_store8(cur, Jc.K, Jc.N, (unsigned char*)Jc.dst, Jc.kind - 16, scr, itc, lane);
          else titem_store(cur, Jc.K, Jc.N, Jc.dst, Jc.kind, scr, itc, lane);
#pragma unroll
          for (int i = 0; i < 32; ++i) cur[i] = nxt[i];
          Jc = Jn; itc = itn; g = gn;
      } }
    for (int l = 0; l < 2; ++l) { constexpr int WES = WIN_I8 ? 1 : 2; u32x4* z = (u32x4*)(F.ws + WS_WIN + l * SZ_WIN + (size_t)INW * DM * WES); const int n16 = (INWP - INW) * DM * WES / 16;
        for (int i = gw * 64 + lane; i < n16; i += NGW * 64) z[i] = (u32x4){0u, 0u, 0u, 0u}; }
    } else {
    { const int nM = (MOD_DEFER && F.G == 256) ? 16 * 48 : 2 * 16 * 48, nGU = DENSE_I8 ? 2 * 16 * 28 : 0, nWI = WIN_I8 ? 2 * 16 * 25 : 0;
      float* WSCP = (float*)(F.ws + WS_WSCP); float* WSCP2 = (float*)(F.ws + WS_WSCP2);
      for (int it = wave * F.G + F.vcu; it < nM + nGU + nWI; it += NGW) {
          if (it < nM) mod_partial_item(F, it, lane);
          else if (it < nM + nGU) { const int i2 = it - nM, m = i2 / (16 * 28), kc = (i2 / 28) % 16, cb = i2 % 28, n0 = cb * 256 + 4 * lane;
              const GAS float* W = (const GAS float*)in_ptr(19 + m) + (size_t)(kc * 128) * DFF + n0;
              f32x4 mx = {0.f, 0.f, 0.f, 0.f};
#pragma unroll
              for (int k = 0; k < 128; k += AMAX_STRIDE) { const f32x4 w = *(const GAS f32x4*)(W + (size_t)k * DFF); mx = __builtin_elementwise_max(mx, __builtin_elementwise_abs(w)); }
              *(f32x4*)(WSCP + ((size_t)kc * 2 + m) * DFF + n0) = mx; }
          else { const int i3 = it - nM - nGU, l = i3 / (16 * 25), kc = (i3 / 25) % 16, cb = i3 % 25, n0 = cb * 256 + 4 * lane;
              if (n0 < INW) { const GAS float* W = (const GAS float*)in_ptr(10) + (size_t)l * DM * INW + (size_t)(kc * 128) * INW + n0;
                  f32x4 mx = {0.f, 0.f, 0.f, 0.f};
#pragma unroll
                  for (int k = 0; k < 128; k += AMAX_STRIDE) { const f32x4 w = *(const GAS f32x4*)(W + (size_t)k * INW); mx = __builtin_elementwise_max(mx, __builtin_elementwise_abs(w)); }
                  *(f32x4*)(WSCP2 + ((size_t)kc * 2 + l) * INWP + n0) = mx; } } } }
    { float* rc = (float*)(F.ws + WS_ROPE); float* rsn = rc + SEQ * 32;
      for (int i = gw * 64 + lane; i < SEQ * 32; i += NGW * 64) { const int s = i >> 5, f = i & 31, jf = f & 15;
          const float inv = __builtin_amdgcn_exp2f(-(float)jf * (13.287712379549449f / 16.0f));
          const float pos = (float)(f < 16 ? (s >> 6) : (s & 63)); const float ang = pos * inv;
          const float rev = ang * 0.15915494309189535f; const float fr = rev - floorf(rev);
          rc[i] = __builtin_amdgcn_cosf(fr); rsn[i] = __builtin_amdgcn_sinf(fr); } }
    }
}
__device__ __forceinline__ void witem_load(const float* W, int N, int item, int lane, f32x4 (&v)[8]) {
    const int nblk = N / 32, kb = item / nblk, nb = item % nblk;
    const float* p = W + (size_t)(64 * kb + (lane >> 3)) * N + 32 * nb + 4 * (lane & 7);
#pragma unroll
    for (int i = 0; i < 8; ++i) v[i] = __builtin_nontemporal_load((const f32x4*)(p + (size_t)(8 * i) * N));
}
__device__ __forceinline__ void witem_store8(const f32x4 (&v)[8], int K, int N, unsigned char* WT, int kind, LAS float* scr, int item, int lane) {
    const int nblk = N / 32, kb = item / nblk, nb = item % nblk, k0 = 64 * kb, n0 = 32 * nb;
#pragma unroll
    for (int i = 0; i < 8; ++i) *(LAS f32x4*)(scr + ((lane >> 3) + 8 * i) * 36 + 4 * (lane & 7)) = v[i] * (float)(1 << pg8::FP8_WSHIFT);
    asm volatile("s_waitcnt lgkmcnt(0)" ::: "memory");
    const int c = lane & 3;
#pragma unroll
    for (int j = 0; j < 2; ++j) { const int n = (lane >> 2) + 16 * j; const LAS float* s = scr + (16 * c) * 36 + n;
        u32x4 o; o.x = cvt4_fp8(s[0 * 36], s[1 * 36], s[2 * 36], s[3 * 36]); o.y = cvt4_fp8(s[4 * 36], s[5 * 36], s[6 * 36], s[7 * 36]);
        o.z = cvt4_fp8(s[8 * 36], s[9 * 36], s[10 * 36], s[11 * 36]); o.w = cvt4_fp8(s[12 * 36], s[13 * 36], s[14 * 36], s[15 * 36]);
        *(u32x4*)(WT + (size_t)dst_row(kind, n0 + n) * K + k0 + 16 * c) = o; }
    asm volatile("s_waitcnt lgkmcnt(0)" ::: "memory");
}
constexpr int QBATCH = 8;
__device__ __forceinline__ int queue_grab(unsigned* qh, int lane) { int v = 0; if (lane == 0) v = (int)__hip_atomic_fetch_add(qh, (unsigned)QBATCH, RLX_AGENT); return __builtin_amdgcn_readfirstlane(v); }
__device__ __forceinline__ void bg_item_load(const Frame& F, int g, int lane, float (&v)[32]) { const Job J = get_job(F, 19 + g / EXP_ITEMS_PER_JOB); titem_load(J.src, J.N, g % EXP_ITEMS_PER_JOB, lane, v); }
__device__ __forceinline__ void bg_item_store(const Frame& F, int g, int lane, const float (&v)[32], LAS float* scr) { const Job J = get_job(F, 19 + g / EXP_ITEMS_PER_JOB);
    if (MOE_FP8) titem_store8(v, J.K, J.N, (unsigned char*)J.dst, J.kind - 16, scr, g % EXP_ITEMS_PER_JOB, lane);
    else titem_store(v, J.K, J.N, J.dst, J.kind, scr, g % EXP_ITEMS_PER_JOB, lane); }
__device__ __forceinline__ void convert_bg(const Frame& F, int ph, unsigned thr) {
#if BG_CONVERT
    const int qoff = (AC_CONVERT && F.G == 256) ? att::AC_JOBS * EXP_ITEMS_PER_JOB : 0;
    if (ph >= 0 && thr == 0u) return;
    PHASE_IDS();
    LAS float* scr = (LAS float*)(F.lds + wave * 16384);
    unsigned* qh = F.ctl + CW_QHEAD; unsigned* dn = F.ctl + CW_DONE + 64 * (ph < 0 ? 0 : ph);
    float cur[32], nxt[32];
    if (ph < 0) {
        const int h = __builtin_amdgcn_readfirstlane((int)__hip_atomic_load(qh, RLX_AGENT)) + qoff;
        const int gw = F.vcu * 8 + wave, NGW = F.G * 8;
        int g = h + gw;
        if (g < EXP_ITEMS) bg_item_load(F, g, lane, cur);
        while (g < EXP_ITEMS) { const int gn = g + NGW;
            if (gn < EXP_ITEMS) bg_item_load(F, gn, lane, nxt);
            bg_item_store(F, g, lane, cur, scr);
#pragma unroll
            for (int i = 0; i < 32; ++i) cur[i] = nxt[i];
            g = gn; }
        return;
    }
    volatile LAS int* qw = (volatile LAS int*)(F.lds + MISC_OFF + 128);
    for (;;) {
        __syncthreads();
        if (tid == 0) { int g0 = EXP_ITEMS;
            if (__hip_atomic_load(dn, RLX_AGENT) < thr) g0 = (int)__hip_atomic_fetch_add(qh, 32u, RLX_AGENT) + qoff;
            qw[0] = g0; }
        __syncthreads();
        const int g0 = __builtin_amdgcn_readfirstlane(qw[0]);
        if (g0 >= EXP_ITEMS) break;
        const int gb = g0 + wave * 4;
#if MOE_FP8
        f32x4 w0[8], w1[8], w2[8], w3[8];
        { const Job J = get_job(F, 19 + gb / EXP_ITEMS_PER_JOB); const int it = gb % EXP_ITEMS_PER_JOB;
          witem_load(J.src, J.N, it, lane, w0); witem_load(J.src, J.N, it + 1, lane, w1); witem_load(J.src, J.N, it + 2, lane, w2); witem_load(J.src, J.N, it + 3, lane, w3);
          witem_store8(w0, J.K, J.N, (unsigned char*)J.dst, J.kind - 16, scr, it, lane); witem_store8(w1, J.K, J.N, (unsigned char*)J.dst, J.kind - 16, scr, it + 1, lane);
          witem_store8(w2, J.K, J.N, (unsigned char*)J.dst, J.kind - 16, scr, it + 2, lane); witem_store8(w3, J.K, J.N, (unsigned char*)J.dst, J.kind - 16, scr, it + 3, lane); }
#else
#pragma unroll 1
        for (int q = 0; q < 4; ++q) { bg_item_load(F, gb + q, lane, cur); bg_item_store(F, gb + q, lane, cur, scr); }
#endif
    }
#endif
}
__device__ __forceinline__ void report_done(const Frame& F, int ph) {
#if BG_CONVERT
    if (threadIdx.x == 0) __hip_atomic_fetch_add(F.ctl + CW_DONE + 64 * ph, 1u, RLX_AGENT);
#endif
}
__device__ __forceinline__ unsigned bg_thr(int units, int G) { const int rem = units % G; return rem ? (unsigned)(G - rem + 1) : 0u; }
__device__ __forceinline__ void phase_mod_reduce(const Frame& F) {
    const float* MODP = (const float*)(F.ws + WS_MODP); float* MOD = (float*)(F.ws + WS_MOD);
    PHASE_IDS(); const float* bmod = in_ptr(5);
    mod_reduce_layer(F, 0, tid);
    if (!(MOD_DEFER && F.G == 256)) mod_reduce_layer(F, 1, tid);
#if DENSE_I8
    { const float* WSCP = (const float*)(F.ws + WS_WSCP); float* WSC = (float*)(F.ws + WS_WSC);
      for (int i = (F.vcu * 8 + wave) * 64 + lane; i < 2 * DFF; i += F.G * 512) { float mx = 1e-30f;
          for (int kc = 0; kc < 16; ++kc) mx = fmaxf(mx, WSCP[(size_t)kc * 2 * DFF + i]);
          mx *= AMAX_MARGIN; WSC[i] = mx * (1.0f / 127.0f); WSC[2 * DFF + i] = 127.0f / mx; } }
#endif
#if WIN_I8
    { const float* WSCP2 = (const float*)(F.ws + WS_WSCP2); float* WSC2 = (float*)(F.ws + WS_WSC2);
      for (int i = (F.vcu * 8 + wave) * 64 + lane; i < 2 * INW; i += F.G * 512) { const int l = i / INW, n = i % INW; float mx = 1e-30f;
          for (int kc = 0; kc < 16; ++kc) mx = fmaxf(mx, WSCP2[((size_t)kc * 2 + l) * INWP + n]);
          mx *= AMAX_MARGIN; WSC2[l * INWP + dst_row(MAP_WIN, n)] = mx * (1.0f / 127.0f); WSC2[2 * INWP + l * INW + n] = 127.0f / mx; }
      for (int i = (F.vcu * 8 + wave) * 64 + lane; i < 2 * (INWP - INW); i += F.G * 512) WSC2[(i / (INWP - INW)) * INWP + INW + i % (INWP - INW)] = 1.0f; }
#endif
}

template <int L>
__device__ __forceinline__ void layer_body(const Frame& F, const XcdBarrier& bar, char* lds_gen) {
    unsigned char* ws = F.ws;
    const float* ropec = (const float*)(ws + WS_ROPE); const float* ropes = ropec + SEQ * 32;
    constexpr int l = L;
    if constexpr (L == 0) {
      constexpr int WES = WIN_I8 ? 1 : 2;
      SchedDense S; S.o.init(R / 256, INWP / 256, F.G, (int)blockIdx.x); S.A = (const char*)(ws + WS_H); S.B = (const char*)(ws + WS_WIN + l * SZ_WIN); S.lda2 = DM * WES; S.ldb2 = DM * WES;
      EpiG1 E{(bf16_t*)(ws + WS_P), in_ptr(11) + l * 4096, ropec, ropes, WIN_I8 ? (const float*)(ws + WS_HSC) : nullptr, WIN_I8 ? (const float*)(ws + WS_WSC2) + l * INWP : nullptr};
      pg8::gemm_phase<false, EpiG1, SchedDense, WIN_I8 != 0>(F.lds, F.ws, F.wv, DM, DM, DM / (WIN_I8 ? 128 : 64), S, E);
      report_done(F, l * 8 + 0); convert_bg(F, l * 8 + 0, bg_thr((R / 256) * (INWP / 256), F.G));
    } else {
      SchedG1Last S; S.o.init(NLAT / 256, INWP / 256, F.G, (int)blockIdx.x); S.A = (const char*)(ws + WS_H); S.B = (const char*)(ws + WS_WIN + l * SZ_WIN); S.es = WIN_I8 ? 1 : 2;
      EpiG1 E{(bf16_t*)(ws + WS_P), in_ptr(11) + l * 4096, ropec, ropes, WIN_I8 ? (const float*)(ws + WS_HSC) : nullptr, WIN_I8 ? (const float*)(ws + WS_WSC2) + l * INWP : nullptr};
      pg8::gemm_phase<false, EpiG1, SchedG1Last, WIN_I8 != 0>(F.lds, F.ws, F.wv, DM, DM, DM / (WIN_I8 ? 128 : 64), S, E);
      report_done(F, l * 8 + 0); convert_bg(F, l * 8 + 0, bg_thr((NLAT / 256) * (INWP / 256) + 6, F.G));
    }
    xcd_barrier(bar);
    phase_thin2(F, l);
    xcd_barrier(bar);
    { SchedDense S; S.o.init(L == 1 ? NLAT / 256 : R / 256, 3072 / 256, F.G, (int)blockIdx.x); S.lat_only = (L == 1);
      S.A = (const char*)(ws + WS_QLN); S.B = (const char*)(ws + WS_WQUP + l * SZ_WQUP); S.lda2 = QL * 2; S.ldb2 = QL * 2;
      EpiQ E{(bf16_t*)(ws + WS_Q), ropec, ropes};
      pg8::gemm_phase<false>(F.lds, F.ws, F.wv, QL, QL, QL / 64, S, E); }
    { SchedDense S; S.o.init(R / 256, 4096 / 256, F.G, F.G == 256 ? ((int)blockIdx.x + 104) & 255 : (int)blockIdx.x); S.A = (const char*)(ws + WS_KVLN); S.B = (const char*)(ws + WS_WKVUP + l * SZ_WKVUP); S.lda2 = KVL * 2; S.ldb2 = KVL * 2;
      EpiKV E{(bf16_t*)(ws + WS_KN), (bf16_t*)(ws + WS_V)};
      pg8::gemm_phase<false>(F.lds, F.ws, F.wv, KVL, KVL, KVL / 64, S, E); }
    { SchedPool S; S.o.init(L == 1 ? NLAT / 256 : R / 256, 2048 / 256, F.G, F.G == 256 ? ((int)blockIdx.x + 72) & 255 : (int)blockIdx.x); S.lat_only = (L == 1); S.A = (const char*)(ws + WS_PL); S.B = (const char*)(ws + WS_WPOOL + l * SZ_WPOOL);
      EpiPool E{(bf16_t*)(ws + WS_POOLM), (const bf16_t*)(ws + WS_P), in_ptr(17) + l * DM};
      pg8::gemm_phase<false>(F.lds, F.ws, F.wv, POOLW, 256, 4, S, E); }
    report_done(F, l * 8 + 1); convert_bg(F, l * 8 + 1, F.G == 256 ? 73u : 0u);
    xcd_barrier(bar);
    { const att::Out O{ws};
#if !NAIVE_ATTN
      int slot = 0;
      for (int uid = F.vcu; uid < 512; uid += F.G, ++slot) { const int b = uid >> 8, h = (uid >> 4) & 15, qt = uid & 15;
          const bool ac = AC_CONVERT && F.G == 256;
          att::attn_unit(b * TPB + CTXL + qt * 256, b * TPB, TPB, h, lds_gen, F.lds, O, F.wv, ac ? (l * 2 + slot) * 256 + F.vcu : -1); }
      if (l == 0) for (int j = 0; j < 32; ++j) if ((j * 8) % F.G == F.vcu) { const int b = j >> 4, h = j & 15;
          att::attn_unit(b * TPB, b * TPB, CTXL, h, lds_gen, F.lds, O, F.wv, -1); }
      if constexpr (L == 0) if (MOD_DEFER && F.G == 256 && (F.vcu & 7) != 0) {
          PHASE_IDS(); const int idx = F.vcu - (F.vcu / 8 + 1), it = wave * 224 + idx;
          if (wave < 4 && it < 16 * 48) mod_partial_item(F, 16 * 48 + it, lane); }
#else
      const bf16_t* Qg = (const bf16_t*)(ws + WS_Q); const bf16_t* KNg = (const bf16_t*)(ws + WS_KN); const bf16_t* Pg = (const bf16_t*)(ws + WS_P); const bf16_t* Vg = (const bf16_t*)(ws + WS_V);
      PHASE_IDS();
      if (wave < 7) { LAS float* sc = (LAS float*)(F.lds) + wave * (TPB + DQK); LAS float* qs = sc + TPB;
          const int gw7 = F.vcu * 7 + wave, NG7 = F.G * 7;
          for (int it = gw7; it < NLAT * NH; it += NG7) { const int tok = it >> 4, h = it & 15, b = tok / SEQ, s = tok % SEQ;
              att::attn_naive_item(Qg, KNg, Pg, Vg, b * TPB + CTXL + s, b * TPB, TPB, h, sc, qs, lane, O); }
          if (l == 0) for (int it = gw7; it < NB * CTXL * NH; it += NG7) { const int tok = it >> 4, h = it & 15, b = tok / CTXL, t = tok % CTXL;
              att::attn_naive_item(Qg, KNg, Pg, Vg, b * TPB + t, b * TPB, CTXL, h, sc, qs, lane, O); } }
      __syncthreads();
#endif
    }
    xcd_barrier(bar);
    { SchedDense S; S.o.init(NLAT / 256, DM / 256, F.G, (int)blockIdx.x); S.lat_only = true;
      S.A = (const char*)(ws + WS_MB); S.B = (const char*)(ws + WS_WOUT + l * SZ_WOUT); S.lda2 = DM * 2; S.ldb2 = DM * 2;
      EpiPlain E{(bf16_t*)(ws + WS_Y), DM};
      pg8::gemm_phase<false>(F.lds, F.ws, F.wv, DM, DM, DM / 64, S, E); }
    if constexpr (L == 0) {
      SchedCtxSplit S; S.o.init(2, (DM / 256) * ZS_G3, F.G, (int)blockIdx.x); S.A = (const char*)(ws + WS_MB); S.B = (const char*)(ws + WS_WOUT + l * SZ_WOUT); S.lda2 = DM * 2; S.ldb2 = DM * 2; S.nN = DM / 256; S.ksb = (DM / ZS_G3) * 2;
      EpiCtxPart E{ws};
      pg8::gemm_phase<false>(F.lds, F.ws, F.wv, DM, DM, DM / ZS_G3 / 64, S, E); }
    xcd_barrier(bar);
    if constexpr (L == 0) {
        phase_thin3_dense(F, l);
        xcd_barrier(bar);
#if DENSE_I8
        { SchedDense S; S.o.init(R / 256, 14336 / 256, F.G, (int)blockIdx.x); S.A = (const char*)(ws + WS_H); S.B = (const char*)(ws + WS_WFFGU); S.lda2 = DM; S.ldb2 = DM;
          EpiSwigluI8 E{ws};
          pg8::gemm_phase<false, EpiSwigluI8, SchedDense, true>(F.lds, F.ws, F.wv, DM, DM, DM / 128, S, E); }
#else
        { SchedDense S; S.o.init(R / 256, 14336 / 256, F.G, (int)blockIdx.x); S.A = (const char*)(ws + WS_H); S.B = (const char*)(ws + WS_WFFGU); S.lda2 = DM * 2; S.ldb2 = DM * 2;
          EpiSwiglu E{(bf16_t*)(ws + WS_ACT)};
          pg8::gemm_phase<false>(F.lds, F.ws, F.wv, DM, DM, DM / 64, S, E); }
#endif
        report_done(F, 3); convert_bg(F, 3, bg_thr((R / 256) * (14336 / 256), F.G));
        xcd_barrier(bar);
        { SchedDense S; S.o.init(NLAT / 256, DM / 256, F.G, (int)blockIdx.x); S.lat_only = true;
          S.A = (const char*)(ws + WS_ACT); S.B = (const char*)(ws + WS_WFFD); S.lda2 = DFF * 2; S.ldb2 = DFF * 2;
          EpiDown E{ws, (unsigned)(MOE_ROWS * DM), 1.0f};
          pg8::gemm_phase<false>(F.lds, F.ws, F.wv, DFF, DFF, DFF / 64, S, E); }
        { SchedCtxSplit S; S.o.init(2, (DM / 256) * ZS_G5, F.G, (int)blockIdx.x); S.A = (const char*)(ws + WS_ACT); S.B = (const char*)(ws + WS_WFFD); S.lda2 = DFF * 2; S.ldb2 = DFF * 2; S.nN = DM / 256; S.ksb = (DFF / ZS_G5) * 2;
          EpiCtxPart E{ws};
          pg8::gemm_phase<false>(F.lds, F.ws, F.wv, DFF, DFF, DFF / ZS_G5 / 64, S, E); }
        report_done(F, 4); convert_bg(F, 4, bg_thr(2 * (DM / 256) * ZS_G5, F.G));
        xcd_barrier(bar);
        phase_thin4_dense(F, l);
        xcd_barrier(bar);
    } else {
        convert_bg(F, -1, 0u);
        phase_thin3_moe(F, l);
        xcd_barrier(bar);
        const MoeTiles mt = moe_tiles(F);
#if !MOE_DIRECT
        phase_moe_scatter(F, l, mt);
        xcd_barrier(bar);
#endif
        { SchedMoeUp S; S.o.init(mt.total, 14336 / 256, F.G, (int)blockIdx.x); S.mt = mt; S.A = (const char*)(ws + (MOE_DIRECT ? WS_HS2 : WS_HS)); S.B = (const char*)(ws + WS_WEGU);
#if MOE_FP8
          EpiSwiglu8 E{ws};
          pg8::gemm_phase<true>(F.lds, F.ws, F.wv, DM, DM, DM / 128, S, E); }
#else
          EpiSwiglu E{(bf16_t*)(ws + WS_ACT)};
          pg8::gemm_phase<false>(F.lds, F.ws, F.wv, DM, DM, DM / 64, S, E); }
#endif
        xcd_barrier(bar);
        { SchedMoeDown S; S.o.init(mt.total, (DM / 256) * ZK, F.G, (int)blockIdx.x); S.mt = mt; S.A = (const char*)(ws + WS_ACT); S.B = (const char*)(ws + WS_WED); S.nN = DM / 256;
          EpiDown E{ws, (unsigned)(MOE_ROWS * DM), MOE_FP8 ? pg8::FP8_WINV : 1.0f};
          pg8::gemm_phase<MOE_FP8 != 0>(F.lds, F.ws, F.wv, DFF, DFF, KSPL / (MOE_FP8 ? 128 : 64), S, E); }
        xcd_barrier(bar);
        phase_final_moe(F, l, mt);
    }
}

__global__ void __launch_bounds__(512, 2) fwd_kernel(Args args) {
    extern __shared__ __attribute__((aligned(16))) unsigned char lds_raw[];
    const int G = gridDim.x, bx = blockIdx.x;
    const Frame F{(LAS unsigned char*)lds_raw, (unsigned*)(args.ws + WS_CTL), args.ws, (G % 8 == 0) ? (bx % 8) * (G / 8) + bx / 8 : bx, G, __builtin_amdgcn_readfirstlane((int)threadIdx.x >> 6), args.out};
    volatile LAS unsigned* MISC = (volatile LAS unsigned*)(F.lds + MISC_OFF);
    for (int u = threadIdx.x; u < (LDS_BYTES - LDSCTL_OFF) / 4; u += 512) ((LAS unsigned*)(F.lds + LDSCTL_OFF))[u] = 0u;
    __syncthreads();
    const XcdBarrier bar = xcd_barrier_post(F.ctl + CW_BAR, MISC + 8);

    phase_prologue<0>(F);
    xcd_barrier(bar);
    phase_mod_reduce(F);
    xcd_barrier(bar);
    phase_prologue<1>(F);
    phase_norm1_l0(F);
    xcd_barrier(bar);
    layer_body<0>(F, bar, (char*)lds_raw);
    layer_body<1>(F, bar, (char*)lds_raw);
}

extern "C" void kernel_launch(void* const* d_in, const int* in_sizes, int n_in, void* d_out, int out_size, void* d_ws, size_t ws_size, hipStream_t stream) {
    static int grid = 0;
    if (grid == 0) {
        if (n_in != 27 || out_size != NLAT * DM || ws_size < WS_END) { fprintf(stderr, "kernel_launch: shape mismatch n_in %d out %d ws %zu (need %zu)\n", n_in, out_size, ws_size, (size_t)WS_END); grid = -1; return; }
        int dev = 0, cus = 0;
        if (hipGetDevice(&dev) != hipSuccess || hipDeviceGetAttribute(&cus, hipDeviceAttributeMultiprocessorCount, dev) != hipSuccess) { grid = -1; return; }
        if (hipFuncSetAttribute((const void*)fwd_kernel, hipFuncAttributeMaxDynamicSharedMemorySize, LDS_BYTES) != hipSuccess) { fprintf(stderr, "kernel_launch: hipFuncSetAttribute failed\n"); grid = -1; return; }
        int per_cu = 0;
        if (hipOccupancyMaxActiveBlocksPerMultiprocessor(&per_cu, (const void*)fwd_kernel, 512, LDS_BYTES) != hipSuccess || per_cu < 1) fprintf(stderr, "kernel_launch: occupancy query says %d\n", per_cu);
        (void)hipGetLastError();
        grid = cus;
    }
    if (grid < 0) return;
    (void)hipMemsetAsync((char*)d_ws + WS_CTL, 0, CTL_BYTES, stream);
    Args a{};
    for (int i = 0; i < 27; ++i) a.in[i] = (const float*)d_in[i];
    a.out = (float*)d_out; a.ws = (unsigned char*)d_ws;
    hipLaunchKernelGGL(fwd_kernel, dim3(grid), dim3(512), LDS_BYTES, stream, a);
    const hipError_t le = hipPeekAtLastError();
    if (le != hipSuccess) fprintf(stderr, "kernel_launch: launch failed: %s\n", hipGetErrorName(le));
}
```
